# Optimizing an MI355X kernel written in HIP

```python
import jax, jax.numpy as jnp
from jax import lax
import numpy as np

D_MODEL = 2048
BATCH = 4
SEQ = 4096
DEPTH = 1

HEAD_DIM = 128
MIX_WIDTH = D_MODEL
N_HEADS = MIX_WIDTH // HEAD_DIM
N_HEADS_MOBA = N_HEADS // 2
N_HEADS_DIL = N_HEADS - N_HEADS_MOBA
W_MOBA = N_HEADS_MOBA * HEAD_DIM
W_DIL = N_HEADS_DIL * HEAD_DIM
QKV_SPLITS = (W_MOBA, 2 * W_MOBA, 3 * W_MOBA, 3 * W_MOBA + W_DIL, 3 * W_MOBA + 2 * W_DIL)
ROT_DIM = HEAD_DIM // 4
ROPE_THETA = 500000.0
MOBA_BLOCK = 256
MOBA_TOPK = 3
MOBA_QCHUNK = 32
DIL_PAIRS = ((128, 1), (512, 4), (2048, 16))
DIL_BLOCK = 128
D_FF = 4 * D_MODEL
CONV_WIDTH = 3
RMS_EPS = 1e-6
SCALE = HEAD_DIM ** -0.5
NEG = -1e30

kernel_name = 'hymba_moba_dilated_convffn_block'


def rms_norm(x, g):
    xf = x.astype(jnp.float32)
    y = xf * lax.rsqrt(jnp.mean(xf * xf, axis=-1, keepdims=True) + RMS_EPS)
    return (y * g.astype(jnp.float32)).astype(x.dtype)


def partial_rope(t, positions):
    half = ROT_DIM // 2
    inv_freq = ROPE_THETA ** (-jnp.arange(half, dtype=jnp.float32) / half)
    ang = positions.astype(jnp.float32)[..., None] * inv_freq
    cos = jnp.cos(ang)[:, :, None, :]
    sin = jnp.sin(ang)[:, :, None, :]
    tr = t[..., :ROT_DIM].astype(jnp.float32)
    t1, t2 = tr[..., :half], tr[..., half:]
    rot = jnp.concatenate([t1 * cos - t2 * sin, t2 * cos + t1 * sin], axis=-1).astype(t.dtype)
    return jnp.concatenate([rot, t[..., ROT_DIM:]], axis=-1)


def moba_attention(q, k, v):
    B, S, H, Dh = q.shape
    nb = -(-S // MOBA_BLOCK)
    Sp = nb * MOBA_BLOCK
    k_top = min(MOBA_TOPK, nb - 1)
    pad = ((0, 0), (0, Sp - S), (0, 0), (0, 0))
    kbh = jnp.pad(k, pad).reshape(B, nb, MOBA_BLOCK, H, Dh).transpose(0, 3, 1, 2, 4)
    vbh = jnp.pad(v, pad).reshape(B, nb, MOBA_BLOCK, H, Dh).transpose(0, 3, 1, 2, 4)
    q_pos = jnp.arange(S, dtype=jnp.int32)
    q_blk = q_pos // MOBA_BLOCK
    qh = q.transpose(0, 2, 1, 3)
    own = jnp.broadcast_to(q_blk[None, None, :, None], (B, H, S, 1))
    own_valid = jnp.ones((B, H, S, 1), dtype=bool)
    if k_top > 0:
        k_mean = jnp.mean(kbh.astype(jnp.float32), axis=3)
        gate = jnp.einsum('bhsd,bhnd->bhsn', qh.astype(jnp.float32), k_mean)
        fully_past = jnp.arange(nb)[None, :] < q_blk[:, None]
        gate = jnp.where(fully_past, gate, NEG)
        _, top_idx = lax.top_k(gate, k_top)
        top_idx = top_idx.astype(jnp.int32)
        sel = jnp.concatenate([top_idx, own], axis=-1)
        valid = jnp.concatenate([top_idx < q_blk[:, None], own_valid], axis=-1)
    else:
        sel, valid = own, own_valid
    nsel = sel.shape[-1]
    C = MOBA_QCHUNK
    NC = S // C

    def to_chunks(t):
        return jnp.moveaxis(t.reshape((B, H, NC, C) + t.shape[3:]), 2, 0)

    bi = jnp.arange(B)[:, None, None, None]
    hi = jnp.arange(H)[None, :, None, None]

    def chunk(args):
        qc, selc, validc, posc = args
        kg = kbh[bi, hi, selc]
        vg = vbh[bi, hi, selc]
        s = jnp.einsum('bhcd,bhcjkd->bhcjk', qc, kg, preferred_element_type=jnp.float32) * SCALE
        key_pos = selc[..., None] * MOBA_BLOCK + jnp.arange(MOBA_BLOCK, dtype=jnp.int32)
        mask = validc[..., None] & (key_pos <= posc[None, None, :, None, None])
        s = jnp.where(mask, s, NEG).reshape(B, H, C, nsel * MOBA_BLOCK)
        p = jax.nn.softmax(s, axis=-1).reshape(B, H, C, nsel, MOBA_BLOCK)
        return jnp.einsum('bhcjk,bhcjkd->bhcd', p.astype(vg.dtype), vg,
                          preferred_element_type=jnp.float32)

    out = lax.map(chunk, (to_chunks(qh), to_chunks(sel), to_chunks(valid), q_pos.reshape(NC, C)))
    return jnp.moveaxis(out, 0, 2).reshape(B, H, S, Dh).transpose(0, 2, 1, 3)


def dilated_branch(q, k, v, window, dilation):
    B, S, H, Dh = q.shape
    n_back = window // dilation
    unit = dilation * DIL_BLOCK
    Sp = -(-S // unit) * unit
    L = Sp // dilation
    nblk = L // DIL_BLOCK

    def split(t):
        t = jnp.pad(t, ((0, 0), (0, Sp - S), (0, 0), (0, 0))).reshape(B, L, dilation, H, Dh)
        return t.transpose(0, 2, 3, 1, 4).reshape(B, dilation, H, nblk, DIL_BLOCK, Dh)

    def with_prev(t):
        prev = jnp.pad(t, ((0, 0), (0, 0), (0, 0), (1, 0), (0, 0), (0, 0)))[:, :, :, :-1]
        return jnp.concatenate([prev, t], axis=4)

    qs = split(q)
    kk = with_prev(split(k))
    vv = with_prev(split(v))
    s = jnp.einsum('brhnqd,brhnkd->brhnqk', qs, kk, preferred_element_type=jnp.float32) * SCALE
    qi = jnp.arange(DIL_BLOCK) + DIL_BLOCK
    ki = jnp.arange(2 * DIL_BLOCK)
    dist = qi[:, None] - ki[None, :]
    band = (dist >= 0) & (dist <= n_back)
    blk_ok = (jnp.arange(nblk)[:, None, None] > 0) | (ki[None, None, :] >= DIL_BLOCK)
    mask = band[None] & blk_ok
    s = jnp.where(mask, s, NEG)
    m = jnp.max(s, axis=-1, keepdims=True)
    p = jnp.exp(s - m)
    den = jnp.sum(p, axis=-1, keepdims=True)
    o = jnp.einsum('brhnqk,brhnkd->brhnqd', p.astype(vv.dtype), vv,
                   preferred_element_type=jnp.float32) / den
    lse = (m + jnp.log(den))[..., 0]
    o = o.reshape(B, dilation, H, L, Dh).transpose(0, 3, 1, 2, 4).reshape(B, Sp, H, Dh)[:, :S]
    lse = lse.reshape(B, dilation, H, L).transpose(0, 3, 1, 2).reshape(B, Sp, H)[:, :S]
    return o, lse


def dilated_mixture(q, k, v):
    outs, lses = [], []
    for window, dilation in DIL_PAIRS:
        o, lse = dilated_branch(q, k, v, window, dilation)
        outs.append(o)
        lses.append(lse)
    w = jax.nn.softmax(jnp.stack(lses, axis=0), axis=0)
    return jnp.sum(w[..., None] * jnp.stack(outs, axis=0), axis=0)


def conv_glu_ffn(h, w_gate, w_up, conv_w, conv_b, w_down):
    S = h.shape[1]
    g = h @ w_gate
    u = h @ w_up
    gp = jnp.pad(g, ((0, 0), (CONV_WIDTH - 1, 0), (0, 0)))
    g = conv_b + gp[:, 0:S] * conv_w[0]
    for j in range(1, CONV_WIDTH):
        g = g + gp[:, j:j + S] * conv_w[j]
    return (jax.nn.gelu(g, approximate=True) * u) @ w_down


def setup_inputs(seed: int = 0) -> dict:
    key = jax.random.key(seed)
    ks = jax.random.split(key, 14)
    f32 = jnp.float32

    def nrm(k, shape, scale):
        return jax.random.normal(k, shape, f32) * scale

    def gain(k, n):
        return 1.0 + 0.02 * jax.random.normal(k, (DEPTH, n), f32)

    return {
        'x': jax.random.normal(ks[0], (BATCH, SEQ, D_MODEL), f32),
        'positions': jnp.broadcast_to(jnp.arange(SEQ, dtype=jnp.int32), (BATCH, SEQ)),
        'attn_pre_g': gain(ks[1], D_MODEL),
        'w_qkv': nrm(ks[2], (DEPTH, D_MODEL, 3 * MIX_WIDTH), D_MODEL ** -0.5),
        'moba_out_g': gain(ks[3], W_MOBA),
        'dil_out_g': gain(ks[4], W_DIL),
        'w_o': nrm(ks[5], (DEPTH, MIX_WIDTH, D_MODEL), MIX_WIDTH ** -0.5),
        'attn_post_g': gain(ks[6], D_MODEL),
        'ffn_pre_g': gain(ks[7], D_MODEL),
        'w_gate': nrm(ks[8], (DEPTH, D_MODEL, D_FF), D_MODEL ** -0.5),
        'w_up': nrm(ks[9], (DEPTH, D_MODEL, D_FF), D_MODEL ** -0.5),
        'conv_w': nrm(ks[10], (DEPTH, CONV_WIDTH, D_FF), CONV_WIDTH ** -0.5),
        'conv_b': nrm(ks[11], (DEPTH, D_FF), 0.01),
        'w_down': nrm(ks[12], (DEPTH, D_FF, D_MODEL), D_FF ** -0.5),
        'ffn_post_g': gain(ks[13], D_MODEL),
    }


def reference(x, positions, attn_pre_g, w_qkv, moba_out_g, dil_out_g, w_o, attn_post_g,
              ffn_pre_g, w_gate, w_up, conv_w, conv_b, w_down, ffn_post_g):
    B, S, _ = x.shape
    for l in range(DEPTH):
        h = rms_norm(x, attn_pre_g[l])
        qkv = h @ w_qkv[l]
        qa, ka, va, qb, kb, vb = jnp.split(qkv, QKV_SPLITS, axis=-1)
        qa = partial_rope(qa.reshape(B, S, N_HEADS_MOBA, HEAD_DIM), positions)
        ka = partial_rope(ka.reshape(B, S, N_HEADS_MOBA, HEAD_DIM), positions)
        va = va.reshape(B, S, N_HEADS_MOBA, HEAD_DIM)
        qb = partial_rope(qb.reshape(B, S, N_HEADS_DIL, HEAD_DIM), positions)
        kb = partial_rope(kb.reshape(B, S, N_HEADS_DIL, HEAD_DIM), positions)
        vb = vb.reshape(B, S, N_HEADS_DIL, HEAD_DIM)
        oa = moba_attention(qa, ka, va).astype(x.dtype).reshape(B, S, W_MOBA)
        ob = dilated_mixture(qb, kb, vb).astype(x.dtype).reshape(B, S, W_DIL)
        mix = jnp.concatenate([rms_norm(oa, moba_out_g[l]), rms_norm(ob, dil_out_g[l])], axis=-1)
        x = x + rms_norm(mix @ w_o[l], attn_post_g[l])
        h = rms_norm(x, ffn_pre_g[l])
        y = conv_glu_ffn(h, w_gate[l], w_up[l], conv_w[l], conv_b[l], w_down[l])
        x = x + rms_norm(y, ffn_post_g[l])
    return x
```

```cpp
#define OPT_P1 1
#define OPT_P2 1
#define OPT_P4 1
#define OPT_P5 1
#define OPT_P6 1
#define ONE_LAUNCH 1
#include <hip/hip_runtime.h>
#include <hip/hip_cooperative_groups.h>
#include <cstdio>
#include <cstdint>

typedef _Float16 h16;
typedef h16 h16x8 __attribute__((ext_vector_type(8)));
typedef h16 h16x2 __attribute__((ext_vector_type(2)));
typedef float f32x4 __attribute__((ext_vector_type(4)));
typedef float f32x2 __attribute__((ext_vector_type(2)));
typedef unsigned u32x4 __attribute__((ext_vector_type(4)));
#define LAS __attribute__((address_space(3)))

constexpr int BATCH = 4, SEQ = 4096, DM = 2048, M = BATCH * SEQ, NQKV = 6144, FF = 8192, HD = 128, NH = 8;
constexpr float RMS_EPS = 1e-6f;
constexpr float SCALE = 0.08838834764831845f;
constexpr size_t MiB = 1u << 20;
constexpr size_t WS_CTL = 0, WS_CS = 1 * MiB, WS_KSUM = 3 * MiB, WS_SS = 4 * MiB, WS_LSE = 6 * MiB, WS_HALO = 8 * MiB, WS_FIXP = 12 * MiB, WS_FIXU = 16 * MiB;
constexpr size_t WS_WQKV = 24 * MiB, WS_WO = 48 * MiB, WS_WGU = 56 * MiB, WS_WD = 120 * MiB;
constexpr size_t WS_XN = 152 * MiB;
constexpr size_t WS_OB0 = 152 * MiB, WS_OB1 = 184 * MiB, WS_XN2 = 152 * MiB, WS_Y2 = 152 * MiB;
constexpr size_t WS_QKV = 216 * MiB;
constexpr size_t WS_MIX = 216 * MiB, WS_Y = 280 * MiB, WS_ACT = 216 * MiB;
constexpr size_t WS_OA = 408 * MiB, WS_OB2 = 440 * MiB;
constexpr size_t WS_NSCR1 = 408 * MiB;
constexpr size_t WS_NSCR4 = 344 * MiB;
constexpr size_t WS_NSCR5 = 472 * MiB;
constexpr size_t WS_NSCR6 = 24 * MiB;
constexpr size_t WS_END = 512 * MiB;

struct Ptrs {
    const float* x; const int* pos; const float* g_attn_pre; const float* w_qkv; const float* g_moba; const float* g_dil; const float* w_o;
    const float* g_attn_post; const float* g_ffn_pre; const float* w_gate; const float* w_up; const float* conv_w; const float* conv_b;
    const float* w_down; const float* g_ffn_post; float* out; unsigned char* ws;
};

__device__ __forceinline__ unsigned pk2h(float lo, float hi) { f32x2 v = {lo, hi}; h16x2 b = __builtin_convertvector(v, h16x2); return __builtin_bit_cast(unsigned, b); }
__device__ __forceinline__ float wave_sum(float v) {
#pragma unroll
    for (int o = 1; o < 64; o <<= 1) v += __shfl_xor(v, o);
    return v;
}
__device__ __forceinline__ float gelu_tanh(float x) {
    const float t = x * x;
    const float z2 = x * (1.5957691216057308f + 0.07135481627f * t);
    const float e = __builtin_amdgcn_exp2f(-z2 * 1.4426950408889634f);
    return x * __builtin_amdgcn_rcpf(1.0f + e);
}

__device__ __forceinline__ void p0_transpose_item(const float* W, int K, int N, h16* WT, int k0, int n0, int dest_row0, LAS float* scr, int lane) {
#pragma unroll 8
    for (int i = 0; i < 32; ++i) { const int kk = 2 * i + (lane >> 5); scr[kk * 33 + (lane & 31)] = W[(size_t)(k0 + kk) * N + n0 + (lane & 31)]; }
    asm volatile("s_waitcnt lgkmcnt(0)" ::: "memory");
    const int c = lane & 7;
#pragma unroll
    for (int j = 0; j < 4; ++j) { const int n = (lane >> 3) + 8 * j; const LAS float* s = scr + (8 * c) * 33 + n;
        u32x4 o; o.x = pk2h(s[0 * 33], s[1 * 33]); o.y = pk2h(s[2 * 33], s[3 * 33]); o.z = pk2h(s[4 * 33], s[5 * 33]); o.w = pk2h(s[6 * 33], s[7 * 33]);
        *(u32x4*)(WT + (size_t)(dest_row0 + n) * K + k0 + 8 * c) = o; }
    asm volatile("s_waitcnt lgkmcnt(0)" ::: "memory");
}
__device__ __forceinline__ void rms_row_to_h16(const float* xrow, const float* g, h16* orow, int lane) {
    f32x4 v[4][2]; float s = 0.f;
#pragma unroll
    for (int j = 0; j < 4; ++j) { const int c = (lane + 64 * j) * 8; v[j][0] = *(const f32x4*)(xrow + c); v[j][1] = *(const f32x4*)(xrow + c + 4);
#pragma unroll
        for (int q = 0; q < 2; ++q) s += (v[j][q].x * v[j][q].x + v[j][q].y * v[j][q].y) + (v[j][q].z * v[j][q].z + v[j][q].w * v[j][q].w); }
    const float rstd = 1.0f / sqrtf(wave_sum(s) * (1.0f / DM) + RMS_EPS);
#pragma unroll
    for (int j = 0; j < 4; ++j) { const int c = (lane + 64 * j) * 8; const f32x4 g0 = *(const f32x4*)(g + c), g1 = *(const f32x4*)(g + c + 4);
        u32x4 o; o.x = pk2h(v[j][0].x * rstd * g0.x, v[j][0].y * rstd * g0.y); o.y = pk2h(v[j][0].z * rstd * g0.z, v[j][0].w * rstd * g0.w);
        o.z = pk2h(v[j][1].x * rstd * g1.x, v[j][1].y * rstd * g1.y); o.w = pk2h(v[j][1].z * rstd * g1.z, v[j][1].w * rstd * g1.w);
        *(u32x4*)(orow + c) = o; }
}
constexpr int I_QKV = (DM / 64) * (NQKV / 32), I_O = (DM / 64) * (DM / 32), I_G = (DM / 64) * (FF / 32), I_D = (FF / 64) * (DM / 32);
constexpr int P0_ITEMS = I_QKV + I_O + 2 * I_G + I_D;
__device__ __forceinline__ void p0_prologue(const Ptrs& P, LAS float* scr  , int gw, int NGW, int lane) {
    h16* WQKV = (h16*)(P.ws + WS_WQKV); h16* WO = (h16*)(P.ws + WS_WO); h16* WGU = (h16*)(P.ws + WS_WGU); h16* WD = (h16*)(P.ws + WS_WD);
    for (int it = gw; it < P0_ITEMS; it += NGW) {
        int r = it;
        if (r < I_QKV) { const int nb = NQKV / 32, kb = r / nb, n0 = (r % nb) * 32; p0_transpose_item(P.w_qkv, DM, NQKV, WQKV, kb * 64, n0, n0, scr, lane); continue; } r -= I_QKV;
        if (r < I_O) { const int nb = DM / 32, kb = r / nb, n0 = (r % nb) * 32; p0_transpose_item(P.w_o, DM, DM, WO, kb * 64, n0, n0, scr, lane); continue; } r -= I_O;
        if (r < I_G) { const int nb = FF / 32, kb = r / nb, n0 = (r % nb) * 32; p0_transpose_item(P.w_gate, DM, FF, WGU, kb * 64, n0, (n0 / 128) * 256 + (n0 % 128), scr, lane); continue; } r -= I_G;
        if (r < I_G) { const int nb = FF / 32, kb = r / nb, n0 = (r % nb) * 32; p0_transpose_item(P.w_up, DM, FF, WGU, kb * 64, n0, (n0 / 128) * 256 + 128 + (n0 % 128), scr, lane); continue; } r -= I_G;
        { const int nb = DM / 32, kb = r / nb, n0 = (r % nb) * 32; p0_transpose_item(P.w_down, FF, DM, WD, kb * 64, n0, n0, scr, lane); }
    }
    h16* XN = (h16*)(P.ws + WS_XN);
    for (int m = gw; m < M; m += NGW) rms_row_to_h16(P.x + (size_t)m * DM, P.g_attn_pre, XN + (size_t)m * DM, lane);
    f32x2* CS = (f32x2*)(P.ws + WS_CS);
    for (int e = gw * 64 + lane; e < M * 16; e += NGW * 64) { const int m = e >> 4, i = e & 15;
        const float inv_freq = powf(500000.0f, -(float)i / 16.0f); const float ang = (float)P.pos[m] * inv_freq;
        float sn, cs; sincosf(ang, &sn, &cs); CS[e] = (f32x2){cs, sn}; }
}

__device__ __forceinline__ void p3_row(const Ptrs& P, int m, int lane) {
    const h16* OA = (const h16*)(P.ws + WS_OA) + (size_t)m * 1024;
    const h16* OB[3] = {(const h16*)(P.ws + WS_OB0) + (size_t)m * 1024, (const h16*)(P.ws + WS_OB1) + (size_t)m * 1024, (const h16*)(P.ws + WS_OB2) + (size_t)m * 1024};
    const float* LSE = (const float*)(P.ws + WS_LSE);
    h16* MIX = (h16*)(P.ws + WS_MIX) + (size_t)m * DM;
    {   float v[2][8]; float s = 0.f;
#pragma unroll
        for (int j = 0; j < 2; ++j) { const h16x8 a = *(const h16x8*)(OA + (lane + 64 * j) * 8);
#pragma unroll
            for (int e = 0; e < 8; ++e) { v[j][e] = (float)a[e]; s += v[j][e] * v[j][e]; } }
        const float rstd = 1.0f / sqrtf(wave_sum(s) * (1.0f / 1024.0f) + RMS_EPS);
#pragma unroll
        for (int j = 0; j < 2; ++j) { const int c = (lane + 64 * j) * 8; const f32x4 g0 = *(const f32x4*)(P.g_moba + c), g1 = *(const f32x4*)(P.g_moba + c + 4);
            u32x4 o; o.x = pk2h(v[j][0] * rstd * g0.x, v[j][1] * rstd * g0.y); o.y = pk2h(v[j][2] * rstd * g0.z, v[j][3] * rstd * g0.w);
            o.z = pk2h(v[j][4] * rstd * g1.x, v[j][5] * rstd * g1.y); o.w = pk2h(v[j][6] * rstd * g1.z, v[j][7] * rstd * g1.w);
            *(u32x4*)(MIX + c) = o; } }
    {   float v[2][8]; float s = 0.f;
#pragma unroll
        for (int j = 0; j < 2; ++j) { const int hh = (lane >> 4) + 4 * j;
            const float l0 = LSE[((size_t)0 * M + m) * 8 + hh], l1 = LSE[((size_t)1 * M + m) * 8 + hh], l2 = LSE[((size_t)2 * M + m) * 8 + hh];
            const float mx = fmaxf(l0, fmaxf(l1, l2)); const float e0 = __expf(l0 - mx), e1 = __expf(l1 - mx), e2 = __expf(l2 - mx); const float inv = 1.0f / (e0 + e1 + e2);
            const float w0 = e0 * inv, w1 = e1 * inv, w2 = e2 * inv;
            const h16x8 a0 = *(const h16x8*)(OB[0] + (lane + 64 * j) * 8), a1 = *(const h16x8*)(OB[1] + (lane + 64 * j) * 8), a2 = *(const h16x8*)(OB[2] + (lane + 64 * j) * 8);
#pragma unroll
            for (int e = 0; e < 8; ++e) { v[j][e] = w0 * (float)a0[e] + w1 * (float)a1[e] + w2 * (float)a2[e]; s += v[j][e] * v[j][e]; } }
        const float rstd = 1.0f / sqrtf(wave_sum(s) * (1.0f / 1024.0f) + RMS_EPS);
#pragma unroll
        for (int j = 0; j < 2; ++j) { const int c = (lane + 64 * j) * 8; const f32x4 g0 = *(const f32x4*)(P.g_dil + c), g1 = *(const f32x4*)(P.g_dil + c + 4);
            u32x4 o; o.x = pk2h(v[j][0] * rstd * g0.x, v[j][1] * rstd * g0.y); o.y = pk2h(v[j][2] * rstd * g0.z, v[j][3] * rstd * g0.w);
            o.z = pk2h(v[j][4] * rstd * g1.x, v[j][5] * rstd * g1.y); o.w = pk2h(v[j][6] * rstd * g1.z, v[j][7] * rstd * g1.w);
            *(u32x4*)(MIX + 1024 + c) = o; } }
}
template <bool NEXT>
__device__ __forceinline__ void resid_row(const float* base, const h16* y, const float* ss, const float* gpost, const float* gnext, float* out, h16* xn2, int lane) {
    const float part = (lane < 32) ? ss[lane] : 0.f;
    const float rstd_y = 1.0f / sqrtf(wave_sum(part) * (1.0f / DM) + RMS_EPS);
    f32x4 v[4][2]; float s = 0.f;
#pragma unroll
    for (int j = 0; j < 4; ++j) { const int c = (lane + 64 * j) * 8; const h16x8 yy = *(const h16x8*)(y + c);
#pragma unroll
        for (int q = 0; q < 2; ++q) { const f32x4 b = *(const f32x4*)(base + c + 4 * q), g = *(const f32x4*)(gpost + c + 4 * q);
            f32x4 o; o.x = b.x + (float)yy[4 * q + 0] * rstd_y * g.x; o.y = b.y + (float)yy[4 * q + 1] * rstd_y * g.y; o.z = b.z + (float)yy[4 * q + 2] * rstd_y * g.z; o.w = b.w + (float)yy[4 * q + 3] * rstd_y * g.w;
            v[j][q] = o; s += (o.x * o.x + o.y * o.y) + (o.z * o.z + o.w * o.w); *(f32x4*)(out + c + 4 * q) = o; } }
    if (NEXT) { const float rstd = 1.0f / sqrtf(wave_sum(s) * (1.0f / DM) + RMS_EPS);
#pragma unroll
        for (int j = 0; j < 4; ++j) { const int c = (lane + 64 * j) * 8; const f32x4 g0 = *(const f32x4*)(gnext + c), g1 = *(const f32x4*)(gnext + c + 4);
            u32x4 o; o.x = pk2h(v[j][0].x * rstd * g0.x, v[j][0].y * rstd * g0.y); o.y = pk2h(v[j][0].z * rstd * g0.z, v[j][0].w * rstd * g0.w);
            o.z = pk2h(v[j][1].x * rstd * g1.x, v[j][1].y * rstd * g1.y); o.w = pk2h(v[j][1].z * rstd * g1.z, v[j][1].w * rstd * g1.w);
            *(u32x4*)(xn2 + c) = o; } }
}

__global__ __launch_bounds__(256) void k_p0(Ptrs P) {
    __shared__ float scr_all[4 * 64 * 33];
    const int lane = threadIdx.x & 63, wave = threadIdx.x >> 6;
    p0_prologue(P, (LAS float*)scr_all + wave * 64 * 33, blockIdx.x * 4 + wave, gridDim.x * 4, lane);
}
__global__ __launch_bounds__(512) void k_p3(Ptrs P) {
    const int lane = threadIdx.x & 63, gw = blockIdx.x * 8 + (threadIdx.x >> 6), NGW = gridDim.x * 8;
    for (int m = gw; m < M; m += NGW) p3_row(P, m, lane);
}
__global__ __launch_bounds__(512) void k_p4b(Ptrs P) {
    const int lane = threadIdx.x & 63, gw = blockIdx.x * 8 + (threadIdx.x >> 6), NGW = gridDim.x * 8;
    for (int m = gw; m < M; m += NGW)
        resid_row<true>(P.x + (size_t)m * DM, (const h16*)(P.ws + WS_Y) + (size_t)m * DM, (const float*)(P.ws + WS_SS) + (size_t)m * 32, P.g_attn_post, P.g_ffn_pre,
                        P.out + (size_t)m * DM, (h16*)(P.ws + WS_XN2) + (size_t)m * DM, lane);
}
__global__ __launch_bounds__(512) void k_p6b(Ptrs P) {
    const int lane = threadIdx.x & 63, gw = blockIdx.x * 8 + (threadIdx.x >> 6), NGW = gridDim.x * 8;
    for (int m = gw; m < M; m += NGW)
        resid_row<false>(P.out + (size_t)m * DM, (const h16*)(P.ws + WS_Y2) + (size_t)m * DM, (const float*)(P.ws + WS_SS) + (size_t)m * 32, P.g_ffn_post, nullptr,
                         P.out + (size_t)m * DM, nullptr, lane);
}

__global__ __launch_bounds__(256) void nv_gemm(const h16* A, int lda, const h16* Bt, int ldb, float* C, int ldc, int K) {
    __shared__ float As[32][65]; __shared__ float Bs[32][65];
    const int t = threadIdx.x, m0 = blockIdx.y * 64, n0 = blockIdx.x * 64, lr = t >> 2, lk = (t & 3) * 8, ty = t >> 4, tx = t & 15;
    float acc[4][4];
#pragma unroll
    for (int i = 0; i < 4; ++i)
#pragma unroll
        for (int j = 0; j < 4; ++j) acc[i][j] = 0.f;
    for (int k0 = 0; k0 < K; k0 += 32) {
        const h16x8 a = *(const h16x8*)(A + (size_t)(m0 + lr) * lda + k0 + lk);
        const h16x8 b = *(const h16x8*)(Bt + (size_t)(n0 + lr) * ldb + k0 + lk);
#pragma unroll
        for (int e = 0; e < 8; ++e) { As[lk + e][lr] = (float)a[e]; Bs[lk + e][lr] = (float)b[e]; }
        __syncthreads();
#pragma unroll 8
        for (int kk = 0; kk < 32; ++kk) {
            float av[4], bv[4];
#pragma unroll
            for (int i = 0; i < 4; ++i) { av[i] = As[kk][ty * 4 + i]; bv[i] = Bs[kk][tx * 4 + i]; }
#pragma unroll
            for (int i = 0; i < 4; ++i)
#pragma unroll
                for (int j = 0; j < 4; ++j) acc[i][j] = fmaf(av[i], bv[j], acc[i][j]);
        }
        __syncthreads();
    }
#pragma unroll
    for (int i = 0; i < 4; ++i) { f32x4 o = {acc[i][0], acc[i][1], acc[i][2], acc[i][3]}; *(f32x4*)(C + (size_t)(m0 + ty * 4 + i) * ldc + n0 + tx * 4) = o; }
}
__global__ __launch_bounds__(256) void nv_rope(const float* C, h16* QKV, const f32x2* CS, int chunk) {
    const size_t e = (size_t)blockIdx.x * 256 + threadIdx.x; const int m = (int)(e >> 10), j = (int)(e & 1023), d = j & 127;
    float v = C[e];
    if ((chunk % 3) != 2 && d < 32) {
        const int i = d & 15; const f32x2 cs = CS[(size_t)m * 16 + i];
        if (d < 16) v = v * cs.x - C[e + 16] * cs.y; else v = v * cs.x + C[e - 16] * cs.y;
    }
    QKV[(size_t)m * NQKV + chunk * 1024 + j] = (h16)v;
}
__global__ __launch_bounds__(256) void nv_ksum(const h16* QKV, float* KSUM) {
    const int e = blockIdx.x * 256 + threadIdx.x; const int pm = e >> 10, c = e & 1023;
    float s = 0.f;
    for (int r = 0; r < 256; ++r) s += (float)QKV[(size_t)(pm * 256 + r) * NQKV + 1024 + c];
    KSUM[(size_t)(pm * 2 + 0) * 1024 + c] = s; KSUM[(size_t)(pm * 2 + 1) * 1024 + c] = 0.f;
}
__global__ __launch_bounds__(256) void nv_cvt_ss(const float* C, int ncols, h16* Y, int col0, float* SS) {
    const int lane = threadIdx.x & 63; const size_t w = (size_t)blockIdx.x * 4 + (threadIdx.x >> 6); const int nslot = ncols / 64; const int m = (int)(w / nslot), s = (int)(w % nslot);
    const float v = C[(size_t)m * ncols + s * 64 + lane];
    Y[(size_t)m * DM + col0 + s * 64 + lane] = (h16)v;
    const float q = wave_sum(v * v);
    if (lane == 0) SS[(size_t)m * 32 + col0 / 64 + s] = q;
}
__global__ __launch_bounds__(256) void nv_conv(const float* C, h16* ACT, const float* conv_w, const float* conv_b, int g0) {
    const size_t e = (size_t)blockIdx.x * 256 + threadIdx.x; const int m = (int)(e >> 8), jj = (int)(e & 255), gi = jj >> 7, j = jj & 127;
    const int c = 128 * (g0 + gi) + j; const int s = m & (SEQ - 1);
    const float* Cg = C + (size_t)m * 512 + gi * 256 + j;
    const float g_0 = Cg[0], g_1 = (s >= 1) ? Cg[-512] : 0.f, g_2 = (s >= 2) ? Cg[-1024] : 0.f, u = Cg[128];
    const float pre = conv_b[c] + conv_w[c] * g_2 + conv_w[FF + c] * g_1 + conv_w[2 * FF + c] * g_0;
    ACT[(size_t)m * FF + c] = (h16)(gelu_tanh(pre) * u);
}
__global__ __launch_bounds__(256) void nv_attn(const h16* QKV, const float* KSUM, h16* OA, h16* OB0, h16* OB1, h16* OB2, float* LSE, int mode) {
    __shared__ float Qs[32][129]; __shared__ float Ks[32][129]; __shared__ float Vs[32][128]; __shared__ float Ps[32][33]; __shared__ float Gs[32][16]; __shared__ unsigned Sel[32];
    const int t = threadIdx.x, u = blockIdx.x, b = u >> 10, h = (u >> 7) & 7, rem = u & 127;
    int d = 1, r = 0, i0, W; const h16 *Qp, *Kp, *Vp; h16* Op; size_t pitch, opitch;
    if (mode == 0) { i0 = rem * 32; W = 1 << 30; pitch = NQKV; opitch = 1024;
        Qp = QKV + (size_t)(b * SEQ) * NQKV + 0 + h * HD; Kp = Qp + 1024; Vp = Qp + 2048; Op = OA + (size_t)(b * SEQ) * 1024 + h * HD; }
    else { d = (mode == 1) ? 1 : (mode == 2) ? 4 : 16; const int nq = (SEQ / d) / 32; r = rem / nq; i0 = (rem % nq) * 32; W = 129; pitch = (size_t)NQKV * d; opitch = (size_t)1024 * d;
        Qp = QKV + (size_t)(b * SEQ + r) * NQKV + 3072 + h * HD; Kp = Qp + 1024; Vp = Qp + 2048;
        h16* OBm = (mode == 1) ? OB0 : (mode == 2) ? OB1 : OB2; Op = OBm + (size_t)(b * SEQ + r) * 1024 + h * HD; }
    for (int e = t; e < 32 * 128; e += 256) { const int qi = e >> 7, c = e & 127; Qs[qi][c] = (float)Qp[(size_t)(i0 + qi) * pitch + c]; }
    __syncthreads();
    const int qi = t >> 3, sub = t & 7;
    if (mode == 0) {
        const int qblk = i0 >> 8;
        for (int jj = 0; jj < 2; ++jj) { const int j = sub + 8 * jj; float g = 0.f;
            if (j < qblk) { const float* k0 = KSUM + (size_t)((b * 16 + j) * 2) * 1024 + h * HD; for (int c = 0; c < 128; ++c) g += Qs[qi][c] * (k0[c] + k0[1024 + c]) * (1.0f / 256.0f); }
            Gs[qi][j] = g; }
        __syncthreads();
        if (sub == 0) { unsigned sel = 0;
            for (int rnd = 0; rnd < 3; ++rnd) { float best = -3.0e38f; int bi = -1;
                for (int j = 0; j < 16; ++j) if (j < qblk && !((sel >> j) & 1u) && Gs[qi][j] > best) { best = Gs[qi][j]; bi = j; }
                if (bi >= 0) sel |= 1u << bi; }
            sel |= 1u << qblk; Sel[qi] = sel; }
        __syncthreads();
    }
    const unsigned selmask = (mode == 0) ? Sel[qi] : 0xffffffffu;
    float o[16];
#pragma unroll
    for (int c = 0; c < 16; ++c) o[c] = 0.f;
    float mrun = -1e30f, lrun = 0.f;
    int klo = (mode == 0) ? 0 : (i0 - 128 > 0 ? i0 - 128 : 0); klo &= ~31;
    const int khi = i0 + 32;
    const int iq = i0 + qi;
    for (int k0 = klo; k0 < khi; k0 += 32) {
        __syncthreads();
        for (int e = t; e < 32 * 128; e += 256) { const int kk = e >> 7, c = e & 127; Ks[kk][c] = (float)Kp[(size_t)(k0 + kk) * pitch + c]; Vs[kk][c] = (float)Vp[(size_t)(k0 + kk) * pitch + c]; }
        __syncthreads();
        float sc[4]; float tmax = -1e30f;
#pragma unroll
        for (int j = 0; j < 4; ++j) { const int kk = sub * 4 + j, kidx = k0 + kk; float a = 0.f;
            for (int c = 0; c < 128; ++c) a += Qs[qi][c] * Ks[kk][c];
            a *= SCALE;
            bool ok = (kidx <= iq) && (iq - kidx < W);
            if (mode == 0) ok = ok && ((selmask >> (kidx >> 8)) & 1u);
            sc[j] = ok ? a : -INFINITY; tmax = fmaxf(tmax, sc[j]); }
        tmax = fmaxf(tmax, __shfl_xor(tmax, 1)); tmax = fmaxf(tmax, __shfl_xor(tmax, 2)); tmax = fmaxf(tmax, __shfl_xor(tmax, 4));
        const float mnew = fmaxf(mrun, tmax); const float alpha = __expf(mrun - mnew);
        float ps = 0.f;
#pragma unroll
        for (int j = 0; j < 4; ++j) { const float p = __expf(sc[j] - mnew); Ps[qi][sub * 4 + j] = p; ps += p; }
        ps += __shfl_xor(ps, 1); ps += __shfl_xor(ps, 2); ps += __shfl_xor(ps, 4);
        lrun = lrun * alpha + ps; mrun = mnew;
        __syncthreads();
#pragma unroll
        for (int c = 0; c < 16; ++c) o[c] *= alpha;
        for (int kk = 0; kk < 32; ++kk) { const float p = Ps[qi][kk];
#pragma unroll
            for (int c = 0; c < 16; ++c) o[c] = fmaf(p, Vs[kk][sub * 16 + c], o[c]); }
    }
    const float inv = 1.0f / lrun;
#pragma unroll
    for (int c = 0; c < 16; ++c) Op[(size_t)(i0 + qi) * opitch + sub * 16 + c] = (h16)(o[c] * inv);
    if (mode != 0 && sub == 0) LSE[((size_t)(mode - 1) * M + (size_t)(b * SEQ + r + d * (i0 + qi))) * 8 + h] = mrun + __logf(lrun);
}

namespace pg8 {
#define PG8_LAS __attribute__((address_space(3)))
constexpr int BM = 256, BK = 64, HALF = 128, HTB = HALF * BK * 2, STAGE_BYTES = 8 * HTB, NXCD = 8, WGM = 8;
__host__ __device__ __forceinline__ int lds_byte(int r, int c) { const int st = (r >> 4) * 2 + (c >> 5), rr = r & 15, cc = c & 31, ob = rr * 64 + cc * 2; return st * 1024 + (ob ^ (((ob >> 9) & 1) << 5)); }
__host__ __device__ __forceinline__ void stage_rc(int b, int& R, int& C) { const int st = b / 1024, sb = b % 1024, swz = sb ^ (((sb >> 9) & 1) << 5); R = (st >> 1) * 16 + swz / 64; C = (st & 1) * 32 + (swz % 64) / 2; }
__host__ __device__ __forceinline__ int perm32(int rho) { const int n = rho >> 4, i = rho & 15; return 8 * (i >> 2) + 4 * n + (i & 3); }
struct Unit { int pm, pn; };
struct Gemm { const h16* A; const h16* Bt; int M, N, K; };
struct StaticOrder {
    int nM, nN, nwg, G, c;
    __host__ __device__ void init(int M_, int N_, int G_, int c_) { nM = M_ / BM; nN = N_ / BM; nwg = nM * nN; G = G_; c = c_; }
    __host__ __device__ bool next(int i, Unit& u) const {
        const long L = (long)i * G + c; if (L >= nwg) return false;
        int wgid = (int)L; { const int q = nwg / NXCD, r = nwg % NXCD, xcd = wgid % NXCD, off = wgid / NXCD; wgid = (xcd < r ? xcd * (q + 1) : r * (q + 1) + (xcd - r) * q) + off; }
        const int nig = WGM * nN, gid = wgid / nig, fm = gid * WGM, gsz = (nM - fm) < WGM ? (nM - fm) : WGM;
        u.pm = fm + ((wgid % nig) % gsz); u.pn = (wgid % nig) / gsz; return true;
    }
};
typedef f32x4 Acc[2][2][4][2];

__device__ __forceinline__ u32x4 pack8h(f32x4 v0, f32x4 v1) { u32x4 w; w.x = pk2h(v0[0], v0[1]); w.y = pk2h(v0[2], v0[3]); w.z = pk2h(v1[0], v1[1]); w.w = pk2h(v1[2], v1[3]); return w; }

struct EpiQKV {
    h16* O; const f32x2* CS; float* KSUM;
    __device__ __forceinline__ void operator()(Acc& acc, const Unit& u, int wr, int wc, int fr, int fq, PG8_LAS unsigned char* xlds) const {
        const int grp6 = u.pn >> 2, kind = grp6 % 3;
        const int row0 = u.pm * BM + wr * 64 + fr;
        if (kind != 2 && wc == 0) {
            const float sgn = (fq < 2) ? -1.f : 1.f;
#pragma unroll
            for (int ai = 0; ai < 2; ++ai)
#pragma unroll
                for (int m = 0; m < 4; ++m) {
                    const f32x4* cp = (const f32x4*)(CS + (size_t)(row0 + ai * HALF + m * 16) * 16 + 8 * (fq & 1));
                    const f32x4 c0 = cp[0], c1 = cp[1], c2 = cp[2], c3 = cp[3];
                    const float cs[8] = {c0[0], c0[2], c1[0], c1[2], c2[0], c2[2], c3[0], c3[2]}, sn[8] = {c0[1], c0[3], c1[1], c1[3], c2[1], c2[3], c3[1], c3[3]};
#pragma unroll
                    for (int bj = 0; bj < 2; ++bj)
#pragma unroll
                        for (int n = 0; n < 2; ++n)
#pragma unroll
                            for (int e = 0; e < 4; ++e) { const float v = acc[ai][bj][m][n][e]; const float o = __shfl_xor(v, 32);
                                acc[ai][bj][m][n][e] = v * cs[4 * n + e] + sgn * o * sn[4 * n + e]; }
                }
        }
        if (grp6 == 1) {
#pragma unroll
            for (int bj = 0; bj < 2; ++bj)
#pragma unroll
                for (int n = 0; n < 2; ++n) { f32x4 s = {0.f, 0.f, 0.f, 0.f};
#pragma unroll
                    for (int ai = 0; ai < 2; ++ai)
#pragma unroll
                        for (int m = 0; m < 4; ++m) s += acc[ai][bj][m][n];
#pragma unroll
                    for (int e = 0; e < 4; ++e) { float t = s[e]; t += __shfl_xor(t, 1); t += __shfl_xor(t, 2); t += __shfl_xor(t, 4); t += __shfl_xor(t, 8); s[e] = t; }
                    if (fr == 0) *(f32x4*)(KSUM + (size_t)(u.pm * 2 + wr) * 1024 + (u.pn - 4) * 256 + bj * HALF + wc * 32 + 8 * fq + 4 * n) = s; }
        }
        const int col0 = u.pn * BM + wc * 32 + 8 * fq;
#pragma unroll
        for (int ai = 0; ai < 2; ++ai)
#pragma unroll
            for (int m = 0; m < 4; ++m) { h16* rowp = O + (size_t)(row0 + ai * HALF + m * 16) * NQKV + col0;
#pragma unroll
                for (int bj = 0; bj < 2; ++bj) *(u32x4*)(rowp + bj * HALF) = pack8h(acc[ai][bj][m][0], acc[ai][bj][m][1]); }
    }
};
struct EpiY {
    h16* O; float* SS;
    __device__ __forceinline__ void operator()(Acc& acc, const Unit& u, int wr, int wc, int fr, int fq, PG8_LAS unsigned char* xlds) const {
        const int row0 = u.pm * BM + wr * 64 + fr, col0 = u.pn * BM + wc * 32 + 8 * fq;
#pragma unroll
        for (int ai = 0; ai < 2; ++ai)
#pragma unroll
            for (int m = 0; m < 4; ++m) { const int row = row0 + ai * HALF + m * 16; h16* rowp = O + (size_t)row * DM + col0; float q = 0.f;
#pragma unroll
                for (int bj = 0; bj < 2; ++bj) { const f32x4 v0 = acc[ai][bj][m][0], v1 = acc[ai][bj][m][1];
                    q += (v0[0] * v0[0] + v0[1] * v0[1]) + (v0[2] * v0[2] + v0[3] * v0[3]) + (v1[0] * v1[0] + v1[1] * v1[1]) + (v1[2] * v1[2] + v1[3] * v1[3]);
                    *(u32x4*)(rowp + bj * HALF) = pack8h(v0, v1); }
                q += __shfl_xor(q, 16); q += __shfl_xor(q, 32);
                if (fq == 0) SS[(size_t)row * 32 + u.pn * 4 + wc] = q; }
    }
};
template <int CTRL> __device__ __forceinline__ float dpp_mov(float old, float src) {
    return __builtin_bit_cast(float, __builtin_amdgcn_update_dpp(__builtin_bit_cast(int, old), __builtin_bit_cast(int, src), CTRL, 0xF, 0xF, false)); }
struct EpiGU {
    h16* ACT; const float* conv_w; const float* conv_b; float* HALO; float* FIXP; float* FIXU;
    __device__ __forceinline__ void operator()(Acc& acc, const Unit& u, int wr, int wc, int fr, int fq, PG8_LAS unsigned char* xlds) const {
        PG8_LAS float* xb = (PG8_LAS float*)xlds;
        const int c0 = u.pn * HALF + wc * 32 + 8 * fq;
        if (fr >= 14) {
#pragma unroll
            for (int ai = 0; ai < 2; ++ai) { PG8_LAS float* d = xb + ((((ai * 2 + wr) * 4 + wc) * 4 + fq) * 2 + (fr - 14)) * 8;
                *(PG8_LAS f32x4*)d = acc[ai][0][3][0]; *(PG8_LAS f32x4*)(d + 4) = acc[ai][0][3][1]; }
            if (wr == 1) { float* hp = HALO + ((size_t)(u.pm * 2 + (fr - 14))) * FF + c0;
                *(f32x4*)hp = acc[1][0][3][0]; *(f32x4*)(hp + 4) = acc[1][0][3][1]; }
        }
        asm volatile("s_waitcnt lgkmcnt(0)" ::: "memory"); __builtin_amdgcn_s_barrier(); asm volatile("" ::: "memory");
        f32x4 w0[2], w1[2], w2[2], bb[2];
#pragma unroll
        for (int n = 0; n < 2; ++n) { w0[n] = *(const f32x4*)(conv_w + c0 + 4 * n); w1[n] = *(const f32x4*)(conv_w + FF + c0 + 4 * n); w2[n] = *(const f32x4*)(conv_w + 2 * FF + c0 + 4 * n); bb[n] = *(const f32x4*)(conv_b + c0 + 4 * n); }
#pragma unroll
        for (int ai = 0; ai < 2; ++ai) {
            f32x4 pv[2];
            if (ai == 0 && wr == 0) { pv[0] = (f32x4){0.f, 0.f, 0.f, 0.f}; pv[1] = pv[0]; }
            else { const int sg = (wr == 1) ? (ai * 2 + 0) : (0 * 2 + 1);
                const PG8_LAS float* s = xb + (((sg * 4 + wc) * 4 + fq) * 2 + (fr & 1)) * 8;
                pv[0] = *(const PG8_LAS f32x4*)s; pv[1] = *(const PG8_LAS f32x4*)(s + 4); }
#pragma unroll
            for (int m = 0; m < 4; ++m) {
                const int row = u.pm * BM + ai * HALF + wr * 64 + m * 16 + fr;
                f32x4 o[2];
#pragma unroll
                for (int n = 0; n < 2; ++n)
#pragma unroll
                    for (int e = 0; e < 4; ++e) { const float g = acc[ai][0][m][n][e], pg = pv[n][e];
                        const float p1 = dpp_mov<0x111>(dpp_mov<0x121>(0.f, pg), g);
                        const float p2 = dpp_mov<0x112>(dpp_mov<0x122>(0.f, pg), g);
                        const float pre = bb[n][e] + w0[n][e] * p2 + w1[n][e] * p1 + w2[n][e] * g;
                        o[n][e] = pre; }
                if (ai == 0 && wr == 0 && m == 0 && fr < 2) { float* fp = FIXP + ((size_t)(u.pm * 2 + fr)) * FF + c0; float* fu = FIXU + ((size_t)(u.pm * 2 + fr)) * FF + c0;
                    *(f32x4*)fp = o[0]; *(f32x4*)(fp + 4) = o[1]; *(f32x4*)fu = acc[0][1][0][0]; *(f32x4*)(fu + 4) = acc[0][1][0][1]; }
#pragma unroll
                for (int n = 0; n < 2; ++n)
#pragma unroll
                    for (int e = 0; e < 4; ++e) o[n][e] = gelu_tanh(o[n][e]) * acc[ai][1][m][n][e];
                *(u32x4*)(ACT + (size_t)row * FF + c0) = pack8h(o[0], o[1]);
                pv[0] = acc[ai][0][m][0]; pv[1] = acc[ai][0][m][1];
            }
        }
    }
};

template <class Epi, class Sched>
__device__ __forceinline__ void gemm_phase(PG8_LAS unsigned char* lds, PG8_LAS unsigned char* xlds, const Gemm g, const Sched& S, const Epi& E) {
    const int tid = threadIdx.x, wid = __builtin_amdgcn_readfirstlane(tid >> 6), lane = tid & 63, wr = wid >> 2, wc = wid & 3, fr = lane & 15, fq = lane >> 4;
    const int K = g.K, nt = K / BK;
    unsigned voffA[2], voffB[2];
#pragma unroll
    for (int i = 0; i < 2; ++i) { int R, C; stage_rc(tid * 16 + i * 8192, R, C); const int Rb = (R & ~31) + perm32(R & 31);
        voffA[i] = (unsigned)(R * K + C) * 2u; voffB[i] = (unsigned)(Rb * K + C) * 2u; }
    const size_t kstep = (size_t)(BK * 2);
    const size_t hstep = (size_t)HALF * K * 2;
    const size_t tstep = 2 * hstep;
    const unsigned ldsw = (unsigned)wid * 1024u;
    const int aoff = lds_byte(wr * 64 + fr, fq * 8), boff = lds_byte(wc * 32 + fr, fq * 8);
#define PG8_SA(b, h) (((b) * 2 + (h)) * HTB)
#define PG8_SB(b, h) ((4 + (b) * 2 + (h)) * HTB)
#define PG8_STAGE(bufoff, gbase, voff) do { _Pragma("unroll") for (int _i = 0; _i < 2; ++_i) \
        __builtin_amdgcn_global_load_lds((const unsigned*)((const char*)(gbase) + (voff)[_i]), (PG8_LAS unsigned*)(lds + (bufoff) + ldsw + _i * 8192), 16, 0, 0); } while (0)
#define PG8_LDA(dst, b, h) do { _Pragma("unroll") for (int m = 0; m < 4; ++m) _Pragma("unroll") for (int k = 0; k < 2; ++k) dst[m][k] = *(const PG8_LAS h16x8*)(lds + PG8_SA(b, h) + aoff + m * 2048 + k * 1024); } while (0)
#define PG8_LDB(dst, b, h) do { _Pragma("unroll") for (int n = 0; n < 2; ++n) _Pragma("unroll") for (int k = 0; k < 2; ++k) dst[n][k] = *(const PG8_LAS h16x8*)(lds + PG8_SB(b, h) + boff + n * 2048 + k * 1024); } while (0)
#define PG8_MMA(ai, bj, At, Bt) do { __builtin_amdgcn_s_setprio(1); _Pragma("unroll") for (int m = 0; m < 4; ++m) _Pragma("unroll") for (int n = 0; n < 2; ++n) _Pragma("unroll") for (int k = 0; k < 2; ++k) \
        acc[ai][bj][m][n] = __builtin_amdgcn_mfma_f32_16x16x32_f16(Bt[n][k], At[m][k], acc[ai][bj][m][n], 0, 0, 0); __builtin_amdgcn_s_setprio(0); } while (0)
#define PG8_WAIT_V(n) asm volatile("s_waitcnt vmcnt(" #n ")" ::: "memory")
#define PG8_WAIT_L(n) asm volatile("s_waitcnt lgkmcnt(" #n ")" ::: "memory")
#define PG8_BAR __builtin_amdgcn_s_barrier()
#define PG8_SCHED __builtin_amdgcn_sched_barrier(0)
    Unit cur, nxt; int ui = 0;
    if (!S.next(0, cur)) return;
    Acc acc;
#pragma unroll
    for (int a = 0; a < 2; ++a)
#pragma unroll
        for (int b = 0; b < 2; ++b)
#pragma unroll
            for (int m = 0; m < 4; ++m)
#pragma unroll
                for (int n = 0; n < 2; ++n) acc[a][b][m][n] = (f32x4){0.f, 0.f, 0.f, 0.f};
    h16x8 At[4][2], B0[2][2], B1[2][2];
    const char* cA = (const char*)g.A + (size_t)cur.pm * tstep; const char* cB = (const char*)g.Bt + (size_t)cur.pn * tstep;
    PG8_STAGE(PG8_SB(0, 0), cB, voffB); PG8_STAGE(PG8_SB(0, 1), cB + hstep, voffB); PG8_STAGE(PG8_SA(0, 0), cA, voffA); PG8_STAGE(PG8_SA(0, 1), cA + hstep, voffA);
    if (wr == 1) PG8_BAR;
    PG8_WAIT_V(2); PG8_BAR;
    PG8_STAGE(PG8_SB(1, 0), cB + kstep, voffB); PG8_STAGE(PG8_SA(1, 0), cA + kstep, voffA); PG8_STAGE(PG8_SB(1, 1), cB + hstep + kstep, voffB);
    PG8_WAIT_V(6); PG8_BAR;
    for (;;) {
        const bool has_next = S.next(ui + 1, nxt);
        const char* nA = has_next ? (const char*)g.A + (size_t)nxt.pm * tstep : cA; const char* nB = has_next ? (const char*)g.Bt + (size_t)nxt.pn * tstep : cB;
        for (int t = 0; t < nt; t += 2) {
            const bool last = (t == nt - 2);
            const char* a1 = cA + (size_t)(t + 1) * kstep;
            const char* a2 = last ? nA : cA + (size_t)(t + 2) * kstep; const char* b2 = last ? nB : cB + (size_t)(t + 2) * kstep;
            const char* a3 = a2 + kstep; const char* b3 = b2 + kstep;
            PG8_LDB(B0, 0, 0); PG8_LDB(B1, 0, 1); PG8_SCHED; PG8_LDA(At, 0, 0); PG8_STAGE(PG8_SA(1, 1), a1 + hstep, voffA);
            PG8_WAIT_V(8); PG8_WAIT_L(0); PG8_BAR; PG8_MMA(0, 0, At, B0); PG8_MMA(0, 1, At, B1); PG8_BAR; PG8_SCHED;
            PG8_LDA(At, 0, 1); PG8_STAGE(PG8_SB(0, 0), b2, voffB); PG8_STAGE(PG8_SB(0, 1), b2 + hstep, voffB); PG8_STAGE(PG8_SA(0, 0), a2, voffA);
            PG8_WAIT_V(8); PG8_WAIT_L(0); PG8_BAR; PG8_MMA(1, 0, At, B0); PG8_MMA(1, 1, At, B1); PG8_BAR; PG8_SCHED;
            PG8_LDB(B0, 1, 0); PG8_LDB(B1, 1, 1); PG8_SCHED; PG8_LDA(At, 1, 0); PG8_STAGE(PG8_SA(0, 1), a2 + hstep, voffA);
            PG8_WAIT_V(8); PG8_WAIT_L(0); PG8_BAR; PG8_MMA(0, 0, At, B0); PG8_MMA(0, 1, At, B1); PG8_BAR; PG8_SCHED;
            PG8_LDA(At, 1, 1); PG8_STAGE(PG8_SB(1, 0), b3, voffB); PG8_STAGE(PG8_SB(1, 1), b3 + hstep, voffB); PG8_STAGE(PG8_SA(1, 0), a3, voffA);
            PG8_WAIT_V(8); PG8_WAIT_L(0); PG8_BAR; PG8_MMA(1, 0, At, B0); PG8_MMA(1, 1, At, B1); PG8_BAR; PG8_SCHED;
        }
        if (wr == 0) PG8_BAR;
        E(acc, cur, wr, wc, fr, fq, xlds);
        if (!has_next) break;
#pragma unroll
        for (int a = 0; a < 2; ++a)
#pragma unroll
            for (int b = 0; b < 2; ++b)
#pragma unroll
                for (int m = 0; m < 4; ++m)
#pragma unroll
                    for (int n = 0; n < 2; ++n) acc[a][b][m][n] = (f32x4){0.f, 0.f, 0.f, 0.f};
        cur = nxt; cA = nA; cB = nB; ++ui;
        if (wr == 1) PG8_BAR;
    }
    PG8_WAIT_V(0);
    PG8_BAR;
#undef PG8_SA
#undef PG8_SB
#undef PG8_STAGE
#undef PG8_LDA
#undef PG8_LDB
#undef PG8_MMA
#undef PG8_WAIT_V
#undef PG8_WAIT_L
#undef PG8_BAR
#undef PG8_SCHED
}
}

__device__ __forceinline__ void p5b_fixup(const Ptrs& P, int gtid, int nthreads) {
    const float* HALO = (const float*)(P.ws + WS_HALO); const float* FIXP = (const float*)(P.ws + WS_FIXP); const float* FIXU = (const float*)(P.ws + WS_FIXU); h16* ACT = (h16*)(P.ws + WS_ACT);
    for (int e = gtid; e < 64 * 2 * (FF / 4); e += nthreads) {
        const int c = (e % (FF / 4)) * 4, i = (e / (FF / 4)) & 1, pm = e / (2 * (FF / 4));
        if ((pm & 15) == 0) continue;
        const f32x4 p = *(const f32x4*)(FIXP + (size_t)(pm * 2 + i) * FF + c), uu = *(const f32x4*)(FIXU + (size_t)(pm * 2 + i) * FF + c);
        const f32x4 h0 = *(const f32x4*)(HALO + (size_t)((pm - 1) * 2 + 0) * FF + c), h1 = *(const f32x4*)(HALO + (size_t)((pm - 1) * 2 + 1) * FF + c);
        const f32x4 w0 = *(const f32x4*)(P.conv_w + c), w1 = *(const f32x4*)(P.conv_w + FF + c);
        f32x4 pre;
        if (i == 0) pre = p + w0 * h0 + w1 * h1; else pre = p + w0 * h1;
        const unsigned lo = pk2h(gelu_tanh(pre[0]) * uu[0], gelu_tanh(pre[1]) * uu[1]), hi = pk2h(gelu_tanh(pre[2]) * uu[2], gelu_tanh(pre[3]) * uu[3]);
        *(unsigned long long*)(ACT + (size_t)(pm * 256 + i) * FF + c) = (unsigned long long)lo | ((unsigned long long)hi << 32);
    }
}

namespace att {
constexpr int NW = 8, QBLK = 32, KVBLK = 64, QB = NW * QBLK;
constexpr int SHM_V = KVBLK * HD * 2, SHM_K = KVBLK * HD * 2;
constexpr int LDS_BYTES = 2 * SHM_V + 2 * SHM_K + NW * 64 * 4;
constexpr float THR = 8.f;
typedef short s16x4 __attribute__((ext_vector_type(4)));
typedef short s16x8 __attribute__((ext_vector_type(8)));
typedef float f32x16 __attribute__((ext_vector_type(16)));
#define KSWZ(row, colB) ((row) * 256 + ((colB) ^ (((row) & 7) << 4)))
#define SBAR() __builtin_amdgcn_sched_barrier(0)
__device__ __forceinline__ int v_st(int k, int c) { const int kk = (k & ~0xC) | ((k & 4) << 1) | ((k & 8) >> 1); return ((kk >> 3) * 4 + (c >> 5)) * 512 + ((kk & 7) * 32 + (c & 31)) * 2; }
__device__ __forceinline__ int v_rd_base(int lane) { return ((lane & 3) << 3) | (((lane >> 2) & 3) << 6) | (((lane >> 4) & 1) << 5) | (((lane >> 5) & 1) << 8); }
constexpr int v_rd_off(int d0, int ks, int half) { return d0 * 512 + ks * 4096 + half * 2048; }
__device__ __forceinline__ int crow(int r, int hi) { return (r & 3) + 8 * (r >> 2) + 4 * hi; }
__device__ __forceinline__ h16x8 load8(const h16* p) { return *reinterpret_cast<const h16x8*>(p); }
__device__ __forceinline__ void mask_tile(f32x16& p0, f32x16& p1, int dq, unsigned W) {
    const float NEG = -__builtin_inff();
#pragma unroll
    for (int r = 0; r < 16; ++r) {
        const int c = (r & 3) + 8 * (r >> 2);
        if ((unsigned)(dq - c) >= W) p0[r] = NEG;
        if ((unsigned)(dq - c - 32) >= W) p1[r] = NEG;
    }
}
__device__ __forceinline__ void kill_tile(f32x16& p0, f32x16& p1, bool dead) {
    const float NEG = -__builtin_inff();
#pragma unroll
    for (int r = 0; r < 16; ++r) { p0[r] = dead ? NEG : p0[r]; p1[r] = dead ? NEG : p1[r]; }
}
__device__ __forceinline__ void partialSM(f32x16& p0, f32x16& p1, float& m_reg, float& mn, float& alpha) {
    float pmax = p0[0];
#pragma unroll
    for (int r = 1; r < 16; ++r) pmax = fmaxf(pmax, p0[r]);
#pragma unroll
    for (int r = 0; r < 16; ++r) pmax = fmaxf(pmax, p1[r]);
    { auto rr = __builtin_amdgcn_permlane32_swap(__float_as_uint(pmax), __float_as_uint(pmax), false, false);
      pmax = fmaxf(__uint_as_float(rr[0]), __uint_as_float(rr[1])); }
    constexpr float C2 = 1.4426950408889634f * SCALE;
    if (__builtin_expect(__all((pmax - m_reg) * SCALE <= THR), 1)) { mn = m_reg; alpha = 1.f; }
    else { mn = fmaxf(m_reg, pmax); alpha = __builtin_amdgcn_exp2f((m_reg - mn) * C2); m_reg = mn; }
    const float mnL = -mn * C2;
#pragma unroll
    for (int r = 0; r < 16; ++r) p0[r] = fmaf(p0[r], C2, mnL);
#pragma unroll
    for (int r = 0; r < 16; ++r) p1[r] = fmaf(p1[r], C2, mnL);
#pragma unroll
    for (int r = 0; r < 16; ++r) p0[r] = __builtin_amdgcn_exp2f(p0[r]);
}
__device__ __forceinline__ void finishSM(f32x16& p0, f32x16& p1, float alpha, float& l_reg, h16x8& pa0, h16x8& pa1, h16x8& pa2, h16x8& pa3) {
#pragma unroll
    for (int r = 0; r < 16; ++r) p1[r] = __builtin_amdgcn_exp2f(p1[r]);
    float ps = 0;
#pragma unroll
    for (int r = 0; r < 16; ++r) ps += p0[r];
#pragma unroll
    for (int r = 0; r < 16; ++r) ps += p1[r];
    { auto rr = __builtin_amdgcn_permlane32_swap(__float_as_uint(ps), __float_as_uint(ps), false, false);
      ps = __uint_as_float(rr[0]) + __uint_as_float(rr[1]); }
    l_reg = l_reg * alpha + ps;
#define PK4(P, B_, OUT) do { unsigned a0 = pk2h(P[B_+0], P[B_+1]), a1 = pk2h(P[B_+2], P[B_+3]);                          \
        unsigned b0 = pk2h(P[B_+4], P[B_+5]), b1 = pk2h(P[B_+6], P[B_+7]);                                             \
        auto r0 = __builtin_amdgcn_permlane32_swap(a0, b0, false, false); auto r1 = __builtin_amdgcn_permlane32_swap(a1, b1, false, false); \
        u32x4 w = {r0[0], r1[0], r0[1], r1[1]}; OUT = __builtin_bit_cast(h16x8, w); } while (0)
    PK4(p0, 0, pa0); PK4(p0, 8, pa1); PK4(p1, 0, pa2); PK4(p1, 8, pa3);
#undef PK4
}
template <int KB>
__device__ __forceinline__ void qkt(f32x16& p0, f32x16& p1, const char* K_lds, int r32, int hi, const h16x8* qr, bool act) {
    if (!act) { const float NEG = -__builtin_inff();
#pragma unroll
        for (int r = 0; r < 16; ++r) { p0[r] = NEG; p1[r] = NEG; } return; }
    p0 = f32x16{}; p1 = f32x16{};
    const char* kb[4];
#pragma unroll
    for (int dd = 0; dd < 4; ++dd) kb[dd] = K_lds + KB * SHM_K + KSWZ(r32, (dd * 16 + hi * 8) * 2);
#pragma unroll
    for (int d0 = 0; d0 < 8; ++d0) { const char* a = kb[d0 & 3] + (d0 >> 2) * 128;
        h16x8 b0 = *reinterpret_cast<const h16x8*>(a);
        h16x8 b1 = *reinterpret_cast<const h16x8*>(a + 32 * 256);
        p0 = __builtin_amdgcn_mfma_f32_32x32x16_f16(b0, qr[d0], p0, 0, 0, 0);
        p1 = __builtin_amdgcn_mfma_f32_32x32x16_f16(b1, qr[d0], p1, 0, 0, 0); }
}
template <int VB>
__device__ __forceinline__ void pv_tile(f32x16* o, int vb0, h16x8 pa0, h16x8 pa1, h16x8 pa2, h16x8 pa3, bool act) {
    if (!act) return;
#define TRRD(dst, off) asm volatile("ds_read_b64_tr_b16 %0, %1 offset:%2" : "=&v"(dst) : "v"(vb0), "i"(off) : "memory")
#define MKB(l, h) __builtin_bit_cast(h16x8, (s16x8){l[0], l[1], l[2], l[3], h[0], h[1], h[2], h[3]})
#define PV_D0(d0) do { s16x4 l0, l1, l2, l3, h0, h1, h2, h3; constexpr int b_ = VB * SHM_V + v_rd_off(d0, 0, 0); \
        TRRD(l0, b_); TRRD(h0, b_ + 2048); TRRD(l1, b_ + 4096); TRRD(h1, b_ + 6144); TRRD(l2, b_ + 8192); TRRD(h2, b_ + 10240); TRRD(l3, b_ + 12288); TRRD(h3, b_ + 14336); \
        asm volatile("s_waitcnt lgkmcnt(0)" ::: "memory"); SBAR();   \
        o[d0] = __builtin_amdgcn_mfma_f32_32x32x16_f16(pa0, MKB(l0, h0), o[d0], 0, 0, 0);   \
        o[d0] = __builtin_amdgcn_mfma_f32_32x32x16_f16(pa1, MKB(l1, h1), o[d0], 0, 0, 0);   \
        o[d0] = __builtin_amdgcn_mfma_f32_32x32x16_f16(pa2, MKB(l2, h2), o[d0], 0, 0, 0);   \
        o[d0] = __builtin_amdgcn_mfma_f32_32x32x16_f16(pa3, MKB(l3, h3), o[d0], 0, 0, 0); } while (0)
    PV_D0(0); PV_D0(1); PV_D0(2); PV_D0(3);
#undef PV_D0
#undef MKB
#undef TRRD
}

struct BlockRef { const h16* K; h16* Ob; float* LSE; const float* KS; int P0, pitch, opitch, W, lsestride, moba; };
struct Seam { h16x8 qr[8]; h16x8 st_v0, st_v1, st_k0, st_k1; };
__device__ __forceinline__ int swa_jlo(int P0, int W) { const int lowk = P0 - W + 1; return lowk > 0 ? lowk / KVBLK : 0; }
#define VMW() asm volatile("s_waitcnt vmcnt(0)" ::: "memory")
#define VMWN(n) asm volatile("s_waitcnt vmcnt(%0)" :: "i"(n) : "memory")
#define SLOAD_H(Kt, o0, o1) do { S.st_v0 = load8((Kt) + 1024 + (o0)); S.st_v1 = load8((Kt) + 1024 + (o1));              \
                         S.st_k0 = load8((Kt) + (o0)); S.st_k1 = load8((Kt) + (o1)); } while (0)
#define SWRITE_HK(bf) do { *(h16x8*)(K_lds + (bf) * SHM_K + kws) = S.st_k0; *(h16x8*)(K_lds + (bf) * SHM_K + kws + 32 * 256) = S.st_k1; } while (0)
#define SWRITE_HV(bf) do { *(h16x8*)(V_lds + (bf) * SHM_V + vst0) = S.st_v0; *(h16x8*)(V_lds + (bf) * SHM_V + vst1) = S.st_v1; } while (0)
#define SWRITE_H(bf) do { SWRITE_HV(bf); SWRITE_HK(bf); } while (0)
__device__ __forceinline__ void attn_prime(const BlockRef& cur, char* lds, Seam& S) {
    const int tid = threadIdx.x, wid = __builtin_amdgcn_readfirstlane(tid >> 6), lane = tid & 63, r32 = lane & 31, hi = lane >> 5;
    const int sr = tid >> 4, sc = (tid & 15) * 8, kws = KSWZ(sr, sc * 2); char* K_lds = lds + 2 * SHM_V;
    const int kb0 = swa_jlo(cur.P0, cur.W) * KVBLK;
    const h16* Qw = cur.K - 1024 + (size_t)(cur.P0 + wid * QBLK) * cur.pitch;
    const unsigned qo = (unsigned)(r32 * cur.pitch + hi * 8);
#pragma unroll
    for (int d0 = 0; d0 < 8; ++d0) S.qr[d0] = load8(Qw + qo + d0 * 16);
    { const unsigned o0 = (unsigned)(sr * cur.pitch + sc), o1 = o0 + 32u * (unsigned)cur.pitch; const h16* Kt = cur.K + (size_t)kb0 * cur.pitch;
      SLOAD_H(Kt, o0, o1); } VMW(); SWRITE_HK(0);
    __syncthreads();
}
__device__ __forceinline__ void attn_block(const BlockRef& cur, const BlockRef& nxt, char* lds, Seam& S) {
    const int tid = threadIdx.x, wid = __builtin_amdgcn_readfirstlane(tid >> 6), lane = tid & 63, r32 = lane & 31, hi = lane >> 5;
    const int W = cur.W;
    const int j_lo = swa_jlo(cur.P0, W);
    const int j_hi = (cur.P0 + QB - 1) / KVBLK + 1;
    const int NT = j_hi - j_lo;
    const int kbn = swa_jlo(nxt.P0, nxt.W) * KVBLK;
    const int qlo = cur.P0 + wid * QBLK, qm = qlo + r32 - 4 * hi;
    char* V_lds = lds; char* K_lds = lds + 2 * SHM_V;
    float* ws = (float*)(lds + 2 * SHM_V + 2 * SHM_K) + wid * 64; float* li_l = ws, * al_l = ws + 32;
    float m_reg = -1e30f, l_reg = 0; f32x16 o[4] = {};
    const int sr = tid >> 4, sc = (tid & 15) * 8, vst0 = v_st(sr, sc), vst1 = v_st(32 + sr, sc), kws = KSWZ(sr, sc * 2);
    const int vb0 = (int)(uintptr_t)V_lds + v_rd_base(lane);
    const h16* Kh = cur.K; const int pitch = cur.pitch;
    const unsigned so0 = (unsigned)(sr * pitch + sc), so1 = so0 + 32u * (unsigned)pitch;
#define KTILE(t) (Kh + (size_t)KBASE(t) * pitch)
    unsigned selmask = 0xffffffffu;
    if (cur.moba) {
        const int qblk = cur.P0 >> 8;
        f32x16 gacc = f32x16{};
#pragma unroll
        for (int d0 = 0; d0 < 8; ++d0) {
            f32x4 a0 = {0.f, 0.f, 0.f, 0.f}, a1 = a0;
            if (r32 < qblk) { const float* kp = cur.KS + (size_t)(r32 * 2) * 1024 + d0 * 16 + hi * 8;
                a0 = *(const f32x4*)kp + *(const f32x4*)(kp + 1024); a1 = *(const f32x4*)(kp + 4) + *(const f32x4*)(kp + 1024 + 4); }
            a0 = a0 * (1.0f / 256.0f); a1 = a1 * (1.0f / 256.0f);
            u32x4 w = {pk2h(a0[0], a0[1]), pk2h(a0[2], a0[3]), pk2h(a1[0], a1[1]), pk2h(a1[2], a1[3])};
            gacc = __builtin_amdgcn_mfma_f32_32x32x16_f16(__builtin_bit_cast(h16x8, w), S.qr[d0], gacc, 0, 0, 0);
        }
        float gb[16];
#pragma unroll
        for (int j = 0; j < 16; ++j) { const int rj = (j & 3) + 4 * (j >> 3); const float own = gacc[rj]; const float oth = __shfl_xor(own, 32);
            gb[j] = (hi == ((j >> 2) & 1)) ? own : oth; }
        unsigned sel = 0u;
#pragma unroll
        for (int rnd = 0; rnd < 3; ++rnd) { float best = -3.0e38f; int bi = -1;
#pragma unroll
            for (int j = 0; j < 15; ++j) { const bool ok = (j < qblk) && !((sel >> j) & 1u) && (gb[j] > best); best = ok ? gb[j] : best; bi = ok ? j : bi; }
            if (bi >= 0) sel |= 1u << bi; }
        selmask = sel | (1u << qblk);
    }
#define RESC(a) do { if (__any((a) < 1.f)) { if (hi == 0) al_l[r32] = (a); asm volatile("s_waitcnt lgkmcnt(0)" ::: "memory");              \
                     _Pragma("unroll") for (int d_ = 0; d_ < 4; ++d_) _Pragma("unroll") for (int r = 0; r < 16; ++r) o[d_][r] *= al_l[crow(r, hi)]; } } while (0)
#define KBASE(t) ((j_lo + (t)) * KVBLK)
#define SELB(t) (((selmask >> (KBASE(t) >> 8)) & 1u) != 0u)
#define ACT(t) (KBASE(t) <= qlo + QBLK - 1 && KBASE(t) + KVBLK - 1 >= qlo - W + 1 && (!cur.moba || __any(SELB(t))))
#define MASKT(P0_, P1_, t) do { const int kb_ = KBASE(t); if (ACT(t)) { if (kb_ + KVBLK - 1 > qlo || kb_ <= qlo + QBLK - 1 - W) mask_tile(P0_, P1_, qm - kb_, (unsigned)W); \
                                 if (cur.moba && !__all(SELB(t))) kill_tile(P0_, P1_, !SELB(t)); } } while (0)
    constexpr int NQL = 8;
#define SEAM_K0() do { VMWN(NQL); SWRITE_HK(0); SBAR(); } while (0)
    f32x16 pA0, pA1, pB0, pB1; float mnA, mnB, alA, alB; h16x8 pa0, pa1, pa2, pa3;
    SWRITE_HV(0); SBAR();
    if (NT > 1) { SLOAD_H(KTILE(1), so0, so1); }
    SBAR(); qkt<0>(pA0, pA1, K_lds, r32, hi, S.qr, ACT(0));
    MASKT(pA0, pA1, 0); partialSM(pA0, pA1, m_reg, mnA, alA);
    if (NT > 1) { VMW(); SWRITE_H(1); }
    __syncthreads();
#define HALF_STEP(PX0, PX1, mnX, alX, PY0, PY1, alY, t, KB, VB, SB) do {                                                      \
        SBAR(); qkt<KB>(PX0, PX1, K_lds, r32, hi, S.qr, ACT(t));                                             \
        finishSM(PY0, PY1, alY, l_reg, pa0, pa1, pa2, pa3); SBAR();                                                           \
        if ((t) + 1 < NT) { SLOAD_H(KTILE((t) + 1), so0, so1); SBAR(); }                                               \
        pv_tile<VB>(o, vb0, pa0, pa1, pa2, pa3, ACT((t) - 1)); MASKT(PX0, PX1, (t)); partialSM(PX0, PX1, m_reg, mnX, alX);                                        \
        __syncthreads();                                                                                                      \
        if ((t) + 1 < NT) { VMW(); SWRITE_H(SB); }                                                                          \
        RESC(alX); __syncthreads(); } while (0)
    for (int t = 1; t + 1 < NT; t += 2) {
        HALF_STEP(pB0, pB1, mnB, alB, pA0, pA1, alA, t, 1, 0, 0);
        HALF_STEP(pA0, pA1, mnA, alA, pB0, pB1, alB, t + 1, 0, 1, 1);
    }
    const bool even = (NT & 1) == 0;
    if (even) { SBAR(); qkt<1>(pB0, pB1, K_lds, r32, hi, S.qr, ACT(NT - 1)); SBAR(); }
    { const unsigned n0 = (unsigned)(sr * nxt.pitch + sc), n1 = n0 + 32u * (unsigned)nxt.pitch; const h16* Kt = nxt.K + (size_t)kbn * nxt.pitch;
      SLOAD_H(Kt, n0, n1); SBAR();
      const h16* Qw = nxt.K - 1024 + (size_t)(nxt.P0 + wid * QBLK) * nxt.pitch; const unsigned qo = (unsigned)(r32 * nxt.pitch + hi * 8);
#pragma unroll
      for (int d0 = 0; d0 < 8; ++d0) S.qr[d0] = load8(Qw + qo + d0 * 16); }
    SBAR();
    finishSM(pA0, pA1, alA, l_reg, pa0, pa1, pa2, pa3); SBAR();
    pv_tile<0>(o, vb0, pa0, pa1, pa2, pa3, ACT(even ? NT - 2 : NT - 1));
    if (even) { MASKT(pB0, pB1, NT - 1); partialSM(pB0, pB1, m_reg, mnB, alB); __syncthreads(); RESC(alB);
        finishSM(pB0, pB1, alB, l_reg, pa0, pa1, pa2, pa3); SBAR(); pv_tile<1>(o, vb0, pa0, pa1, pa2, pa3, ACT(NT - 1)); }
    SBAR(); SEAM_K0();
    if (hi == 0) { li_l[r32] = l_reg; if (cur.LSE) cur.LSE[(size_t)(wid * QBLK + r32) * cur.lsestride] = m_reg * SCALE + __logf(l_reg); }
    asm volatile("s_waitcnt lgkmcnt(0)" ::: "memory");
    float rli[16];
#pragma unroll
    for (int r = 0; r < 16; ++r) rli[r] = __builtin_amdgcn_rcpf(li_l[crow(r, hi)]);
    h16* Ow = cur.Ob + (size_t)(cur.P0 + wid * QBLK) * cur.opitch;
    const unsigned olane = (unsigned)(4 * hi * cur.opitch + r32);
#pragma unroll
    for (int r = 0; r < 16; ++r) { h16* rp = Ow + (size_t)(((r & 3) + 8 * (r >> 2)) * cur.opitch);
#pragma unroll
        for (int d0 = 0; d0 < 4; ++d0) { const float v = o[d0][r] * rli[r];
            const float vn = __shfl_xor(v, 1);
            if ((r32 & 1) == 0) *(unsigned*)(rp + olane + d0 * 32) = pk2h(v, vn); } }
    __syncthreads();
#undef RESC
#undef KBASE
#undef SELB
#undef ACT
#undef MASKT
#undef SEAM_K0
#undef HALF_STEP
#undef KTILE
}
#undef ROWP
#undef VMW
#undef VMWN
#undef SLOAD_H
#undef SWRITE_HK
#undef SWRITE_HV
#undef SWRITE_H

__device__ __forceinline__ BlockRef unit_ref(int idx, unsigned char* ws) {
    const h16* QKV = (const h16*)(ws + WS_QKV);
    BlockRef R;
    if (idx < 512) { const int qb = 15 - (idx >> 5), bh = idx & 31, b = bh >> 3, h = bh & 7;
        const size_t tok0 = (size_t)b * SEQ;
        R.K = QKV + tok0 * NQKV + 1024 + h * HD;
        R.Ob = (h16*)(ws + WS_OA) + tok0 * 1024 + h * HD; R.LSE = nullptr; R.KS = (const float*)(ws + WS_KSUM) + (size_t)(b * 16 * 2) * 1024 + h * HD;
        R.P0 = qb * 256; R.pitch = NQKV; R.opitch = 1024; R.W = 1 << 30; R.lsestride = 0; R.moba = 1; }
    else { const int j = idx - 512, g = j >> 9, rem = j & 511, bh = rem & 31, sub = rem >> 5, b = bh >> 3, h = bh & 7;
        const int d = (g == 0) ? 1 : (g == 1) ? 4 : 16, nqb = 16 / d, r = sub / nqb, qb = sub % nqb;
        const size_t tok0 = (size_t)b * SEQ + r, tokq = tok0 + (size_t)d * qb * 256;
        R.K = QKV + tok0 * NQKV + 4096 + h * HD;
        h16* OBg = (h16*)(ws + (g == 0 ? WS_OB0 : g == 1 ? WS_OB1 : WS_OB2));
        R.Ob = OBg + tok0 * 1024 + h * HD; R.LSE = (float*)(ws + WS_LSE) + ((size_t)g * M + tokq) * 8 + h; R.KS = nullptr;
        R.P0 = qb * 256; R.pitch = NQKV * d; R.opitch = 1024 * d; R.W = 129; R.lsestride = 8 * d; R.moba = 0; }
    return R;
}
constexpr int NUNITS = 2048;
__device__ __forceinline__ int unit_pos(int k, int G, int w) { return (k & 1) ? (k + 1) * G - 1 - w : k * G + w; }
__device__ __forceinline__ void attn_phase(char* lds, unsigned char* ws, int G, int w) {
    int k = 0; int p = unit_pos(0, G, w); if (p >= NUNITS) return;
    BlockRef cur = unit_ref(p, ws);
    Seam S;
    attn_prime(cur, lds, S);
    for (;;) {
        const int pn = unit_pos(k + 1, G, w); const bool last = pn >= NUNITS;
        const BlockRef nxt = last ? cur : unit_ref(pn, ws);
        attn_block(cur, nxt, lds, S);
        if (last) break;
        cur = nxt; ++k;
    }
}
#undef KSWZ
#undef SBAR
}

constexpr int MK_LDS_BYTES = 147456, MK_XLDS_OFF = 131072;
struct MkArgs { Ptrs P; int ph_lo, ph_hi; };
namespace cg = cooperative_groups;
__global__ void __launch_bounds__(512, 2) mk_fwd(MkArgs a) {
    cg::grid_group grid = cg::this_grid();
    extern __shared__ __attribute__((aligned(16))) unsigned char lds_raw[];
    LAS unsigned char* lds = (LAS unsigned char*)lds_raw;
    const Ptrs& P = a.P;
    const int tid = threadIdx.x, lane = tid & 63, wave = __builtin_amdgcn_readfirstlane(tid >> 6);
    const int G = gridDim.x, gw = blockIdx.x * 8 + wave, NGW = G * 8;
    unsigned char* ws = P.ws;
#define IN(k) (a.ph_lo <= (k) && (k) < a.ph_hi)
#define SEAM(k) do { if (IN(k) && IN((k) + 1)) grid.sync(); } while (0)
    if (IN(0)) p0_prologue(P, (LAS float*)lds + wave * 64 * 33, gw, NGW, lane);
    SEAM(0);
    if (IN(1)) { pg8::Gemm g{(const h16*)(ws + WS_XN), (const h16*)(ws + WS_WQKV), M, NQKV, DM}; pg8::StaticOrder S; S.init(M, NQKV, G, (int)blockIdx.x);
        pg8::EpiQKV E{(h16*)(ws + WS_QKV), (const f32x2*)(ws + WS_CS), (float*)(ws + WS_KSUM)};
        pg8::gemm_phase<pg8::EpiQKV, pg8::StaticOrder>(lds, lds + MK_XLDS_OFF, g, S, E); }
    SEAM(1);
    if (IN(2)) att::attn_phase((char*)lds_raw, ws, G, (int)blockIdx.x);
    SEAM(2);
    if (IN(3)) { for (int m = gw; m < M; m += NGW) p3_row(P, m, lane); }
    SEAM(3);
    if (IN(4)) { pg8::Gemm g{(const h16*)(ws + WS_MIX), (const h16*)(ws + WS_WO), M, DM, DM}; pg8::StaticOrder S; S.init(M, DM, G, (int)blockIdx.x);
        pg8::EpiY E{(h16*)(ws + WS_Y), (float*)(ws + WS_SS)};
        pg8::gemm_phase<pg8::EpiY, pg8::StaticOrder>(lds, lds + MK_XLDS_OFF, g, S, E); }
    SEAM(4);
    if (IN(5)) { for (int m = gw; m < M; m += NGW)
        resid_row<true>(P.x + (size_t)m * DM, (const h16*)(ws + WS_Y) + (size_t)m * DM, (const float*)(ws + WS_SS) + (size_t)m * 32, P.g_attn_post, P.g_ffn_pre,
                        P.out + (size_t)m * DM, (h16*)(ws + WS_XN2) + (size_t)m * DM, lane); }
    SEAM(5);
    if (IN(6)) { pg8::Gemm g{(const h16*)(ws + WS_XN2), (const h16*)(ws + WS_WGU), M, 2 * FF, DM}; pg8::StaticOrder S; S.init(M, 2 * FF, G, (int)blockIdx.x);
        pg8::EpiGU E{(h16*)(ws + WS_ACT), P.conv_w, P.conv_b, (float*)(ws + WS_HALO), (float*)(ws + WS_FIXP), (float*)(ws + WS_FIXU)};
        pg8::gemm_phase<pg8::EpiGU, pg8::StaticOrder>(lds, lds + MK_XLDS_OFF, g, S, E); }
    SEAM(6);
    if (IN(7)) p5b_fixup(P, blockIdx.x * 512 + tid, G * 512);
    SEAM(7);
    if (IN(8)) { pg8::Gemm g{(const h16*)(ws + WS_ACT), (const h16*)(ws + WS_WD), M, DM, FF}; pg8::StaticOrder S; S.init(M, DM, G, (int)blockIdx.x);
        pg8::EpiY E{(h16*)(ws + WS_Y2), (float*)(ws + WS_SS)};
        pg8::gemm_phase<pg8::EpiY, pg8::StaticOrder>(lds, lds + MK_XLDS_OFF, g, S, E); }
    SEAM(8);
    if (IN(9)) { for (int m = gw; m < M; m += NGW)
        resid_row<false>(P.out + (size_t)m * DM, (const h16*)(ws + WS_Y2) + (size_t)m * DM, (const float*)(ws + WS_SS) + (size_t)m * 32, P.g_ffn_post, nullptr,
                         P.out + (size_t)m * DM, nullptr, lane); }
#undef IN
#undef SEAM
}

extern "C" void kernel_launch(void* const* d_in, const int* in_sizes, int n_in, void* d_out, int out_size, void* d_ws, size_t ws_size, hipStream_t stream) {
    if (n_in != 15 || ws_size < WS_END) { fprintf(stderr, "kernel_launch: unexpected n_in %d or ws_size %zu (need %zu)\n", n_in, ws_size, (size_t)WS_END); return; }
    static int grid = 0;
    if (grid == 0) {
        int dev = 0, cus = 0, per_cu = 0;
        (void)hipGetDevice(&dev); (void)hipDeviceGetAttribute(&cus, hipDeviceAttributeMultiprocessorCount, dev);
        (void)hipFuncSetAttribute((const void*)mk_fwd, hipFuncAttributeMaxDynamicSharedMemorySize, MK_LDS_BYTES);
        (void)hipOccupancyMaxActiveBlocksPerMultiprocessor(&per_cu, (const void*)mk_fwd, 512, MK_LDS_BYTES);
        if (per_cu < 1) per_cu = 1;
        grid = cus * per_cu;
        fprintf(stderr, "kernel_launch: cus %d per_cu %d grid %d\n", cus, per_cu, grid);
    }
    Ptrs P{};
    P.x = (const float*)d_in[0]; P.pos = (const int*)d_in[1]; P.g_attn_pre = (const float*)d_in[2]; P.w_qkv = (const float*)d_in[3]; P.g_moba = (const float*)d_in[4];
    P.g_dil = (const float*)d_in[5]; P.w_o = (const float*)d_in[6]; P.g_attn_post = (const float*)d_in[7]; P.g_ffn_pre = (const float*)d_in[8]; P.w_gate = (const float*)d_in[9];
    P.w_up = (const float*)d_in[10]; P.conv_w = (const float*)d_in[11]; P.conv_b = (const float*)d_in[12]; P.w_down = (const float*)d_in[13]; P.g_ffn_post = (const float*)d_in[14];
    P.out = (float*)d_out; P.ws = (unsigned char*)d_ws;
    unsigned char* ws = P.ws;
    MkArgs a{}; a.P = P;
#if ONE_LAUNCH
    a.ph_lo = 0; a.ph_hi = 10;
    { void* kargs[] = {&a};
      hipError_t e = hipLaunchCooperativeKernel((const void*)mk_fwd, dim3(grid), dim3(512), kargs, MK_LDS_BYTES, stream);
      if (e != hipSuccess) fprintf(stderr, "kernel_launch: cooperative launch failed: %s (grid %d)\n", hipGetErrorString(e), grid); }
    return;
#endif
#define MK(lo, hi) do { a.ph_lo = (lo); a.ph_hi = (hi); hipLaunchKernelGGL(mk_fwd, dim3(grid), dim3(512), MK_LDS_BYTES, stream, a); } while (0)
    MK(0, 1);
#if OPT_P1
    MK(1, 2);
#else
    for (int c = 0; c < 6; ++c) { float* scr = (float*)(ws + WS_NSCR1);
        nv_gemm<<<dim3(1024 / 64, M / 64), 256, 0, stream>>>((const h16*)(ws + WS_XN), DM, (const h16*)(ws + WS_WQKV) + (size_t)c * 1024 * DM, DM, scr, 1024, DM);
        nv_rope<<<(M * 1024) / 256, 256, 0, stream>>>(scr, (h16*)(ws + WS_QKV), (const f32x2*)(ws + WS_CS), c); }
    nv_ksum<<<(64 * 1024) / 256, 256, 0, stream>>>((const h16*)(ws + WS_QKV), (float*)(ws + WS_KSUM));
#endif
#if OPT_P2
    MK(2, 3);
#else
    for (int mode = 0; mode < 4; ++mode)
        nv_attn<<<4096, 256, 0, stream>>>((const h16*)(ws + WS_QKV), (const float*)(ws + WS_KSUM), (h16*)(ws + WS_OA), (h16*)(ws + WS_OB0), (h16*)(ws + WS_OB1), (h16*)(ws + WS_OB2), (float*)(ws + WS_LSE), mode);
#endif
    MK(3, 4);
#if OPT_P4
    MK(4, 5);
#else
    { float* scr = (float*)(ws + WS_NSCR4);
      nv_gemm<<<dim3(DM / 64, M / 64), 256, 0, stream>>>((const h16*)(ws + WS_MIX), DM, (const h16*)(ws + WS_WO), DM, scr, DM, DM);
      nv_cvt_ss<<<(M * 32) / 4, 256, 0, stream>>>(scr, DM, (h16*)(ws + WS_Y), 0, (float*)(ws + WS_SS)); }
#endif
    MK(5, 6);
#if OPT_P5
    MK(6, 7); MK(7, 8);
#else
    for (int c = 0; c < 32; ++c) { float* scr = (float*)(ws + WS_NSCR5);
        nv_gemm<<<dim3(512 / 64, M / 64), 256, 0, stream>>>((const h16*)(ws + WS_XN2), DM, (const h16*)(ws + WS_WGU) + (size_t)c * 512 * DM, DM, scr, 512, DM);
        nv_conv<<<(M * 256) / 256, 256, 0, stream>>>(scr, (h16*)(ws + WS_ACT), P.conv_w, P.conv_b, 2 * c); }
#endif
#if OPT_P6
    MK(8, 9);
#else
    for (int c = 0; c < 2; ++c) { float* scr = (float*)(ws + WS_NSCR6);
        nv_gemm<<<dim3(1024 / 64, M / 64), 256, 0, stream>>>((const h16*)(ws + WS_ACT), FF, (const h16*)(ws + WS_WD) + (size_t)c * 1024 * FF, FF, scr, 1024, FF);
        nv_cvt_ss<<<(M * 16) / 4, 256, 0, stream>>>(scr, 1024, (h16*)(ws + WS_Y2), c * 1024, (float*)(ws + WS_SS)); }
#endif
    MK(9, 10);
#undef MK
}
```

```cpp
#define OPT_P1 1
#define OPT_P2 1
#define OPT_P4 1
#define OPT_P5 1
#define OPT_P6 1
#define ONE_LAUNCH 1
#define USE_CG_SYNC 0
#include <hip/hip_runtime.h>
#include <hip/hip_cooperative_groups.h>
#include <cstdio>
#include <cstdint>

typedef _Float16 h16;
typedef h16 h16x8 __attribute__((ext_vector_type(8)));
typedef h16 h16x2 __attribute__((ext_vector_type(2)));
typedef float f32x4 __attribute__((ext_vector_type(4)));
typedef float f32x2 __attribute__((ext_vector_type(2)));
typedef unsigned u32x4 __attribute__((ext_vector_type(4)));
#define LAS __attribute__((address_space(3)))

constexpr int BATCH = 4, SEQ = 4096, DM = 2048, M = BATCH * SEQ, NQKV = 6144, FF = 8192, HD = 128, NH = 8;
constexpr float RMS_EPS = 1e-6f;
constexpr float SCALE = 0.08838834764831845f;
constexpr size_t MiB = 1u << 20;
constexpr size_t WS_CTL = 0, WS_CS = 1 * MiB, WS_KSUM = 3 * MiB, WS_SS = 4 * MiB, WS_LSE = 6 * MiB, WS_HALO = 8 * MiB, WS_FIXP = 12 * MiB, WS_FIXU = 16 * MiB;
constexpr size_t WS_WQKV = 24 * MiB, WS_WO = 48 * MiB, WS_WGU = 56 * MiB, WS_WD = 120 * MiB;
constexpr size_t WS_XN = 152 * MiB;
constexpr size_t WS_OB0 = 152 * MiB, WS_OB1 = 184 * MiB, WS_XN2 = 152 * MiB, WS_Y2 = 152 * MiB;
constexpr size_t WS_QKV = 216 * MiB;
constexpr size_t WS_MIX = 216 * MiB, WS_Y = 280 * MiB, WS_ACT = 216 * MiB;
constexpr size_t WS_OA = 408 * MiB, WS_OB2 = 440 * MiB;
constexpr size_t WS_NSCR1 = 408 * MiB;
constexpr size_t WS_NSCR4 = 344 * MiB;
constexpr size_t WS_NSCR5 = 472 * MiB;
constexpr size_t WS_NSCR6 = 24 * MiB;
constexpr size_t WS_END = 512 * MiB;

struct Ptrs {
    const float* x; const int* pos; const float* g_attn_pre; const float* w_qkv; const float* g_moba; const float* g_dil; const float* w_o;
    const float* g_attn_post; const float* g_ffn_pre; const float* w_gate; const float* w_up; const float* conv_w; const float* conv_b;
    const float* w_down; const float* g_ffn_post; float* out; unsigned char* ws;
};

__device__ __forceinline__ unsigned pk2h(float lo, float hi) { f32x2 v = {lo, hi}; h16x2 b = __builtin_convertvector(v, h16x2); return __builtin_bit_cast(unsigned, b); }
__device__ __forceinline__ float wave_sum(float v) {
#pragma unroll
    for (int o = 1; o < 64; o <<= 1) v += __shfl_xor(v, o);
    return v;
}
__device__ __forceinline__ float gelu_tanh(float x) {
    const float t = x * x;
    const float z2 = x * (1.5957691216057308f + 0.07135481627f * t);
    const float e = __builtin_amdgcn_exp2f(-z2 * 1.4426950408889634f);
    return x * __builtin_amdgcn_rcpf(1.0f + e);
}

__device__ __forceinline__ void p0_transpose_item(const float* W, int K, int N, h16* WT, int k0, int n0, int dest_row0, LAS float* scr, int lane) {
#pragma unroll 8
    for (int i = 0; i < 32; ++i) { const int kk = 2 * i + (lane >> 5); scr[kk * 33 + (lane & 31)] = W[(size_t)(k0 + kk) * N + n0 + (lane & 31)]; }
    asm volatile("s_waitcnt lgkmcnt(0)" ::: "memory");
    const int c = lane & 7;
#pragma unroll
    for (int j = 0; j < 4; ++j) { const int n = (lane >> 3) + 8 * j; const LAS float* s = scr + (8 * c) * 33 + n;
        u32x4 o; o.x = pk2h(s[0 * 33], s[1 * 33]); o.y = pk2h(s[2 * 33], s[3 * 33]); o.z = pk2h(s[4 * 33], s[5 * 33]); o.w = pk2h(s[6 * 33], s[7 * 33]);
        *(u32x4*)(WT + (size_t)(dest_row0 + n) * K + k0 + 8 * c) = o; }
    asm volatile("s_waitcnt lgkmcnt(0)" ::: "memory");
}
__device__ __forceinline__ void rms_row_to_h16(const float* xrow, const float* g, h16* orow, int lane) {
    f32x4 v[4][2]; float s = 0.f;
#pragma unroll
    for (int j = 0; j < 4; ++j) { const int c = (lane + 64 * j) * 8; v[j][0] = *(const f32x4*)(xrow + c); v[j][1] = *(const f32x4*)(xrow + c + 4);
#pragma unroll
        for (int q = 0; q < 2; ++q) s += (v[j][q].x * v[j][q].x + v[j][q].y * v[j][q].y) + (v[j][q].z * v[j][q].z + v[j][q].w * v[j][q].w); }
    const float rstd = 1.0f / sqrtf(wave_sum(s) * (1.0f / DM) + RMS_EPS);
#pragma unroll
    for (int j = 0; j < 4; ++j) { const int c = (lane + 64 * j) * 8; const f32x4 g0 = *(const f32x4*)(g + c), g1 = *(const f32x4*)(g + c + 4);
        u32x4 o; o.x = pk2h(v[j][0].x * rstd * g0.x, v[j][0].y * rstd * g0.y); o.y = pk2h(v[j][0].z * rstd * g0.z, v[j][0].w * rstd * g0.w);
        o.z = pk2h(v[j][1].x * rstd * g1.x, v[j][1].y * rstd * g1.y); o.w = pk2h(v[j][1].z * rstd * g1.z, v[j][1].w * rstd * g1.w);
        *(u32x4*)(orow + c) = o; }
}
constexpr int I_QKV = (DM / 64) * (NQKV / 32), I_O = (DM / 64) * (DM / 32), I_G = (DM / 64) * (FF / 32), I_D = (FF / 64) * (DM / 32);
constexpr int P0_ITEMS = I_QKV + I_O + 2 * I_G + I_D;
__device__ __forceinline__ void p0_prologue(const Ptrs& P, LAS float* scr  , int gw, int NGW, int lane) {
    h16* WQKV = (h16*)(P.ws + WS_WQKV); h16* WO = (h16*)(P.ws + WS_WO); h16* WGU = (h16*)(P.ws + WS_WGU); h16* WD = (h16*)(P.ws + WS_WD);
    for (int it = gw; it < P0_ITEMS; it += NGW) {
        int r = it;
        if (r < I_QKV) { const int nb = NQKV / 32, kb = r / nb, n0 = (r % nb) * 32; p0_transpose_item(P.w_qkv, DM, NQKV, WQKV, kb * 64, n0, n0, scr, lane); continue; } r -= I_QKV;
        if (r < I_O) { const int nb = DM / 32, kb = r / nb, n0 = (r % nb) * 32; p0_transpose_item(P.w_o, DM, DM, WO, kb * 64, n0, n0, scr, lane); continue; } r -= I_O;
        if (r < I_G) { const int nb = FF / 32, kb = r / nb, n0 = (r % nb) * 32; p0_transpose_item(P.w_gate, DM, FF, WGU, kb * 64, n0, (n0 / 128) * 256 + (n0 % 128), scr, lane); continue; } r -= I_G;
        if (r < I_G) { const int nb = FF / 32, kb = r / nb, n0 = (r % nb) * 32; p0_transpose_item(P.w_up, DM, FF, WGU, kb * 64, n0, (n0 / 128) * 256 + 128 + (n0 % 128), scr, lane); continue; } r -= I_G;
        { const int nb = DM / 32, kb = r / nb, n0 = (r % nb) * 32; p0_transpose_item(P.w_down, FF, DM, WD, kb * 64, n0, n0, scr, lane); }
    }
    h16* XN = (h16*)(P.ws + WS_XN);
    for (int m = gw; m < M; m += NGW) rms_row_to_h16(P.x + (size_t)m * DM, P.g_attn_pre, XN + (size_t)m * DM, lane);
    f32x2* CS = (f32x2*)(P.ws + WS_CS);
    for (int e = gw * 64 + lane; e < M * 16; e += NGW * 64) { const int m = e >> 4, i = e & 15;
        const float inv_freq = powf(500000.0f, -(float)i / 16.0f); const float ang = (float)P.pos[m] * inv_freq;
        float sn, cs; sincosf(ang, &sn, &cs); CS[e] = (f32x2){cs, sn}; }
}

__device__ __forceinline__ void p3_row(const Ptrs& P, int m, int lane) {
    const h16* OA = (const h16*)(P.ws + WS_OA) + (size_t)m * 1024;
    const h16* OB[3] = {(const h16*)(P.ws + WS_OB0) + (size_t)m * 1024, (const h16*)(P.ws + WS_OB1) + (size_t)m * 1024, (const h16*)(P.ws + WS_OB2) + (size_t)m * 1024};
    const float* LSE = (const float*)(P.ws + WS_LSE);
    h16* MIX = (h16*)(P.ws + WS_MIX) + (size_t)m * DM;
    {   float v[2][8]; float s = 0.f;
#pragma unroll
        for (int j = 0; j < 2; ++j) { const h16x8 a = *(const h16x8*)(OA + (lane + 64 * j) * 8);
#pragma unroll
            for (int e = 0; e < 8; ++e) { v[j][e] = (float)a[e]; s += v[j][e] * v[j][e]; } }
        const float rstd = 1.0f / sqrtf(wave_sum(s) * (1.0f / 1024.0f) + RMS_EPS);
#pragma unroll
        for (int j = 0; j < 2; ++j) { const int c = (lane + 64 * j) * 8; const f32x4 g0 = *(const f32x4*)(P.g_moba + c), g1 = *(const f32x4*)(P.g_moba + c + 4);
            u32x4 o; o.x = pk2h(v[j][0] * rstd * g0.x, v[j][1] * rstd * g0.y); o.y = pk2h(v[j][2] * rstd * g0.z, v[j][3] * rstd * g0.w);
            o.z = pk2h(v[j][4] * rstd * g1.x, v[j][5] * rstd * g1.y); o.w = pk2h(v[j][6] * rstd * g1.z, v[j][7] * rstd * g1.w);
            *(u32x4*)(MIX + c) = o; } }
    {   float v[2][8]; float s = 0.f;
#pragma unroll
        for (int j = 0; j < 2; ++j) { const int hh = (lane >> 4) + 4 * j;
            const float l0 = LSE[((size_t)0 * M + m) * 8 + hh], l1 = LSE[((size_t)1 * M + m) * 8 + hh], l2 = LSE[((size_t)2 * M + m) * 8 + hh];
            const float mx = fmaxf(l0, fmaxf(l1, l2)); const float e0 = __expf(l0 - mx), e1 = __expf(l1 - mx), e2 = __expf(l2 - mx); const float inv = 1.0f / (e0 + e1 + e2);
            const float w0 = e0 * inv, w1 = e1 * inv, w2 = e2 * inv;
            const h16x8 a0 = *(const h16x8*)(OB[0] + (lane + 64 * j) * 8), a1 = *(const h16x8*)(OB[1] + (lane + 64 * j) * 8), a2 = *(const h16x8*)(OB[2] + (lane + 64 * j) * 8);
#pragma unroll
            for (int e = 0; e < 8; ++e) { v[j][e] = w0 * (float)a0[e] + w1 * (float)a1[e] + w2 * (float)a2[e]; s += v[j][e] * v[j][e]; } }
        const float rstd = 1.0f / sqrtf(wave_sum(s) * (1.0f / 1024.0f) + RMS_EPS);
#pragma unroll
        for (int j = 0; j < 2; ++j) { const int c = (lane + 64 * j) * 8; const f32x4 g0 = *(const f32x4*)(P.g_dil + c), g1 = *(const f32x4*)(P.g_dil + c + 4);
            u32x4 o; o.x = pk2h(v[j][0] * rstd * g0.x, v[j][1] * rstd * g0.y); o.y = pk2h(v[j][2] * rstd * g0.z, v[j][3] * rstd * g0.w);
            o.z = pk2h(v[j][4] * rstd * g1.x, v[j][5] * rstd * g1.y); o.w = pk2h(v[j][6] * rstd * g1.z, v[j][7] * rstd * g1.w);
            *(u32x4*)(MIX + 1024 + c) = o; } }
}
template <bool NEXT>
__device__ __forceinline__ void resid_row(const float* base, const h16* y, const float* ss, const float* gpost, const float* gnext, float* out, h16* xn2, int lane) {
    const float part = (lane < 32) ? ss[lane] : 0.f;
    const float rstd_y = 1.0f / sqrtf(wave_sum(part) * (1.0f / DM) + RMS_EPS);
    f32x4 v[4][2]; float s = 0.f;
#pragma unroll
    for (int j = 0; j < 4; ++j) { const int c = (lane + 64 * j) * 8; const h16x8 yy = *(const h16x8*)(y + c);
#pragma unroll
        for (int q = 0; q < 2; ++q) { const f32x4 b = *(const f32x4*)(base + c + 4 * q), g = *(const f32x4*)(gpost + c + 4 * q);
            f32x4 o; o.x = b.x + (float)yy[4 * q + 0] * rstd_y * g.x; o.y = b.y + (float)yy[4 * q + 1] * rstd_y * g.y; o.z = b.z + (float)yy[4 * q + 2] * rstd_y * g.z; o.w = b.w + (float)yy[4 * q + 3] * rstd_y * g.w;
            v[j][q] = o; s += (o.x * o.x + o.y * o.y) + (o.z * o.z + o.w * o.w); *(f32x4*)(out + c + 4 * q) = o; } }
    if (NEXT) { const float rstd = 1.0f / sqrtf(wave_sum(s) * (1.0f / DM) + RMS_EPS);
#pragma unroll
        for (int j = 0; j < 4; ++j) { const int c = (lane + 64 * j) * 8; const f32x4 g0 = *(const f32x4*)(gnext + c), g1 = *(const f32x4*)(gnext + c + 4);
            u32x4 o; o.x = pk2h(v[j][0].x * rstd * g0.x, v[j][0].y * rstd * g0.y); o.y = pk2h(v[j][0].z * rstd * g0.z, v[j][0].w * rstd * g0.w);
            o.z = pk2h(v[j][1].x * rstd * g1.x, v[j][1].y * rstd * g1.y); o.w = pk2h(v[j][1].z * rstd * g1.z, v[j][1].w * rstd * g1.w);
            *(u32x4*)(xn2 + c) = o; } }
}

__global__ __launch_bounds__(256) void k_p0(Ptrs P) {
    __shared__ float scr_all[4 * 64 * 33];
    const int lane = threadIdx.x & 63, wave = threadIdx.x >> 6;
    p0_prologue(P, (LAS float*)scr_all + wave * 64 * 33, blockIdx.x * 4 + wave, gridDim.x * 4, lane);
}
__global__ __launch_bounds__(512) void k_p3(Ptrs P) {
    const int lane = threadIdx.x & 63, gw = blockIdx.x * 8 + (threadIdx.x >> 6), NGW = gridDim.x * 8;
    for (int m = gw; m < M; m += NGW) p3_row(P, m, lane);
}
__global__ __launch_bounds__(512) void k_p4b(Ptrs P) {
    const int lane = threadIdx.x & 63, gw = blockIdx.x * 8 + (threadIdx.x >> 6), NGW = gridDim.x * 8;
    for (int m = gw; m < M; m += NGW)
        resid_row<true>(P.x + (size_t)m * DM, (const h16*)(P.ws + WS_Y) + (size_t)m * DM, (const float*)(P.ws + WS_SS) + (size_t)m * 32, P.g_attn_post, P.g_ffn_pre,
                        P.out + (size_t)m * DM, (h16*)(P.ws + WS_XN2) + (size_t)m * DM, lane);
}
__global__ __launch_bounds__(512) void k_p6b(Ptrs P) {
    const int lane = threadIdx.x & 63, gw = blockIdx.x * 8 + (threadIdx.x >> 6), NGW = gridDim.x * 8;
    for (int m = gw; m < M; m += NGW)
        resid_row<false>(P.out + (size_t)m * DM, (const h16*)(P.ws + WS_Y2) + (size_t)m * DM, (const float*)(P.ws + WS_SS) + (size_t)m * 32, P.g_ffn_post, nullptr,
                         P.out + (size_t)m * DM, nullptr, lane);
}

__global__ __launch_bounds__(256) void nv_gemm(const h16* A, int lda, const h16* Bt, int ldb, float* C, int ldc, int K) {
    __shared__ float As[32][65]; __shared__ float Bs[32][65];
    const int t = threadIdx.x, m0 = blockIdx.y * 64, n0 = blockIdx.x * 64, lr = t >> 2, lk = (t & 3) * 8, ty = t >> 4, tx = t & 15;
    float acc[4][4];
#pragma unroll
    for (int i = 0; i < 4; ++i)
#pragma unroll
        for (int j = 0; j < 4; ++j) acc[i][j] = 0.f;
    for (int k0 = 0; k0 < K; k0 += 32) {
        const h16x8 a = *(const h16x8*)(A + (size_t)(m0 + lr) * lda + k0 + lk);
        const h16x8 b = *(const h16x8*)(Bt + (size_t)(n0 + lr) * ldb + k0 + lk);
#pragma unroll
        for (int e = 0; e < 8; ++e) { As[lk + e][lr] = (float)a[e]; Bs[lk + e][lr] = (float)b[e]; }
        __syncthreads();
#pragma unroll 8
        for (int kk = 0; kk < 32; ++kk) {
            float av[4], bv[4];
#pragma unroll
            for (int i = 0; i < 4; ++i) { av[i] = As[kk][ty * 4 + i]; bv[i] = Bs[kk][tx * 4 + i]; }
#pragma unroll
            for (int i = 0; i < 4; ++i)
#pragma unroll
                for (int j = 0; j < 4; ++j) acc[i][j] = fmaf(av[i], bv[j], acc[i][j]);
        }
        __syncthreads();
    }
#pragma unroll
    for (int i = 0; i < 4; ++i) { f32x4 o = {acc[i][0], acc[i][1], acc[i][2], acc[i][3]}; *(f32x4*)(C + (size_t)(m0 + ty * 4 + i) * ldc + n0 + tx * 4) = o; }
}
__global__ __launch_bounds__(256) void nv_rope(const float* C, h16* QKV, const f32x2* CS, int chunk) {
    const size_t e = (size_t)blockIdx.x * 256 + threadIdx.x; const int m = (int)(e >> 10), j = (int)(e & 1023), d = j & 127;
    float v = C[e];
    if ((chunk % 3) != 2 && d < 32) {
        const int i = d & 15; const f32x2 cs = CS[(size_t)m * 16 + i];
        if (d < 16) v = v * cs.x - C[e + 16] * cs.y; else v = v * cs.x + C[e - 16] * cs.y;
    }
    QKV[(size_t)m * NQKV + chunk * 1024 + j] = (h16)v;
}
__global__ __launch_bounds__(256) void nv_ksum(const h16* QKV, float* KSUM) {
    const int e = blockIdx.x * 256 + threadIdx.x; const int pm = e >> 10, c = e & 1023;
    float s = 0.f;
    for (int r = 0; r < 256; ++r) s += (float)QKV[(size_t)(pm * 256 + r) * NQKV + 1024 + c];
    KSUM[(size_t)(pm * 2 + 0) * 1024 + c] = s; KSUM[(size_t)(pm * 2 + 1) * 1024 + c] = 0.f;
}
__global__ __launch_bounds__(256) void nv_cvt_ss(const float* C, int ncols, h16* Y, int col0, float* SS) {
    const int lane = threadIdx.x & 63; const size_t w = (size_t)blockIdx.x * 4 + (threadIdx.x >> 6); const int nslot = ncols / 64; const int m = (int)(w / nslot), s = (int)(w % nslot);
    const float v = C[(size_t)m * ncols + s * 64 + lane];
    Y[(size_t)m * DM + col0 + s * 64 + lane] = (h16)v;
    const float q = wave_sum(v * v);
    if (lane == 0) SS[(size_t)m * 32 + col0 / 64 + s] = q;
}
__global__ __launch_bounds__(256) void nv_conv(const float* C, h16* ACT, const float* conv_w, const float* conv_b, int g0) {
    const size_t e = (size_t)blockIdx.x * 256 + threadIdx.x; const int m = (int)(e >> 8), jj = (int)(e & 255), gi = jj >> 7, j = jj & 127;
    const int c = 128 * (g0 + gi) + j; const int s = m & (SEQ - 1);
    const float* Cg = C + (size_t)m * 512 + gi * 256 + j;
    const float g_0 = Cg[0], g_1 = (s >= 1) ? Cg[-512] : 0.f, g_2 = (s >= 2) ? Cg[-1024] : 0.f, u = Cg[128];
    const float pre = conv_b[c] + conv_w[c] * g_2 + conv_w[FF + c] * g_1 + conv_w[2 * FF + c] * g_0;
    ACT[(size_t)m * FF + c] = (h16)(gelu_tanh(pre) * u);
}
__global__ __launch_bounds__(256) void nv_attn(const h16* QKV, const float* KSUM, h16* OA, h16* OB0, h16* OB1, h16* OB2, float* LSE, int mode) {
    __shared__ float Qs[32][129]; __shared__ float Ks[32][129]; __shared__ float Vs[32][128]; __shared__ float Ps[32][33]; __shared__ float Gs[32][16]; __shared__ unsigned Sel[32];
    const int t = threadIdx.x, u = blockIdx.x, b = u >> 10, h = (u >> 7) & 7, rem = u & 127;
    int d = 1, r = 0, i0, W; const h16 *Qp, *Kp, *Vp; h16* Op; size_t pitch, opitch;
    if (mode == 0) { i0 = rem * 32; W = 1 << 30; pitch = NQKV; opitch = 1024;
        Qp = QKV + (size_t)(b * SEQ) * NQKV + 0 + h * HD; Kp = Qp + 1024; Vp = Qp + 2048; Op = OA + (size_t)(b * SEQ) * 1024 + h * HD; }
    else { d = (mode == 1) ? 1 : (mode == 2) ? 4 : 16; const int nq = (SEQ / d) / 32; r = rem / nq; i0 = (rem % nq) * 32; W = 129; pitch = (size_t)NQKV * d; opitch = (size_t)1024 * d;
        Qp = QKV + (size_t)(b * SEQ + r) * NQKV + 3072 + h * HD; Kp = Qp + 1024; Vp = Qp + 2048;
        h16* OBm = (mode == 1) ? OB0 : (mode == 2) ? OB1 : OB2; Op = OBm + (size_t)(b * SEQ + r) * 1024 + h * HD; }
    for (int e = t; e < 32 * 128; e += 256) { const int qi = e >> 7, c = e & 127; Qs[qi][c] = (float)Qp[(size_t)(i0 + qi) * pitch + c]; }
    __syncthreads();
    const int qi = t >> 3, sub = t & 7;
    if (mode == 0) {
        const int qblk = i0 >> 8;
        for (int jj = 0; jj < 2; ++jj) { const int j = sub + 8 * jj; float g = 0.f;
            if (j < qblk) { const float* k0 = KSUM + (size_t)((b * 16 + j) * 2) * 1024 + h * HD; for (int c = 0; c < 128; ++c) g += Qs[qi][c] * (k0[c] + k0[1024 + c]) * (1.0f / 256.0f); }
            Gs[qi][j] = g; }
        __syncthreads();
        if (sub == 0) { unsigned sel = 0;
            for (int rnd = 0; rnd < 3; ++rnd) { float best = -3.0e38f; int bi = -1;
                for (int j = 0; j < 16; ++j) if (j < qblk && !((sel >> j) & 1u) && Gs[qi][j] > best) { best = Gs[qi][j]; bi = j; }
                if (bi >= 0) sel |= 1u << bi; }
            sel |= 1u << qblk; Sel[qi] = sel; }
        __syncthreads();
    }
    const unsigned selmask = (mode == 0) ? Sel[qi] : 0xffffffffu;
    float o[16];
#pragma unroll
    for (int c = 0; c < 16; ++c) o[c] = 0.f;
    float mrun = -1e30f, lrun = 0.f;
    int klo = (mode == 0) ? 0 : (i0 - 128 > 0 ? i0 - 128 : 0); klo &= ~31;
    const int khi = i0 + 32;
    const int iq = i0 + qi;
    for (int k0 = klo; k0 < khi; k0 += 32) {
        __syncthreads();
        for (int e = t; e < 32 * 128; e += 256) { const int kk = e >> 7, c = e & 127; Ks[kk][c] = (float)Kp[(size_t)(k0 + kk) * pitch + c]; Vs[kk][c] = (float)Vp[(size_t)(k0 + kk) * pitch + c]; }
        __syncthreads();
        float sc[4]; float tmax = -1e30f;
#pragma unroll
        for (int j = 0; j < 4; ++j) { const int kk = sub * 4 + j, kidx = k0 + kk; float a = 0.f;
            for (int c = 0; c < 128; ++c) a += Qs[qi][c] * Ks[kk][c];
            a *= SCALE;
            bool ok = (kidx <= iq) && (iq - kidx < W);
            if (mode == 0) ok = ok && ((selmask >> (kidx >> 8)) & 1u);
            sc[j] = ok ? a : -INFINITY; tmax = fmaxf(tmax, sc[j]); }
        tmax = fmaxf(tmax, __shfl_xor(tmax, 1)); tmax = fmaxf(tmax, __shfl_xor(tmax, 2)); tmax = fmaxf(tmax, __shfl_xor(tmax, 4));
        const float mnew = fmaxf(mrun, tmax); const float alpha = __expf(mrun - mnew);
        float ps = 0.f;
#pragma unroll
        for (int j = 0; j < 4; ++j) { const float p = __expf(sc[j] - mnew); Ps[qi][sub * 4 + j] = p; ps += p; }
        ps += __shfl_xor(ps, 1); ps += __shfl_xor(ps, 2); ps += __shfl_xor(ps, 4);
        lrun = lrun * alpha + ps; mrun = mnew;
        __syncthreads();
#pragma unroll
        for (int c = 0; c < 16; ++c) o[c] *= alpha;
        for (int kk = 0; kk < 32; ++kk) { const float p = Ps[qi][kk];
#pragma unroll
            for (int c = 0; c < 16; ++c) o[c] = fmaf(p, Vs[kk][sub * 16 + c], o[c]); }
    }
    const float inv = 1.0f / lrun;
#pragma unroll
    for (int c = 0; c < 16; ++c) Op[(size_t)(i0 + qi) * opitch + sub * 16 + c] = (h16)(o[c] * inv);
    if (mode != 0 && sub == 0) LSE[((size_t)(mode - 1) * M + (size_t)(b * SEQ + r + d * (i0 + qi))) * 8 + h] = mrun + __logf(lrun);
}

namespace pg8 {
#define PG8_LAS __attribute__((address_space(3)))
constexpr int BM = 256, BK = 64, HALF = 128, HTB = HALF * BK * 2, STAGE_BYTES = 8 * HTB, NXCD = 8, WGM = 8;
__host__ __device__ __forceinline__ int lds_byte(int r, int c) { const int st = (r >> 4) * 2 + (c >> 5), rr = r & 15, cc = c & 31, ob = rr * 64 + cc * 2; return st * 1024 + (ob ^ (((ob >> 9) & 1) << 5)); }
__host__ __device__ __forceinline__ void stage_rc(int b, int& R, int& C) { const int st = b / 1024, sb = b % 1024, swz = sb ^ (((sb >> 9) & 1) << 5); R = (st >> 1) * 16 + swz / 64; C = (st & 1) * 32 + (swz % 64) / 2; }
__host__ __device__ __forceinline__ int perm32(int rho) { const int n = rho >> 4, i = rho & 15; return 8 * (i >> 2) + 4 * n + (i & 3); }
struct Unit { int pm, pn; };
struct Gemm { const h16* A; const h16* Bt; int M, N, K; };
struct StaticOrder {
    int nM, nN, nwg, G, c;
    __host__ __device__ void init(int M_, int N_, int G_, int c_) { nM = M_ / BM; nN = N_ / BM; nwg = nM * nN; G = G_; c = c_; }
    __host__ __device__ bool next(int i, Unit& u) const {
        const long L = (long)i * G + c; if (L >= nwg) return false;
        int wgid = (int)L; { const int q = nwg / NXCD, r = nwg % NXCD, xcd = wgid % NXCD, off = wgid / NXCD; wgid = (xcd < r ? xcd * (q + 1) : r * (q + 1) + (xcd - r) * q) + off; }
        const int nig = WGM * nN, gid = wgid / nig, fm = gid * WGM, gsz = (nM - fm) < WGM ? (nM - fm) : WGM;
        u.pm = fm + ((wgid % nig) % gsz); u.pn = (wgid % nig) / gsz; return true;
    }
};
typedef f32x4 Acc[2][2][4][2];

__device__ __forceinline__ u32x4 pack8h(f32x4 v0, f32x4 v1) { u32x4 w; w.x = pk2h(v0[0], v0[1]); w.y = pk2h(v0[2], v0[3]); w.z = pk2h(v1[0], v1[1]); w.w = pk2h(v1[2], v1[3]); return w; }

struct EpiQKV {
    h16* O; const f32x2* CS; float* KSUM;
    __device__ __forceinline__ void operator()(Acc& acc, const Unit& u, int wr, int wc, int fr, int fq, PG8_LAS unsigned char* xlds) const {
        const int grp6 = u.pn >> 2, kind = grp6 % 3;
        const int row0 = u.pm * BM + wr * 64 + fr;
        if (kind != 2 && wc == 0) {
            const float sgn = (fq < 2) ? -1.f : 1.f;
#pragma unroll
            for (int ai = 0; ai < 2; ++ai)
#pragma unroll
                for (int m = 0; m < 4; ++m) {
                    const f32x4* cp = (const f32x4*)(CS + (size_t)(row0 + ai * HALF + m * 16) * 16 + 8 * (fq & 1));
                    const f32x4 c0 = cp[0], c1 = cp[1], c2 = cp[2], c3 = cp[3];
                    const float cs[8] = {c0[0], c0[2], c1[0], c1[2], c2[0], c2[2], c3[0], c3[2]}, sn[8] = {c0[1], c0[3], c1[1], c1[3], c2[1], c2[3], c3[1], c3[3]};
#pragma unroll
                    for (int bj = 0; bj < 2; ++bj)
#pragma unroll
                        for (int n = 0; n < 2; ++n)
#pragma unroll
                            for (int e = 0; e < 4; ++e) { const float v = acc[ai][bj][m][n][e]; const float o = __shfl_xor(v, 32);
                                acc[ai][bj][m][n][e] = v * cs[4 * n + e] + sgn * o * sn[4 * n + e]; }
                }
        }
        if (grp6 == 1) {
#pragma unroll
            for (int bj = 0; bj < 2; ++bj)
#pragma unroll
                for (int n = 0; n < 2; ++n) { f32x4 s = {0.f, 0.f, 0.f, 0.f};
#pragma unroll
                    for (int ai = 0; ai < 2; ++ai)
#pragma unroll
                        for (int m = 0; m < 4; ++m) s += acc[ai][bj][m][n];
#pragma unroll
                    for (int e = 0; e < 4; ++e) { float t = s[e]; t += __shfl_xor(t, 1); t += __shfl_xor(t, 2); t += __shfl_xor(t, 4); t += __shfl_xor(t, 8); s[e] = t; }
                    if (fr == 0) *(f32x4*)(KSUM + (size_t)(u.pm * 2 + wr) * 1024 + (u.pn - 4) * 256 + bj * HALF + wc * 32 + 8 * fq + 4 * n) = s; }
        }
        const int col0 = u.pn * BM + wc * 32 + 8 * fq;
#pragma unroll
        for (int ai = 0; ai < 2; ++ai)
#pragma unroll
            for (int m = 0; m < 4; ++m) { h16* rowp = O + (size_t)(row0 + ai * HALF + m * 16) * NQKV + col0;
#pragma unroll
                for (int bj = 0; bj < 2; ++bj) *(u32x4*)(rowp + bj * HALF) = pack8h(acc[ai][bj][m][0], acc[ai][bj][m][1]); }
    }
};
struct EpiY {
    h16* O; float* SS;
    __device__ __forceinline__ void operator()(Acc& acc, const Unit& u, int wr, int wc, int fr, int fq, PG8_LAS unsigned char* xlds) const {
        const int row0 = u.pm * BM + wr * 64 + fr, col0 = u.pn * BM + wc * 32 + 8 * fq;
#pragma unroll
        for (int ai = 0; ai < 2; ++ai)
#pragma unroll
            for (int m = 0; m < 4; ++m) { const int row = row0 + ai * HALF + m * 16; h16* rowp = O + (size_t)row * DM + col0; float q = 0.f;
#pragma unroll
                for (int bj = 0; bj < 2; ++bj) { const f32x4 v0 = acc[ai][bj][m][0], v1 = acc[ai][bj][m][1];
                    q += (v0[0] * v0[0] + v0[1] * v0[1]) + (v0[2] * v0[2] + v0[3] * v0[3]) + (v1[0] * v1[0] + v1[1] * v1[1]) + (v1[2] * v1[2] + v1[3] * v1[3]);
                    *(u32x4*)(rowp + bj * HALF) = pack8h(v0, v1); }
                q += __shfl_xor(q, 16); q += __shfl_xor(q, 32);
                if (fq == 0) SS[(size_t)row * 32 + u.pn * 4 + wc] = q; }
    }
};
template <int CTRL> __device__ __forceinline__ float dpp_mov(float old, float src) {
    return __builtin_bit_cast(float, __builtin_amdgcn_update_dpp(__builtin_bit_cast(int, old), __builtin_bit_cast(int, src), CTRL, 0xF, 0xF, false)); }
struct EpiGU {
    h16* ACT; const float* conv_w; const float* conv_b; float* HALO; float* FIXP; float* FIXU;
    __device__ __forceinline__ void operator()(Acc& acc, const Unit& u, int wr, int wc, int fr, int fq, PG8_LAS unsigned char* xlds) const {
        PG8_LAS float* xb = (PG8_LAS float*)xlds;
        const int c0 = u.pn * HALF + wc * 32 + 8 * fq;
        if (fr >= 14) {
#pragma unroll
            for (int ai = 0; ai < 2; ++ai) { PG8_LAS float* d = xb + ((((ai * 2 + wr) * 4 + wc) * 4 + fq) * 2 + (fr - 14)) * 8;
                *(PG8_LAS f32x4*)d = acc[ai][0][3][0]; *(PG8_LAS f32x4*)(d + 4) = acc[ai][0][3][1]; }
            if (wr == 1) { float* hp = HALO + ((size_t)(u.pm * 2 + (fr - 14))) * FF + c0;
                *(f32x4*)hp = acc[1][0][3][0]; *(f32x4*)(hp + 4) = acc[1][0][3][1]; }
        }
        asm volatile("s_waitcnt lgkmcnt(0)" ::: "memory"); __builtin_amdgcn_s_barrier(); asm volatile("" ::: "memory");
        f32x4 w0[2], w1[2], w2[2], bb[2];
#pragma unroll
        for (int n = 0; n < 2; ++n) { w0[n] = *(const f32x4*)(conv_w + c0 + 4 * n); w1[n] = *(const f32x4*)(conv_w + FF + c0 + 4 * n); w2[n] = *(const f32x4*)(conv_w + 2 * FF + c0 + 4 * n); bb[n] = *(const f32x4*)(conv_b + c0 + 4 * n); }
#pragma unroll
        for (int ai = 0; ai < 2; ++ai) {
            f32x4 pv[2];
            if (ai == 0 && wr == 0) { pv[0] = (f32x4){0.f, 0.f, 0.f, 0.f}; pv[1] = pv[0]; }
            else { const int sg = (wr == 1) ? (ai * 2 + 0) : (0 * 2 + 1);
                const PG8_LAS float* s = xb + (((sg * 4 + wc) * 4 + fq) * 2 + (fr & 1)) * 8;
                pv[0] = *(const PG8_LAS f32x4*)s; pv[1] = *(const PG8_LAS f32x4*)(s + 4); }
#pragma unroll
            for (int m = 0; m < 4; ++m) {
                const int row = u.pm * BM + ai * HALF + wr * 64 + m * 16 + fr;
                f32x4 o[2];
#pragma unroll
                for (int n = 0; n < 2; ++n)
#pragma unroll
                    for (int e = 0; e < 4; ++e) { const float g = acc[ai][0][m][n][e], pg = pv[n][e];
                        const float p1 = dpp_mov<0x111>(dpp_mov<0x121>(0.f, pg), g);
                        const float p2 = dpp_mov<0x112>(dpp_mov<0x122>(0.f, pg), g);
                        const float pre = bb[n][e] + w0[n][e] * p2 + w1[n][e] * p1 + w2[n][e] * g;
                        o[n][e] = pre; }
                if (ai == 0 && wr == 0 && m == 0 && fr < 2) { float* fp = FIXP + ((size_t)(u.pm * 2 + fr)) * FF + c0; float* fu = FIXU + ((size_t)(u.pm * 2 + fr)) * FF + c0;
                    *(f32x4*)fp = o[0]; *(f32x4*)(fp + 4) = o[1]; *(f32x4*)fu = acc[0][1][0][0]; *(f32x4*)(fu + 4) = acc[0][1][0][1]; }
#pragma unroll
                for (int n = 0; n < 2; ++n)
#pragma unroll
                    for (int e = 0; e < 4; ++e) o[n][e] = gelu_tanh(o[n][e]) * acc[ai][1][m][n][e];
                *(u32x4*)(ACT + (size_t)row * FF + c0) = pack8h(o[0], o[1]);
                pv[0] = acc[ai][0][m][0]; pv[1] = acc[ai][0][m][1];
            }
        }
    }
};

template <class Epi, class Sched>
__device__ __forceinline__ void gemm_phase(PG8_LAS unsigned char* lds, PG8_LAS unsigned char* xlds, const Gemm g, const Sched& S, const Epi& E) {
    const int tid = threadIdx.x, wid = __builtin_amdgcn_readfirstlane(tid >> 6), lane = tid & 63, wr = wid >> 2, wc = wid & 3, fr = lane & 15, fq = lane >> 4;
    const int K = g.K, nt = K / BK;
    unsigned voffA[2], voffB[2];
#pragma unroll
    for (int i = 0; i < 2; ++i) { int R, C; stage_rc(tid * 16 + i * 8192, R, C); const int Rb = (R & ~31) + perm32(R & 31);
        voffA[i] = (unsigned)(R * K + C) * 2u; voffB[i] = (unsigned)(Rb * K + C) * 2u; }
    const size_t kstep = (size_t)(BK * 2);
    const size_t hstep = (size_t)HALF * K * 2;
    const size_t tstep = 2 * hstep;
    const unsigned ldsw = (unsigned)wid * 1024u;
    const int aoff = lds_byte(wr * 64 + fr, fq * 8), boff = lds_byte(wc * 32 + fr, fq * 8);
#define PG8_SA(b, h) (((b) * 2 + (h)) * HTB)
#define PG8_SB(b, h) ((4 + (b) * 2 + (h)) * HTB)
#define PG8_STAGE(bufoff, gbase, voff) do { _Pragma("unroll") for (int _i = 0; _i < 2; ++_i) \
        __builtin_amdgcn_global_load_lds((const unsigned*)((const char*)(gbase) + (voff)[_i]), (PG8_LAS unsigned*)(lds + (bufoff) + ldsw + _i * 8192), 16, 0, 0); } while (0)
#define PG8_LDA(dst, b, h) do { _Pragma("unroll") for (int m = 0; m < 4; ++m) _Pragma("unroll") for (int k = 0; k < 2; ++k) dst[m][k] = *(const PG8_LAS h16x8*)(lds + PG8_SA(b, h) + aoff + m * 2048 + k * 1024); } while (0)
#define PG8_LDB(dst, b, h) do { _Pragma("unroll") for (int n = 0; n < 2; ++n) _Pragma("unroll") for (int k = 0; k < 2; ++k) dst[n][k] = *(const PG8_LAS h16x8*)(lds + PG8_SB(b, h) + boff + n * 2048 + k * 1024); } while (0)
#define PG8_MMA(ai, bj, At, Bt) do { __builtin_amdgcn_s_setprio(1); _Pragma("unroll") for (int m = 0; m < 4; ++m) _Pragma("unroll") for (int n = 0; n < 2; ++n) _Pragma("unroll") for (int k = 0; k < 2; ++k) \
        acc[ai][bj][m][n] = __builtin_amdgcn_mfma_f32_16x16x32_f16(Bt[n][k], At[m][k], acc[ai][bj][m][n], 0, 0, 0); __builtin_amdgcn_s_setprio(0); } while (0)
#define PG8_WAIT_V(n) asm volatile("s_waitcnt vmcnt(" #n ")" ::: "memory")
#define PG8_WAIT_L(n) asm volatile("s_waitcnt lgkmcnt(" #n ")" ::: "memory")
#define PG8_BAR __builtin_amdgcn_s_barrier()
#define PG8_SCHED __builtin_amdgcn_sched_barrier(0)
    Unit cur, nxt; int ui = 0;
    if (!S.next(0, cur)) return;
    Acc acc;
#pragma unroll
    for (int a = 0; a < 2; ++a)
#pragma unroll
        for (int b = 0; b < 2; ++b)
#pragma unroll
            for (int m = 0; m < 4; ++m)
#pragma unroll
                for (int n = 0; n < 2; ++n) acc[a][b][m][n] = (f32x4){0.f, 0.f, 0.f, 0.f};
    h16x8 At[4][2], B0[2][2], B1[2][2];
    const char* cA = (const char*)g.A + (size_t)cur.pm * tstep; const char* cB = (const char*)g.Bt + (size_t)cur.pn * tstep;
    PG8_STAGE(PG8_SB(0, 0), cB, voffB); PG8_STAGE(PG8_SB(0, 1), cB + hstep, voffB); PG8_STAGE(PG8_SA(0, 0), cA, voffA); PG8_STAGE(PG8_SA(0, 1), cA + hstep, voffA);
    if (wr == 1) PG8_BAR;
    PG8_WAIT_V(2); PG8_BAR;
    PG8_STAGE(PG8_SB(1, 0), cB + kstep, voffB); PG8_STAGE(PG8_SA(1, 0), cA + kstep, voffA); PG8_STAGE(PG8_SB(1, 1), cB + hstep + kstep, voffB);
    PG8_WAIT_V(6); PG8_BAR;
    for (;;) {
        const bool has_next = S.next(ui + 1, nxt);
        const char* nA = has_next ? (const char*)g.A + (size_t)nxt.pm * tstep : cA; const char* nB = has_next ? (const char*)g.Bt + (size_t)nxt.pn * tstep : cB;
        for (int t = 0; t < nt; t += 2) {
            const bool last = (t == nt - 2);
            const char* a1 = cA + (size_t)(t + 1) * kstep;
            const char* a2 = last ? nA : cA + (size_t)(t + 2) * kstep; const char* b2 = last ? nB : cB + (size_t)(t + 2) * kstep;
            const char* a3 = a2 + kstep; const char* b3 = b2 + kstep;
            PG8_LDB(B0, 0, 0); PG8_LDB(B1, 0, 1); PG8_SCHED; PG8_LDA(At, 0, 0); PG8_STAGE(PG8_SA(1, 1), a1 + hstep, voffA);
            PG8_WAIT_V(8); PG8_WAIT_L(0); PG8_BAR; PG8_MMA(0, 0, At, B0); PG8_MMA(0, 1, At, B1); PG8_BAR; PG8_SCHED;
            PG8_LDA(At, 0, 1); PG8_STAGE(PG8_SB(0, 0), b2, voffB); PG8_STAGE(PG8_SB(0, 1), b2 + hstep, voffB); PG8_STAGE(PG8_SA(0, 0), a2, voffA);
            PG8_WAIT_V(8); PG8_WAIT_L(0); PG8_BAR; PG8_MMA(1, 0, At, B0); PG8_MMA(1, 1, At, B1); PG8_BAR; PG8_SCHED;
            PG8_LDB(B0, 1, 0); PG8_LDB(B1, 1, 1); PG8_SCHED; PG8_LDA(At, 1, 0); PG8_STAGE(PG8_SA(0, 1), a2 + hstep, voffA);
            PG8_WAIT_V(8); PG8_WAIT_L(0); PG8_BAR; PG8_MMA(0, 0, At, B0); PG8_MMA(0, 1, At, B1); PG8_BAR; PG8_SCHED;
            PG8_LDA(At, 1, 1); PG8_STAGE(PG8_SB(1, 0), b3, voffB); PG8_STAGE(PG8_SB(1, 1), b3 + hstep, voffB); PG8_STAGE(PG8_SA(1, 0), a3, voffA);
            PG8_WAIT_V(8); PG8_WAIT_L(0); PG8_BAR; PG8_MMA(1, 0, At, B0); PG8_MMA(1, 1, At, B1); PG8_BAR; PG8_SCHED;
        }
        if (wr == 0) PG8_BAR;
        E(acc, cur, wr, wc, fr, fq, xlds);
        if (!has_next) break;
#pragma unroll
        for (int a = 0; a < 2; ++a)
#pragma unroll
            for (int b = 0; b < 2; ++b)
#pragma unroll
                for (int m = 0; m < 4; ++m)
#pragma unroll
                    for (int n = 0; n < 2; ++n) acc[a][b][m][n] = (f32x4){0.f, 0.f, 0.f, 0.f};
        cur = nxt; cA = nA; cB = nB; ++ui;
        if (wr == 1) PG8_BAR;
    }
    PG8_WAIT_V(0);
    PG8_BAR;
#undef PG8_SA
#undef PG8_SB
#undef PG8_STAGE
#undef PG8_LDA
#undef PG8_LDB
#undef PG8_MMA
#undef PG8_WAIT_V
#undef PG8_WAIT_L
#undef PG8_BAR
#undef PG8_SCHED
}
}

__device__ __forceinline__ void p5b_fixup(const Ptrs& P, int gtid, int nthreads) {
    const float* HALO = (const float*)(P.ws + WS_HALO); const float* FIXP = (const float*)(P.ws + WS_FIXP); const float* FIXU = (const float*)(P.ws + WS_FIXU); h16* ACT = (h16*)(P.ws + WS_ACT);
    for (int e = gtid; e < 64 * 2 * (FF / 4); e += nthreads) {
        const int c = (e % (FF / 4)) * 4, i = (e / (FF / 4)) & 1, pm = e / (2 * (FF / 4));
        if ((pm & 15) == 0) continue;
        const f32x4 p = *(const f32x4*)(FIXP + (size_t)(pm * 2 + i) * FF + c), uu = *(const f32x4*)(FIXU + (size_t)(pm * 2 + i) * FF + c);
        const f32x4 h0 = *(const f32x4*)(HALO + (size_t)((pm - 1) * 2 + 0) * FF + c), h1 = *(const f32x4*)(HALO + (size_t)((pm - 1) * 2 + 1) * FF + c);
        const f32x4 w0 = *(const f32x4*)(P.conv_w + c), w1 = *(const f32x4*)(P.conv_w + FF + c);
        f32x4 pre;
        if (i == 0) pre = p + w0 * h0 + w1 * h1; else pre = p + w0 * h1;
        const unsigned lo = pk2h(gelu_tanh(pre[0]) * uu[0], gelu_tanh(pre[1]) * uu[1]), hi = pk2h(gelu_tanh(pre[2]) * uu[2], gelu_tanh(pre[3]) * uu[3]);
        *(unsigned long long*)(ACT + (size_t)(pm * 256 + i) * FF + c) = (unsigned long long)lo | ((unsigned long long)hi << 32);
    }
}


#define XB_TMO      128
#define XB_XCNT(j)  (256  + 64 * (j))
#define XB_XSUB(j)  (1280 + 64 * (j))
#define XB_XGEN(j)  (2304 + 64 * (j))
#define XB_TOP      3328
#define XB_TOPGEN   3392
#define XCD_BAR_WORDS 3456
#define XB_SPIN_CAP (1u << 18)
__device__ __forceinline__ unsigned xb_ld(unsigned* p)              { return __hip_atomic_load(p, __ATOMIC_RELAXED, __HIP_MEMORY_SCOPE_AGENT); }
__device__ __forceinline__ unsigned xb_add(unsigned* p, unsigned v) { return __hip_atomic_fetch_add(p, v, __ATOMIC_RELAXED, __HIP_MEMORY_SCOPE_AGENT); }
__device__ __forceinline__ unsigned xb_xcc_id() { return (unsigned)__builtin_amdgcn_s_getreg((3 << 11) | 20) & 0xFu; }
#define XB_SPIN(cond, bar) do { unsigned _sp = 0; while (cond) { __builtin_amdgcn_s_sleep(1); \
    if ((++_sp & 255u) == 0u) { if (xb_ld(&(bar)[XB_TMO])) break; if (_sp > XB_SPIN_CAP) { atomicAdd(&(bar)[XB_TMO], 1u); break; } } } } while (0)
struct XcdBarrier { unsigned* bar; unsigned x; volatile LAS unsigned* st; };
__device__ __forceinline__ XcdBarrier xcd_barrier_post(unsigned* bar, volatile LAS unsigned* st) {
    XcdBarrier b; b.bar = bar; b.x = xb_xcc_id(); b.st = st;
    if (threadIdx.x == 0) (void)xb_add(&bar[XB_XCNT(b.x)], 1u);
    return b;
}
__device__ __forceinline__ void xcd_barrier_complete(unsigned* bar, unsigned x, unsigned& nloc, unsigned& nx) {
    const unsigned G = gridDim.x * gridDim.y * gridDim.z;
    unsigned sum, cnt, mine, sp = 0u;
    for (;;) {
        sum = 0u; cnt = 0u; mine = 0u;
#pragma unroll
        for (unsigned j = 0; j < 16; ++j) { const unsigned c = xb_ld(&bar[XB_XCNT(j)]); sum += c; cnt += (c > 0u) ? 1u : 0u; mine = (j == x) ? c : mine; }
        if (sum == G) break;
        __builtin_amdgcn_s_sleep(1);
        if ((++sp & 255u) == 0u) { if (xb_ld(&bar[XB_TMO])) break; if (sp > XB_SPIN_CAP) { atomicAdd(&bar[XB_TMO], 1u); break; } }
    }
    nloc = mine > 0u ? mine : 1u; nx = cnt > 0u ? cnt : 1u;
}
__device__ __forceinline__ void xcd_barrier(const XcdBarrier& b) {
    asm volatile("s_waitcnt vmcnt(0)" ::: "memory");
    __syncthreads();
    if (threadIdx.x == 0) {
        unsigned* bar = b.bar;
        __builtin_amdgcn_s_waitcnt(0);
        unsigned nloc = b.st[0], nx = b.st[1];
        if (nloc == 0u) { xcd_barrier_complete(bar, b.x, nloc, nx); b.st[0] = nloc; b.st[1] = nx; }
        const unsigned old = xb_add(&bar[XB_XSUB(b.x)], 1u);
        const unsigned gen = old / nloc;
        if (old + 1u == (gen + 1u) * nloc) {
            __builtin_amdgcn_fence(__ATOMIC_RELEASE, "agent");
            asm volatile("s_waitcnt vmcnt(0)" ::: "memory");
            const unsigned og = xb_add(&bar[XB_TOP], 1u);
            const unsigned tg = og / nx;
            if (og + 1u == (tg + 1u) * nx) xb_add(&bar[XB_TOPGEN], 1u);
            else XB_SPIN(xb_ld(&bar[XB_TOPGEN]) == tg, bar);
            __builtin_amdgcn_fence(__ATOMIC_ACQUIRE, "agent");
            xb_add(&bar[XB_XGEN(b.x)], 1u);
            asm volatile("s_waitcnt vmcnt(0)" ::: "memory");
        } else {
            XB_SPIN(xb_ld(&bar[XB_XGEN(b.x)]) == gen, bar);
            __builtin_amdgcn_fence(__ATOMIC_ACQUIRE, "agent");
            asm volatile("s_waitcnt vmcnt(0)" ::: "memory");
        }
    }
    __syncthreads();
}

namespace att {
constexpr int NW = 8, QBLK = 32, KVBLK = 64, QB = NW * QBLK;
constexpr int SHM_V = KVBLK * HD * 2, SHM_K = KVBLK * HD * 2;
constexpr int LDS_BYTES = 2 * SHM_V + 2 * SHM_K + NW * 64 * 4;
constexpr float THR = 8.f;
typedef short s16x4 __attribute__((ext_vector_type(4)));
typedef short s16x8 __attribute__((ext_vector_type(8)));
typedef float f32x16 __attribute__((ext_vector_type(16)));
#define KSWZ(row, colB) ((row) * 256 + ((colB) ^ (((row) & 7) << 4)))
#define SBAR() __builtin_amdgcn_sched_barrier(0)
__device__ __forceinline__ int v_st(int k, int c) { const int kk = (k & ~0xC) | ((k & 4) << 1) | ((k & 8) >> 1); return ((kk >> 3) * 4 + (c >> 5)) * 512 + ((kk & 7) * 32 + (c & 31)) * 2; }
__device__ __forceinline__ int v_rd_base(int lane) { return ((lane & 3) << 3) | (((lane >> 2) & 3) << 6) | (((lane >> 4) & 1) << 5) | (((lane >> 5) & 1) << 8); }
constexpr int v_rd_off(int d0, int ks, int half) { return d0 * 512 + ks * 4096 + half * 2048; }
__device__ __forceinline__ int crow(int r, int hi) { return (r & 3) + 8 * (r >> 2) + 4 * hi; }
__device__ __forceinline__ h16x8 load8(const h16* p) { return *reinterpret_cast<const h16x8*>(p); }
__device__ __forceinline__ void mask_tile(f32x16& p0, f32x16& p1, int dq, unsigned W) {
    const float NEG = -__builtin_inff();
#pragma unroll
    for (int r = 0; r < 16; ++r) {
        const int c = (r & 3) + 8 * (r >> 2);
        if ((unsigned)(dq - c) >= W) p0[r] = NEG;
        if ((unsigned)(dq - c - 32) >= W) p1[r] = NEG;
    }
}
__device__ __forceinline__ void kill_tile(f32x16& p0, f32x16& p1, bool dead) {
    const float NEG = -__builtin_inff();
#pragma unroll
    for (int r = 0; r < 16; ++r) { p0[r] = dead ? NEG : p0[r]; p1[r] = dead ? NEG : p1[r]; }
}
__device__ __forceinline__ void partialSM(f32x16& p0, f32x16& p1, float& m_reg, float& mn, float& alpha) {
    float pmax = p0[0];
#pragma unroll
    for (int r = 1; r < 16; ++r) pmax = fmaxf(pmax, p0[r]);
#pragma unroll
    for (int r = 0; r < 16; ++r) pmax = fmaxf(pmax, p1[r]);
    { auto rr = __builtin_amdgcn_permlane32_swap(__float_as_uint(pmax), __float_as_uint(pmax), false, false);
      pmax = fmaxf(__uint_as_float(rr[0]), __uint_as_float(rr[1])); }
    constexpr float C2 = 1.4426950408889634f * SCALE;
    if (__builtin_expect(__all((pmax - m_reg) * SCALE <= THR), 1)) { mn = m_reg; alpha = 1.f; }
    else { mn = fmaxf(m_reg, pmax); alpha = __builtin_amdgcn_exp2f((m_reg - mn) * C2); m_reg = mn; }
    const float mnL = -mn * C2;
#pragma unroll
    for (int r = 0; r < 16; ++r) p0[r] = fmaf(p0[r], C2, mnL);
#pragma unroll
    for (int r = 0; r < 16; ++r) p1[r] = fmaf(p1[r], C2, mnL);
#pragma unroll
    for (int r = 0; r < 16; ++r) p0[r] = __builtin_amdgcn_exp2f(p0[r]);
}
__device__ __forceinline__ void finishSM(f32x16& p0, f32x16& p1, float alpha, float& l_reg, h16x8& pa0, h16x8& pa1, h16x8& pa2, h16x8& pa3) {
#pragma unroll
    for (int r = 0; r < 16; ++r) p1[r] = __builtin_amdgcn_exp2f(p1[r]);
    float ps = 0;
#pragma unroll
    for (int r = 0; r < 16; ++r) ps += p0[r];
#pragma unroll
    for (int r = 0; r < 16; ++r) ps += p1[r];
    { auto rr = __builtin_amdgcn_permlane32_swap(__float_as_uint(ps), __float_as_uint(ps), false, false);
      ps = __uint_as_float(rr[0]) + __uint_as_float(rr[1]); }
    l_reg = l_reg * alpha + ps;
#define PK4(P, B_, OUT) do { unsigned a0 = pk2h(P[B_+0], P[B_+1]), a1 = pk2h(P[B_+2], P[B_+3]);                          \
        unsigned b0 = pk2h(P[B_+4], P[B_+5]), b1 = pk2h(P[B_+6], P[B_+7]);                                             \
        auto r0 = __builtin_amdgcn_permlane32_swap(a0, b0, false, false); auto r1 = __builtin_amdgcn_permlane32_swap(a1, b1, false, false); \
        u32x4 w = {r0[0], r1[0], r0[1], r1[1]}; OUT = __builtin_bit_cast(h16x8, w); } while (0)
    PK4(p0, 0, pa0); PK4(p0, 8, pa1); PK4(p1, 0, pa2); PK4(p1, 8, pa3);
#undef PK4
}
template <int KB>
__device__ __forceinline__ void qkt(f32x16& p0, f32x16& p1, const char* K_lds, int r32, int hi, const h16x8* qr, bool act) {
    if (!act) { const float NEG = -__builtin_inff();
#pragma unroll
        for (int r = 0; r < 16; ++r) { p0[r] = NEG; p1[r] = NEG; } return; }
    p0 = f32x16{}; p1 = f32x16{};
    const char* kb[4];
#pragma unroll
    for (int dd = 0; dd < 4; ++dd) kb[dd] = K_lds + KB * SHM_K + KSWZ(r32, (dd * 16 + hi * 8) * 2);
#pragma unroll
    for (int d0 = 0; d0 < 8; ++d0) { const char* a = kb[d0 & 3] + (d0 >> 2) * 128;
        h16x8 b0 = *reinterpret_cast<const h16x8*>(a);
        h16x8 b1 = *reinterpret_cast<const h16x8*>(a + 32 * 256);
        p0 = __builtin_amdgcn_mfma_f32_32x32x16_f16(b0, qr[d0], p0, 0, 0, 0);
        p1 = __builtin_amdgcn_mfma_f32_32x32x16_f16(b1, qr[d0], p1, 0, 0, 0); }
}
template <int VB>
__device__ __forceinline__ void pv_tile(f32x16* o, int vb0, h16x8 pa0, h16x8 pa1, h16x8 pa2, h16x8 pa3, bool act) {
    if (!act) return;
#define TRRD(dst, off) asm volatile("ds_read_b64_tr_b16 %0, %1 offset:%2" : "=&v"(dst) : "v"(vb0), "i"(off) : "memory")
#define MKB(l, h) __builtin_bit_cast(h16x8, (s16x8){l[0], l[1], l[2], l[3], h[0], h[1], h[2], h[3]})
#define PV_D0(d0) do { s16x4 l0, l1, l2, l3, h0, h1, h2, h3; constexpr int b_ = VB * SHM_V + v_rd_off(d0, 0, 0); \
        TRRD(l0, b_); TRRD(h0, b_ + 2048); TRRD(l1, b_ + 4096); TRRD(h1, b_ + 6144); TRRD(l2, b_ + 8192); TRRD(h2, b_ + 10240); TRRD(l3, b_ + 12288); TRRD(h3, b_ + 14336); \
        asm volatile("s_waitcnt lgkmcnt(0)" ::: "memory"); SBAR();   \
        o[d0] = __builtin_amdgcn_mfma_f32_32x32x16_f16(pa0, MKB(l0, h0), o[d0], 0, 0, 0);   \
        o[d0] = __builtin_amdgcn_mfma_f32_32x32x16_f16(pa1, MKB(l1, h1), o[d0], 0, 0, 0);   \
        o[d0] = __builtin_amdgcn_mfma_f32_32x32x16_f16(pa2, MKB(l2, h2), o[d0], 0, 0, 0);   \
        o[d0] = __builtin_amdgcn_mfma_f32_32x32x16_f16(pa3, MKB(l3, h3), o[d0], 0, 0, 0); } while (0)
    PV_D0(0); PV_D0(1); PV_D0(2); PV_D0(3);
#undef PV_D0
#undef MKB
#undef TRRD
}

struct BlockRef { const h16* K; h16* Ob; float* LSE; const float* KS; int P0, pitch, opitch, W, lsestride, moba; };
struct Seam { h16x8 qr[8]; h16x8 st_v0, st_v1, st_k0, st_k1; };
__device__ __forceinline__ int swa_jlo(int P0, int W) { const int lowk = P0 - W + 1; return lowk > 0 ? lowk / KVBLK : 0; }
#define VMW() asm volatile("s_waitcnt vmcnt(0)" ::: "memory")
#define VMWN(n) asm volatile("s_waitcnt vmcnt(%0)" :: "i"(n) : "memory")
#define SLOAD_H(Kt, o0, o1) do { S.st_v0 = load8((Kt) + 1024 + (o0)); S.st_v1 = load8((Kt) + 1024 + (o1));              \
                         S.st_k0 = load8((Kt) + (o0)); S.st_k1 = load8((Kt) + (o1)); } while (0)
#define SWRITE_HK(bf) do { *(h16x8*)(K_lds + (bf) * SHM_K + kws) = S.st_k0; *(h16x8*)(K_lds + (bf) * SHM_K + kws + 32 * 256) = S.st_k1; } while (0)
#define SWRITE_HV(bf) do { *(h16x8*)(V_lds + (bf) * SHM_V + vst0) = S.st_v0; *(h16x8*)(V_lds + (bf) * SHM_V + vst1) = S.st_v1; } while (0)
#define SWRITE_H(bf) do { SWRITE_HV(bf); SWRITE_HK(bf); } while (0)
__device__ __forceinline__ void attn_prime(const BlockRef& cur, char* lds, Seam& S) {
    const int tid = threadIdx.x, wid = __builtin_amdgcn_readfirstlane(tid >> 6), lane = tid & 63, r32 = lane & 31, hi = lane >> 5;
    const int sr = tid >> 4, sc = (tid & 15) * 8, kws = KSWZ(sr, sc * 2); char* K_lds = lds + 2 * SHM_V;
    const int kb0 = swa_jlo(cur.P0, cur.W) * KVBLK;
    const h16* Qw = cur.K - 1024 + (size_t)(cur.P0 + wid * QBLK) * cur.pitch;
    const unsigned qo = (unsigned)(r32 * cur.pitch + hi * 8);
#pragma unroll
    for (int d0 = 0; d0 < 8; ++d0) S.qr[d0] = load8(Qw + qo + d0 * 16);
    { const unsigned o0 = (unsigned)(sr * cur.pitch + sc), o1 = o0 + 32u * (unsigned)cur.pitch; const h16* Kt = cur.K + (size_t)kb0 * cur.pitch;
      SLOAD_H(Kt, o0, o1); } VMW(); SWRITE_HK(0);
    __syncthreads();
}
__device__ __forceinline__ void attn_block(const BlockRef& cur, const BlockRef& nxt, char* lds, Seam& S) {
    const int tid = threadIdx.x, wid = __builtin_amdgcn_readfirstlane(tid >> 6), lane = tid & 63, r32 = lane & 31, hi = lane >> 5;
    const int W = cur.W;
    const int j_lo = swa_jlo(cur.P0, W);
    const int j_hi = (cur.P0 + QB - 1) / KVBLK + 1;
    const int NT = j_hi - j_lo;
    const int kbn = swa_jlo(nxt.P0, nxt.W) * KVBLK;
    const int qlo = cur.P0 + wid * QBLK, qm = qlo + r32 - 4 * hi;
    char* V_lds = lds; char* K_lds = lds + 2 * SHM_V;
    float* ws = (float*)(lds + 2 * SHM_V + 2 * SHM_K) + wid * 64; float* li_l = ws, * al_l = ws + 32;
    float m_reg = -1e30f, l_reg = 0; f32x16 o[4] = {};
    const int sr = tid >> 4, sc = (tid & 15) * 8, vst0 = v_st(sr, sc), vst1 = v_st(32 + sr, sc), kws = KSWZ(sr, sc * 2);
    const int vb0 = (int)(uintptr_t)V_lds + v_rd_base(lane);
    const h16* Kh = cur.K; const int pitch = cur.pitch;
    const unsigned so0 = (unsigned)(sr * pitch + sc), so1 = so0 + 32u * (unsigned)pitch;
#define KTILE(t) (Kh + (size_t)KBASE(t) * pitch)
    unsigned selmask = 0xffffffffu;
    if (cur.moba) {
        const int qblk = cur.P0 >> 8;
        f32x16 gacc = f32x16{};
#pragma unroll
        for (int d0 = 0; d0 < 8; ++d0) {
            f32x4 a0 = {0.f, 0.f, 0.f, 0.f}, a1 = a0;
            if (r32 < qblk) { const float* kp = cur.KS + (size_t)(r32 * 2) * 1024 + d0 * 16 + hi * 8;
                a0 = *(const f32x4*)kp + *(const f32x4*)(kp + 1024); a1 = *(const f32x4*)(kp + 4) + *(const f32x4*)(kp + 1024 + 4); }
            a0 = a0 * (1.0f / 256.0f); a1 = a1 * (1.0f / 256.0f);
            u32x4 w = {pk2h(a0[0], a0[1]), pk2h(a0[2], a0[3]), pk2h(a1[0], a1[1]), pk2h(a1[2], a1[3])};
            gacc = __builtin_amdgcn_mfma_f32_32x32x16_f16(__builtin_bit_cast(h16x8, w), S.qr[d0], gacc, 0, 0, 0);
        }
        float gb[16];
#pragma unroll
        for (int j = 0; j < 16; ++j) { const int rj = (j & 3) + 4 * (j >> 3); const float own = gacc[rj]; const float oth = __shfl_xor(own, 32);
            gb[j] = (hi == ((j >> 2) & 1)) ? own : oth; }
        unsigned sel = 0u;
#pragma unroll
        for (int rnd = 0; rnd < 3; ++rnd) { float best = -3.0e38f; int bi = -1;
#pragma unroll
            for (int j = 0; j < 15; ++j) { const bool ok = (j < qblk) && !((sel >> j) & 1u) && (gb[j] > best); best = ok ? gb[j] : best; bi = ok ? j : bi; }
            if (bi >= 0) sel |= 1u << bi; }
        selmask = sel | (1u << qblk);
    }
#define RESC(a) do { if (__any((a) < 1.f)) { if (hi == 0) al_l[r32] = (a); asm volatile("s_waitcnt lgkmcnt(0)" ::: "memory");              \
                     _Pragma("unroll") for (int d_ = 0; d_ < 4; ++d_) _Pragma("unroll") for (int r = 0; r < 16; ++r) o[d_][r] *= al_l[crow(r, hi)]; } } while (0)
#define KBASE(t) ((j_lo + (t)) * KVBLK)
#define SELB(t) (((selmask >> (KBASE(t) >> 8)) & 1u) != 0u)
#define ACT(t) (KBASE(t) <= qlo + QBLK - 1 && KBASE(t) + KVBLK - 1 >= qlo - W + 1 && (!cur.moba || __any(SELB(t))))
#define MASKT(P0_, P1_, t) do { const int kb_ = KBASE(t); if (ACT(t)) { if (kb_ + KVBLK - 1 > qlo || kb_ <= qlo + QBLK - 1 - W) mask_tile(P0_, P1_, qm - kb_, (unsigned)W); \
                                 if (cur.moba && !__all(SELB(t))) kill_tile(P0_, P1_, !SELB(t)); } } while (0)
    constexpr int NQL = 8;
#define SEAM_K0() do { VMWN(NQL); SWRITE_HK(0); SBAR(); } while (0)
    f32x16 pA0, pA1, pB0, pB1; float mnA, mnB, alA, alB; h16x8 pa0, pa1, pa2, pa3;
    SWRITE_HV(0); SBAR();
    if (NT > 1) { SLOAD_H(KTILE(1), so0, so1); }
    SBAR(); qkt<0>(pA0, pA1, K_lds, r32, hi, S.qr, ACT(0));
    MASKT(pA0, pA1, 0); partialSM(pA0, pA1, m_reg, mnA, alA);
    if (NT > 1) { VMW(); SWRITE_H(1); }
    __syncthreads();
#define HALF_STEP(PX0, PX1, mnX, alX, PY0, PY1, alY, t, KB, VB, SB) do {                                                      \
        SBAR(); qkt<KB>(PX0, PX1, K_lds, r32, hi, S.qr, ACT(t));                                             \
        finishSM(PY0, PY1, alY, l_reg, pa0, pa1, pa2, pa3); SBAR();                                                           \
        if ((t) + 1 < NT) { SLOAD_H(KTILE((t) + 1), so0, so1); SBAR(); }                                               \
        pv_tile<VB>(o, vb0, pa0, pa1, pa2, pa3, ACT((t) - 1)); MASKT(PX0, PX1, (t)); partialSM(PX0, PX1, m_reg, mnX, alX);                                        \
        __syncthreads();                                                                                                      \
        if ((t) + 1 < NT) { VMW(); SWRITE_H(SB); }                                                                          \
        RESC(alX); __syncthreads(); } while (0)
    for (int t = 1; t + 1 < NT; t += 2) {
        HALF_STEP(pB0, pB1, mnB, alB, pA0, pA1, alA, t, 1, 0, 0);
        HALF_STEP(pA0, pA1, mnA, alA, pB0, pB1, alB, t + 1, 0, 1, 1);
    }
    const bool even = (NT & 1) == 0;
    if (even) { SBAR(); qkt<1>(pB0, pB1, K_lds, r32, hi, S.qr, ACT(NT - 1)); SBAR(); }
    { const unsigned n0 = (unsigned)(sr * nxt.pitch + sc), n1 = n0 + 32u * (unsigned)nxt.pitch; const h16* Kt = nxt.K + (size_t)kbn * nxt.pitch;
      SLOAD_H(Kt, n0, n1); SBAR();
      const h16* Qw = nxt.K - 1024 + (size_t)(nxt.P0 + wid * QBLK) * nxt.pitch; const unsigned qo = (unsigned)(r32 * nxt.pitch + hi * 8);
#pragma unroll
      for (int d0 = 0; d0 < 8; ++d0) S.qr[d0] = load8(Qw + qo + d0 * 16); }
    SBAR();
    finishSM(pA0, pA1, alA, l_reg, pa0, pa1, pa2, pa3); SBAR();
    pv_tile<0>(o, vb0, pa0, pa1, pa2, pa3, ACT(even ? NT - 2 : NT - 1));
    if (even) { MASKT(pB0, pB1, NT - 1); partialSM(pB0, pB1, m_reg, mnB, alB); __syncthreads(); RESC(alB);
        finishSM(pB0, pB1, alB, l_reg, pa0, pa1, pa2, pa3); SBAR(); pv_tile<1>(o, vb0, pa0, pa1, pa2, pa3, ACT(NT - 1)); }
    SBAR(); SEAM_K0();
    if (hi == 0) { li_l[r32] = l_reg; if (cur.LSE) cur.LSE[(size_t)(wid * QBLK + r32) * cur.lsestride] = m_reg * SCALE + __logf(l_reg); }
    asm volatile("s_waitcnt lgkmcnt(0)" ::: "memory");
    float rli[16];
#pragma unroll
    for (int r = 0; r < 16; ++r) rli[r] = __builtin_amdgcn_rcpf(li_l[crow(r, hi)]);
    h16* Ow = cur.Ob + (size_t)(cur.P0 + wid * QBLK) * cur.opitch;
    const unsigned olane = (unsigned)(4 * hi * cur.opitch + r32);
#pragma unroll
    for (int r = 0; r < 16; ++r) { h16* rp = Ow + (size_t)(((r & 3) + 8 * (r >> 2)) * cur.opitch);
#pragma unroll
        for (int d0 = 0; d0 < 4; ++d0) { const float v = o[d0][r] * rli[r];
            const float vn = __shfl_xor(v, 1);
            if ((r32 & 1) == 0) *(unsigned*)(rp + olane + d0 * 32) = pk2h(v, vn); } }
    __syncthreads();
#undef RESC
#undef KBASE
#undef SELB
#undef ACT
#undef MASKT
#undef SEAM_K0
#undef HALF_STEP
#undef KTILE
}
#undef ROWP
#undef VMW
#undef VMWN
#undef SLOAD_H
#undef SWRITE_HK
#undef SWRITE_HV
#undef SWRITE_H

__device__ __forceinline__ BlockRef unit_ref(int idx, unsigned char* ws) {
    const h16* QKV = (const h16*)(ws + WS_QKV);
    BlockRef R;
    if (idx < 512) { const int qb = 15 - (idx >> 5), bh = idx & 31, b = bh >> 3, h = bh & 7;
        const size_t tok0 = (size_t)b * SEQ;
        R.K = QKV + tok0 * NQKV + 1024 + h * HD;
        R.Ob = (h16*)(ws + WS_OA) + tok0 * 1024 + h * HD; R.LSE = nullptr; R.KS = (const float*)(ws + WS_KSUM) + (size_t)(b * 16 * 2) * 1024 + h * HD;
        R.P0 = qb * 256; R.pitch = NQKV; R.opitch = 1024; R.W = 1 << 30; R.lsestride = 0; R.moba = 1; }
    else { const int j = idx - 512, g = j >> 9, rem = j & 511, bh = rem & 31, sub = rem >> 5, b = bh >> 3, h = bh & 7;
        const int d = (g == 0) ? 1 : (g == 1) ? 4 : 16, nqb = 16 / d, r = sub / nqb, qb = sub % nqb;
        const size_t tok0 = (size_t)b * SEQ + r, tokq = tok0 + (size_t)d * qb * 256;
        R.K = QKV + tok0 * NQKV + 4096 + h * HD;
        h16* OBg = (h16*)(ws + (g == 0 ? WS_OB0 : g == 1 ? WS_OB1 : WS_OB2));
        R.Ob = OBg + tok0 * 1024 + h * HD; R.LSE = (float*)(ws + WS_LSE) + ((size_t)g * M + tokq) * 8 + h; R.KS = nullptr;
        R.P0 = qb * 256; R.pitch = NQKV * d; R.opitch = 1024 * d; R.W = 129; R.lsestride = 8 * d; R.moba = 0; }
    return R;
}
constexpr int NUNITS = 2048;
__device__ __forceinline__ int unit_pos(int k, int G, int w) { return (k & 1) ? (k + 1) * G - 1 - w : k * G + w; }
__device__ __forceinline__ void attn_phase(char* lds, unsigned char* ws, int G, int w) {
    int k = 0; int p = unit_pos(0, G, w); if (p >= NUNITS) return;
    BlockRef cur = unit_ref(p, ws);
    Seam S;
    attn_prime(cur, lds, S);
    for (;;) {
        const int pn = unit_pos(k + 1, G, w); const bool last = pn >= NUNITS;
        const BlockRef nxt = last ? cur : unit_ref(pn, ws);
        attn_block(cur, nxt, lds, S);
        if (last) break;
        cur = nxt; ++k;
    }
}
#undef KSWZ
#undef SBAR
}

constexpr int MK_LDS_BYTES = 147456, MK_XLDS_OFF = 131072;
struct MkArgs { Ptrs P; int ph_lo, ph_hi; };
namespace cg = cooperative_groups;
__global__ void __launch_bounds__(512, 2) mk_fwd(MkArgs a) {
    cg::grid_group grid = cg::this_grid();
    extern __shared__ __attribute__((aligned(16))) unsigned char lds_raw[];
    LAS unsigned char* lds = (LAS unsigned char*)lds_raw;
    const Ptrs& P = a.P;
    if (a.ph_lo < 0) grid.sync();
    volatile LAS unsigned* xst = (volatile LAS unsigned*)(lds + MK_XLDS_OFF + 8192);
    if (threadIdx.x < 4) xst[threadIdx.x] = 0u;
    __syncthreads();
    XcdBarrier xbar = xcd_barrier_post((unsigned*)(a.P.ws + WS_CTL), xst);

    const int tid = threadIdx.x, lane = tid & 63, wave = __builtin_amdgcn_readfirstlane(tid >> 6);
    const int G = gridDim.x, gw = blockIdx.x * 8 + wave, NGW = G * 8;
    unsigned char* ws = P.ws;
#define IN(k) (a.ph_lo <= (k) && (k) < a.ph_hi)
#if USE_CG_SYNC
#define SEAM(k) do { if (IN(k) && IN((k) + 1)) grid.sync(); } while (0)
#else
#define SEAM(k) do { if (IN(k) && IN((k) + 1)) xcd_barrier(xbar); } while (0)
#endif
    if (IN(0)) p0_prologue(P, (LAS float*)lds + wave * 64 * 33, gw, NGW, lane);
    SEAM(0);
    if (IN(1)) { pg8::Gemm g{(const h16*)(ws + WS_XN), (const h16*)(ws + WS_WQKV), M, NQKV, DM}; pg8::StaticOrder S; S.init(M, NQKV, G, (int)blockIdx.x);
        pg8::EpiQKV E{(h16*)(ws + WS_QKV), (const f32x2*)(ws + WS_CS), (float*)(ws + WS_KSUM)};
        pg8::gemm_phase<pg8::EpiQKV, pg8::StaticOrder>(lds, lds + MK_XLDS_OFF, g, S, E); }
    SEAM(1);
    if (IN(2)) att::attn_phase((char*)lds_raw, ws, G, (int)blockIdx.x);
    SEAM(2);
    if (IN(3)) { for (int m = gw; m < M; m += NGW) p3_row(P, m, lane); }
    SEAM(3);
    if (IN(4)) { pg8::Gemm g{(const h16*)(ws + WS_MIX), (const h16*)(ws + WS_WO), M, DM, DM}; pg8::StaticOrder S; S.init(M, DM, G, (int)blockIdx.x);
        pg8::EpiY E{(h16*)(ws + WS_Y), (float*)(ws + WS_SS)};
        pg8::gemm_phase<pg8::EpiY, pg8::StaticOrder>(lds, lds + MK_XLDS_OFF, g, S, E); }
    SEAM(4);
    if (IN(5)) { for (int m = gw; m < M; m += NGW)
        resid_row<true>(P.x + (size_t)m * DM, (const h16*)(ws + WS_Y) + (size_t)m * DM, (const float*)(ws + WS_SS) + (size_t)m * 32, P.g_attn_post, P.g_ffn_pre,
                        P.out + (size_t)m * DM, (h16*)(ws + WS_XN2) + (size_t)m * DM, lane); }
    SEAM(5);
    if (IN(6)) { pg8::Gemm g{(const h16*)(ws + WS_XN2), (const h16*)(ws + WS_WGU), M, 2 * FF, DM}; pg8::StaticOrder S; S.init(M, 2 * FF, G, (int)blockIdx.x);
        pg8::EpiGU E{(h16*)(ws + WS_ACT), P.conv_w, P.conv_b, (float*)(ws + WS_HALO), (float*)(ws + WS_FIXP), (float*)(ws + WS_FIXU)};
        pg8::gemm_phase<pg8::EpiGU, pg8::StaticOrder>(lds, lds + MK_XLDS_OFF, g, S, E); }
    SEAM(6);
    if (IN(7)) p5b_fixup(P, blockIdx.x * 512 + tid, G * 512);
    SEAM(7);
    if (IN(8)) { pg8::Gemm g{(const h16*)(ws + WS_ACT), (const h16*)(ws + WS_WD), M, DM, FF}; pg8::StaticOrder S; S.init(M, DM, G, (int)blockIdx.x);
        pg8::EpiY E{(h16*)(ws + WS_Y2), (float*)(ws + WS_SS)};
        pg8::gemm_phase<pg8::EpiY, pg8::StaticOrder>(lds, lds + MK_XLDS_OFF, g, S, E); }
    SEAM(8);
    if (IN(9)) { for (int m = gw; m < M; m += NGW)
        resid_row<false>(P.out + (size_t)m * DM, (const h16*)(ws + WS_Y2) + (size_t)m * DM, (const float*)(ws + WS_SS) + (size_t)m * 32, P.g_ffn_post, nullptr,
                         P.out + (size_t)m * DM, nullptr, lane); }
#undef IN
#undef SEAM
}

extern "C" void kernel_launch(void* const* d_in, const int* in_sizes, int n_in, void* d_out, int out_size, void* d_ws, size_t ws_size, hipStream_t stream) {
    if (n_in != 15 || ws_size < WS_END) { fprintf(stderr, "kernel_launch: unexpected n_in %d or ws_size %zu (need %zu)\n", n_in, ws_size, (size_t)WS_END); return; }
    static int grid = 0;
    if (grid == 0) {
        int dev = 0, cus = 0, per_cu = 0;
        (void)hipGetDevice(&dev); (void)hipDeviceGetAttribute(&cus, hipDeviceAttributeMultiprocessorCount, dev);
        (void)hipFuncSetAttribute((const void*)mk_fwd, hipFuncAttributeMaxDynamicSharedMemorySize, MK_LDS_BYTES);
        (void)hipOccupancyMaxActiveBlocksPerMultiprocessor(&per_cu, (const void*)mk_fwd, 512, MK_LDS_BYTES);
        if (per_cu < 1) per_cu = 1;
        grid = cus * per_cu;
        fprintf(stderr, "kernel_launch: cus %d per_cu %d grid %d\n", cus, per_cu, grid);
    }
    Ptrs P{};
    P.x = (const float*)d_in[0]; P.pos = (const int*)d_in[1]; P.g_attn_pre = (const float*)d_in[2]; P.w_qkv = (const float*)d_in[3]; P.g_moba = (const float*)d_in[4];
    P.g_dil = (const float*)d_in[5]; P.w_o = (const float*)d_in[6]; P.g_attn_post = (const float*)d_in[7]; P.g_ffn_pre = (const float*)d_in[8]; P.w_gate = (const float*)d_in[9];
    P.w_up = (const float*)d_in[10]; P.conv_w = (const float*)d_in[11]; P.conv_b = (const float*)d_in[12]; P.w_down = (const float*)d_in[13]; P.g_ffn_post = (const float*)d_in[14];
    P.out = (float*)d_out; P.ws = (unsigned char*)d_ws;
    unsigned char* ws = P.ws;
    MkArgs a{}; a.P = P;
    (void)hipMemsetAsync((char*)d_ws + WS_CTL, 0, 16384, stream);
#if ONE_LAUNCH
    a.ph_lo = 0; a.ph_hi = 10;
    { void* kargs[] = {&a};
      hipError_t e = hipLaunchCooperativeKernel((const void*)mk_fwd, dim3(grid), dim3(512), kargs, MK_LDS_BYTES, stream);
      if (e != hipSuccess) fprintf(stderr, "kernel_launch: cooperative launch failed: %s (grid %d)\n", hipGetErrorString(e), grid); }
    return;
#endif
#define MK(lo, hi) do { a.ph_lo = (lo); a.ph_hi = (hi); hipLaunchKernelGGL(mk_fwd, dim3(grid), dim3(512), MK_LDS_BYTES, stream, a); } while (0)
    MK(0, 1);
#if OPT_P1
    MK(1, 2);
#else
    for (int c = 0; c < 6; ++c) { float* scr = (float*)(ws + WS_NSCR1);
        nv_gemm<<<dim3(1024 / 64, M / 64), 256, 0, stream>>>((const h16*)(ws + WS_XN), DM, (const h16*)(ws + WS_WQKV) + (size_t)c * 1024 * DM, DM, scr, 1024, DM);
        nv_rope<<<(M * 1024) / 256, 256, 0, stream>>>(scr, (h16*)(ws + WS_QKV), (const f32x2*)(ws + WS_CS), c); }
    nv_ksum<<<(64 * 1024) / 256, 256, 0, stream>>>((const h16*)(ws + WS_QKV), (float*)(ws + WS_KSUM));
#endif
#if OPT_P2
    MK(2, 3);
#else
    for (int mode = 0; mode < 4; ++mode)
        nv_attn<<<4096, 256, 0, stream>>>((const h16*)(ws + WS_QKV), (const float*)(ws + WS_KSUM), (h16*)(ws + WS_OA), (h16*)(ws + WS_OB0), (h16*)(ws + WS_OB1), (h16*)(ws + WS_OB2), (float*)(ws + WS_LSE), mode);
#endif
    MK(3, 4);
#if OPT_P4
    MK(4, 5);
#else
    { float* scr = (float*)(ws + WS_NSCR4);
      nv_gemm<<<dim3(DM / 64, M / 64), 256, 0, stream>>>((const h16*)(ws + WS_MIX), DM, (const h16*)(ws + WS_WO), DM, scr, DM, DM);
      nv_cvt_ss<<<(M * 32) / 4, 256, 0, stream>>>(scr, DM, (h16*)(ws + WS_Y), 0, (float*)(ws + WS_SS)); }
#endif
    MK(5, 6);
#if OPT_P5
    MK(6, 7); MK(7, 8);
#else
    for (int c = 0; c < 32; ++c) { float* scr = (float*)(ws + WS_NSCR5);
        nv_gemm<<<dim3(512 / 64, M / 64), 256, 0, stream>>>((const h16*)(ws + WS_XN2), DM, (const h16*)(ws + WS_WGU) + (size_t)c * 512 * DM, DM, scr, 512, DM);
        nv_conv<<<(M * 256) / 256, 256, 0, stream>>>(scr, (h16*)(ws + WS_ACT), P.conv_w, P.conv_b, 2 * c); }
#endif
#if OPT_P6
    MK(8, 9);
#else
    for (int c = 0; c < 2; ++c) { float* scr = (float*)(ws + WS_NSCR6);
        nv_gemm<<<dim3(1024 / 64, M / 64), 256, 0, stream>>>((const h16*)(ws + WS_ACT), FF, (const h16*)(ws + WS_WD) + (size_t)c * 1024 * FF, FF, scr, 1024, FF);
        nv_cvt_ss<<<(M * 16) / 4, 256, 0, stream>>>(scr, 1024, (h16*)(ws + WS_Y2), c * 1024, (float*)(ws + WS_SS)); }
#endif
    MK(9, 10);
#undef MK
}
```

```cpp
#define OPT_P1 1
#define OPT_P2 1
#define OPT_P4 1
#define OPT_P5 1
#define OPT_P6 1
#define ONE_LAUNCH 1
#define USE_CG_SYNC 0
#include <hip/hip_runtime.h>
#include <hip/hip_cooperative_groups.h>
#include <cstdio>
#include <cstdint>

typedef _Float16 h16;
typedef h16 h16x8 __attribute__((ext_vector_type(8)));
typedef h16 h16x2 __attribute__((ext_vector_type(2)));
typedef float f32x4 __attribute__((ext_vector_type(4)));
typedef float f32x2 __attribute__((ext_vector_type(2)));
typedef unsigned u32x4 __attribute__((ext_vector_type(4)));
#define LAS __attribute__((address_space(3)))

constexpr int BATCH = 4, SEQ = 4096, DM = 2048, M = BATCH * SEQ, NQKV = 6144, FF = 8192, HD = 128, NH = 8;
constexpr float RMS_EPS = 1e-6f;
constexpr float SCALE = 0.08838834764831845f;
constexpr size_t MiB = 1u << 20;
constexpr size_t WS_CTL = 0, WS_CS = 1 * MiB, WS_KSUM = 3 * MiB, WS_SS = 4 * MiB, WS_LSE = 6 * MiB, WS_HALO = 8 * MiB, WS_FIXP = 12 * MiB, WS_FIXU = 16 * MiB;
constexpr size_t WS_WQKV = 24 * MiB, WS_WO = 48 * MiB, WS_WGU = 56 * MiB, WS_WD = 120 * MiB;
constexpr size_t WS_XN = 152 * MiB;
constexpr size_t WS_OB0 = 152 * MiB, WS_OB1 = 184 * MiB, WS_XN2 = 152 * MiB, WS_Y2 = 152 * MiB;
constexpr size_t WS_QKV = 216 * MiB;
constexpr size_t WS_MIX = 216 * MiB, WS_Y = 280 * MiB, WS_ACT = 216 * MiB;
constexpr size_t WS_OA = 408 * MiB, WS_OB2 = 440 * MiB;
constexpr size_t WS_NSCR1 = 408 * MiB;
constexpr size_t WS_NSCR4 = 344 * MiB;
constexpr size_t WS_NSCR5 = 472 * MiB;
constexpr size_t WS_NSCR6 = 24 * MiB;
constexpr size_t WS_END = 512 * MiB;

struct Ptrs {
    const float* x; const int* pos; const float* g_attn_pre; const float* w_qkv; const float* g_moba; const float* g_dil; const float* w_o;
    const float* g_attn_post; const float* g_ffn_pre; const float* w_gate; const float* w_up; const float* conv_w; const float* conv_b;
    const float* w_down; const float* g_ffn_post; float* out; unsigned char* ws;
};

__device__ __forceinline__ unsigned pk2h(float lo, float hi) { f32x2 v = {lo, hi}; h16x2 b = __builtin_convertvector(v, h16x2); return __builtin_bit_cast(unsigned, b); }
__device__ __forceinline__ unsigned pk4f8(float a, float b, float c, float d) {
    a = fminf(fmaxf(a, -448.f), 448.f); b = fminf(fmaxf(b, -448.f), 448.f); c = fminf(fmaxf(c, -448.f), 448.f); d = fminf(fmaxf(d, -448.f), 448.f);
    int w = __builtin_amdgcn_cvt_pk_fp8_f32(a, b, 0, false); w = __builtin_amdgcn_cvt_pk_fp8_f32(c, d, w, true); return (unsigned)w; }
typedef unsigned u32x2 __attribute__((ext_vector_type(2)));
#ifndef F8FFN
#define F8FFN 1
#endif
constexpr float F8_WGU_SCALE = 512.f, F8_WD_SCALE = 1024.f, F8_ACT_SCALE = 8.f;
__device__ __forceinline__ float wave_sum(float v) {
#pragma unroll
    for (int o = 1; o < 64; o <<= 1) v += __shfl_xor(v, o);
    return v;
}
__device__ __forceinline__ float gelu_tanh(float x) {
    const float t = x * x;
    const float z2 = x * (1.5957691216057308f + 0.07135481627f * t);
    const float e = __builtin_amdgcn_exp2f(-z2 * 1.4426950408889634f);
    return x * __builtin_amdgcn_rcpf(1.0f + e);
}

__device__ __forceinline__ void p0_transpose_item(const float* W, int K, int N, h16* WT, int k0, int n0, int dest_row0, LAS float* scr, int lane) {
#pragma unroll 8
    for (int i = 0; i < 32; ++i) { const int kk = 2 * i + (lane >> 5); scr[kk * 33 + (lane & 31)] = W[(size_t)(k0 + kk) * N + n0 + (lane & 31)]; }
    asm volatile("s_waitcnt lgkmcnt(0)" ::: "memory");
    const int c = lane & 7;
#pragma unroll
    for (int j = 0; j < 4; ++j) { const int n = (lane >> 3) + 8 * j; const LAS float* s = scr + (8 * c) * 33 + n;
        u32x4 o; o.x = pk2h(s[0 * 33], s[1 * 33]); o.y = pk2h(s[2 * 33], s[3 * 33]); o.z = pk2h(s[4 * 33], s[5 * 33]); o.w = pk2h(s[6 * 33], s[7 * 33]);
        *(u32x4*)(WT + (size_t)(dest_row0 + n) * K + k0 + 8 * c) = o; }
    asm volatile("s_waitcnt lgkmcnt(0)" ::: "memory");
}
__device__ __forceinline__ void p0_transpose_item_f8(const float* W, int K, int N, unsigned char* WT, int k0, int n0, int dest_row0, float scale, LAS float* scr, int lane) {
#pragma unroll 8
    for (int i = 0; i < 32; ++i) { const int kk = 2 * i + (lane >> 5); scr[kk * 33 + (lane & 31)] = W[(size_t)(k0 + kk) * N + n0 + (lane & 31)]; }
    asm volatile("s_waitcnt lgkmcnt(0)" ::: "memory");
    const int c = lane & 7;
#pragma unroll
    for (int j = 0; j < 4; ++j) { const int n = (lane >> 3) + 8 * j; const LAS float* s = scr + (8 * c) * 33 + n;
        u32x2 o; o.x = pk4f8(s[0 * 33] * scale, s[1 * 33] * scale, s[2 * 33] * scale, s[3 * 33] * scale); o.y = pk4f8(s[4 * 33] * scale, s[5 * 33] * scale, s[6 * 33] * scale, s[7 * 33] * scale);
        *(u32x2*)(WT + (size_t)(dest_row0 + n) * K + k0 + 8 * c) = o; }
    asm volatile("s_waitcnt lgkmcnt(0)" ::: "memory");
}
__device__ __forceinline__ void rms_row_to_h16(const float* xrow, const float* g, h16* orow, int lane) {
    f32x4 v[4][2]; float s = 0.f;
#pragma unroll
    for (int j = 0; j < 4; ++j) { const int c = (lane + 64 * j) * 8; v[j][0] = *(const f32x4*)(xrow + c); v[j][1] = *(const f32x4*)(xrow + c + 4);
#pragma unroll
        for (int q = 0; q < 2; ++q) s += (v[j][q].x * v[j][q].x + v[j][q].y * v[j][q].y) + (v[j][q].z * v[j][q].z + v[j][q].w * v[j][q].w); }
    const float rstd = 1.0f / sqrtf(wave_sum(s) * (1.0f / DM) + RMS_EPS);
#pragma unroll
    for (int j = 0; j < 4; ++j) { const int c = (lane + 64 * j) * 8; const f32x4 g0 = *(const f32x4*)(g + c), g1 = *(const f32x4*)(g + c + 4);
        u32x4 o; o.x = pk2h(v[j][0].x * rstd * g0.x, v[j][0].y * rstd * g0.y); o.y = pk2h(v[j][0].z * rstd * g0.z, v[j][0].w * rstd * g0.w);
        o.z = pk2h(v[j][1].x * rstd * g1.x, v[j][1].y * rstd * g1.y); o.w = pk2h(v[j][1].z * rstd * g1.z, v[j][1].w * rstd * g1.w);
        *(u32x4*)(orow + c) = o; }
}
constexpr int I_QKV = (DM / 64) * (NQKV / 32), I_O = (DM / 64) * (DM / 32), I_G = (DM / 64) * (FF / 32), I_D = (FF / 64) * (DM / 32);
constexpr int P0_ITEMS = I_QKV + I_O + 2 * I_G + I_D;
__device__ __forceinline__ void p0_prologue(const Ptrs& P, LAS float* scr  , int gw, int NGW, int lane) {
    h16* WQKV = (h16*)(P.ws + WS_WQKV); h16* WO = (h16*)(P.ws + WS_WO); h16* WGU = (h16*)(P.ws + WS_WGU); h16* WD = (h16*)(P.ws + WS_WD);
    for (int it = gw; it < P0_ITEMS; it += NGW) {
        int r = it;
        if (r < I_QKV) { const int nb = NQKV / 32, kb = r / nb, n0 = (r % nb) * 32; p0_transpose_item(P.w_qkv, DM, NQKV, WQKV, kb * 64, n0, n0, scr, lane); continue; } r -= I_QKV;
        if (r < I_O) { const int nb = DM / 32, kb = r / nb, n0 = (r % nb) * 32; p0_transpose_item(P.w_o, DM, DM, WO, kb * 64, n0, n0, scr, lane); continue; } r -= I_O;
#if F8FFN
        if (r < I_G) { const int nb = FF / 32, kb = r / nb, n0 = (r % nb) * 32; p0_transpose_item_f8(P.w_gate, DM, FF, (unsigned char*)WGU, kb * 64, n0, (n0 / 128) * 256 + (n0 % 128), F8_WGU_SCALE, scr, lane); continue; } r -= I_G;
        if (r < I_G) { const int nb = FF / 32, kb = r / nb, n0 = (r % nb) * 32; p0_transpose_item_f8(P.w_up, DM, FF, (unsigned char*)WGU, kb * 64, n0, (n0 / 128) * 256 + 128 + (n0 % 128), F8_WGU_SCALE, scr, lane); continue; } r -= I_G;
        { const int nb = DM / 32, kb = r / nb, n0 = (r % nb) * 32; p0_transpose_item_f8(P.w_down, FF, DM, (unsigned char*)WD, kb * 64, n0, n0, F8_WD_SCALE, scr, lane); }
#else
        if (r < I_G) { const int nb = FF / 32, kb = r / nb, n0 = (r % nb) * 32; p0_transpose_item(P.w_gate, DM, FF, WGU, kb * 64, n0, (n0 / 128) * 256 + (n0 % 128), scr, lane); continue; } r -= I_G;
        if (r < I_G) { const int nb = FF / 32, kb = r / nb, n0 = (r % nb) * 32; p0_transpose_item(P.w_up, DM, FF, WGU, kb * 64, n0, (n0 / 128) * 256 + 128 + (n0 % 128), scr, lane); continue; } r -= I_G;
        { const int nb = DM / 32, kb = r / nb, n0 = (r % nb) * 32; p0_transpose_item(P.w_down, FF, DM, WD, kb * 64, n0, n0, scr, lane); }
#endif
    }
    h16* XN = (h16*)(P.ws + WS_XN);
    for (int m = gw; m < M; m += NGW) rms_row_to_h16(P.x + (size_t)m * DM, P.g_attn_pre, XN + (size_t)m * DM, lane);
    f32x2* CS = (f32x2*)(P.ws + WS_CS);
    for (int e = gw * 64 + lane; e < M * 16; e += NGW * 64) { const int m = e >> 4, i = e & 15;
        const float inv_freq = powf(500000.0f, -(float)i / 16.0f); const float ang = (float)P.pos[m] * inv_freq;
        float sn, cs; sincosf(ang, &sn, &cs); CS[e] = (f32x2){cs, sn}; }
}

__device__ __forceinline__ void p3_row(const Ptrs& P, int m, int lane) {
    const h16* OA = (const h16*)(P.ws + WS_OA) + (size_t)m * 1024;
    const h16* OB[3] = {(const h16*)(P.ws + WS_OB0) + (size_t)m * 1024, (const h16*)(P.ws + WS_OB1) + (size_t)m * 1024, (const h16*)(P.ws + WS_OB2) + (size_t)m * 1024};
    const float* LSE = (const float*)(P.ws + WS_LSE);
    h16* MIX = (h16*)(P.ws + WS_MIX) + (size_t)m * DM;
    {   float v[2][8]; float s = 0.f;
#pragma unroll
        for (int j = 0; j < 2; ++j) { const h16x8 a = *(const h16x8*)(OA + (lane + 64 * j) * 8);
#pragma unroll
            for (int e = 0; e < 8; ++e) { v[j][e] = (float)a[e]; s += v[j][e] * v[j][e]; } }
        const float rstd = 1.0f / sqrtf(wave_sum(s) * (1.0f / 1024.0f) + RMS_EPS);
#pragma unroll
        for (int j = 0; j < 2; ++j) { const int c = (lane + 64 * j) * 8; const f32x4 g0 = *(const f32x4*)(P.g_moba + c), g1 = *(const f32x4*)(P.g_moba + c + 4);
            u32x4 o; o.x = pk2h(v[j][0] * rstd * g0.x, v[j][1] * rstd * g0.y); o.y = pk2h(v[j][2] * rstd * g0.z, v[j][3] * rstd * g0.w);
            o.z = pk2h(v[j][4] * rstd * g1.x, v[j][5] * rstd * g1.y); o.w = pk2h(v[j][6] * rstd * g1.z, v[j][7] * rstd * g1.w);
            *(u32x4*)(MIX + c) = o; } }
    {   float v[2][8]; float s = 0.f;
#pragma unroll
        for (int j = 0; j < 2; ++j) { const int hh = (lane >> 4) + 4 * j;
            const float l0 = LSE[((size_t)0 * M + m) * 8 + hh], l1 = LSE[((size_t)1 * M + m) * 8 + hh], l2 = LSE[((size_t)2 * M + m) * 8 + hh];
            const float mx = fmaxf(l0, fmaxf(l1, l2)); const float e0 = __expf(l0 - mx), e1 = __expf(l1 - mx), e2 = __expf(l2 - mx); const float inv = 1.0f / (e0 + e1 + e2);
            const float w0 = e0 * inv, w1 = e1 * inv, w2 = e2 * inv;
            const h16x8 a0 = *(const h16x8*)(OB[0] + (lane + 64 * j) * 8), a1 = *(const h16x8*)(OB[1] + (lane + 64 * j) * 8), a2 = *(const h16x8*)(OB[2] + (lane + 64 * j) * 8);
#pragma unroll
            for (int e = 0; e < 8; ++e) { v[j][e] = w0 * (float)a0[e] + w1 * (float)a1[e] + w2 * (float)a2[e]; s += v[j][e] * v[j][e]; } }
        const float rstd = 1.0f / sqrtf(wave_sum(s) * (1.0f / 1024.0f) + RMS_EPS);
#pragma unroll
        for (int j = 0; j < 2; ++j) { const int c = (lane + 64 * j) * 8; const f32x4 g0 = *(const f32x4*)(P.g_dil + c), g1 = *(const f32x4*)(P.g_dil + c + 4);
            u32x4 o; o.x = pk2h(v[j][0] * rstd * g0.x, v[j][1] * rstd * g0.y); o.y = pk2h(v[j][2] * rstd * g0.z, v[j][3] * rstd * g0.w);
            o.z = pk2h(v[j][4] * rstd * g1.x, v[j][5] * rstd * g1.y); o.w = pk2h(v[j][6] * rstd * g1.z, v[j][7] * rstd * g1.w);
            *(u32x4*)(MIX + 1024 + c) = o; } }
}
template <bool NEXT>
__device__ __forceinline__ void resid_row(const float* base, const h16* y, const float* ss, const float* gpost, const float* gnext, float* out, h16* xn2, int lane) {
    const float part = (lane < 32) ? ss[lane] : 0.f;
    const float rstd_y = 1.0f / sqrtf(wave_sum(part) * (1.0f / DM) + RMS_EPS);
    f32x4 v[4][2]; float s = 0.f;
#pragma unroll
    for (int j = 0; j < 4; ++j) { const int c = (lane + 64 * j) * 8; const h16x8 yy = *(const h16x8*)(y + c);
#pragma unroll
        for (int q = 0; q < 2; ++q) { const f32x4 b = *(const f32x4*)(base + c + 4 * q), g = *(const f32x4*)(gpost + c + 4 * q);
            f32x4 o; o.x = b.x + (float)yy[4 * q + 0] * rstd_y * g.x; o.y = b.y + (float)yy[4 * q + 1] * rstd_y * g.y; o.z = b.z + (float)yy[4 * q + 2] * rstd_y * g.z; o.w = b.w + (float)yy[4 * q + 3] * rstd_y * g.w;
            v[j][q] = o; s += (o.x * o.x + o.y * o.y) + (o.z * o.z + o.w * o.w); *(f32x4*)(out + c + 4 * q) = o; } }
    if (NEXT) { const float rstd = 1.0f / sqrtf(wave_sum(s) * (1.0f / DM) + RMS_EPS);
#pragma unroll
        for (int j = 0; j < 4; ++j) { const int c = (lane + 64 * j) * 8; const f32x4 g0 = *(const f32x4*)(gnext + c), g1 = *(const f32x4*)(gnext + c + 4);
#if F8FFN
            u32x2 o; o.x = pk4f8(v[j][0].x * rstd * g0.x, v[j][0].y * rstd * g0.y, v[j][0].z * rstd * g0.z, v[j][0].w * rstd * g0.w);
            o.y = pk4f8(v[j][1].x * rstd * g1.x, v[j][1].y * rstd * g1.y, v[j][1].z * rstd * g1.z, v[j][1].w * rstd * g1.w);
            *(u32x2*)((unsigned char*)xn2 + c) = o; } }
#else
            u32x4 o; o.x = pk2h(v[j][0].x * rstd * g0.x, v[j][0].y * rstd * g0.y); o.y = pk2h(v[j][0].z * rstd * g0.z, v[j][0].w * rstd * g0.w);
            o.z = pk2h(v[j][1].x * rstd * g1.x, v[j][1].y * rstd * g1.y); o.w = pk2h(v[j][1].z * rstd * g1.z, v[j][1].w * rstd * g1.w);
            *(u32x4*)(xn2 + c) = o; } }
#endif
}

__global__ __launch_bounds__(256) void k_p0(Ptrs P) {
    __shared__ float scr_all[4 * 64 * 33];
    const int lane = threadIdx.x & 63, wave = threadIdx.x >> 6;
    p0_prologue(P, (LAS float*)scr_all + wave * 64 * 33, blockIdx.x * 4 + wave, gridDim.x * 4, lane);
}
__global__ __launch_bounds__(512) void k_p3(Ptrs P) {
    const int lane = threadIdx.x & 63, gw = blockIdx.x * 8 + (threadIdx.x >> 6), NGW = gridDim.x * 8;
    for (int m = gw; m < M; m += NGW) p3_row(P, m, lane);
}
__global__ __launch_bounds__(512) void k_p4b(Ptrs P) {
    const int lane = threadIdx.x & 63, gw = blockIdx.x * 8 + (threadIdx.x >> 6), NGW = gridDim.x * 8;
    for (int m = gw; m < M; m += NGW)
        resid_row<true>(P.x + (size_t)m * DM, (const h16*)(P.ws + WS_Y) + (size_t)m * DM, (const float*)(P.ws + WS_SS) + (size_t)m * 32, P.g_attn_post, P.g_ffn_pre,
                        P.out + (size_t)m * DM, (h16*)(P.ws + WS_XN2) + (size_t)m * DM, lane);
}
__global__ __launch_bounds__(512) void k_p6b(Ptrs P) {
    const int lane = threadIdx.x & 63, gw = blockIdx.x * 8 + (threadIdx.x >> 6), NGW = gridDim.x * 8;
    for (int m = gw; m < M; m += NGW)
        resid_row<false>(P.out + (size_t)m * DM, (const h16*)(P.ws + WS_Y2) + (size_t)m * DM, (const float*)(P.ws + WS_SS) + (size_t)m * 32, P.g_ffn_post, nullptr,
                         P.out + (size_t)m * DM, nullptr, lane);
}

__global__ __launch_bounds__(256) void nv_gemm(const h16* A, int lda, const h16* Bt, int ldb, float* C, int ldc, int K) {
    __shared__ float As[32][65]; __shared__ float Bs[32][65];
    const int t = threadIdx.x, m0 = blockIdx.y * 64, n0 = blockIdx.x * 64, lr = t >> 2, lk = (t & 3) * 8, ty = t >> 4, tx = t & 15;
    float acc[4][4];
#pragma unroll
    for (int i = 0; i < 4; ++i)
#pragma unroll
        for (int j = 0; j < 4; ++j) acc[i][j] = 0.f;
    for (int k0 = 0; k0 < K; k0 += 32) {
        const h16x8 a = *(const h16x8*)(A + (size_t)(m0 + lr) * lda + k0 + lk);
        const h16x8 b = *(const h16x8*)(Bt + (size_t)(n0 + lr) * ldb + k0 + lk);
#pragma unroll
        for (int e = 0; e < 8; ++e) { As[lk + e][lr] = (float)a[e]; Bs[lk + e][lr] = (float)b[e]; }
        __syncthreads();
#pragma unroll 8
        for (int kk = 0; kk < 32; ++kk) {
            float av[4], bv[4];
#pragma unroll
            for (int i = 0; i < 4; ++i) { av[i] = As[kk][ty * 4 + i]; bv[i] = Bs[kk][tx * 4 + i]; }
#pragma unroll
            for (int i = 0; i < 4; ++i)
#pragma unroll
                for (int j = 0; j < 4; ++j) acc[i][j] = fmaf(av[i], bv[j], acc[i][j]);
        }
        __syncthreads();
    }
#pragma unroll
    for (int i = 0; i < 4; ++i) { f32x4 o = {acc[i][0], acc[i][1], acc[i][2], acc[i][3]}; *(f32x4*)(C + (size_t)(m0 + ty * 4 + i) * ldc + n0 + tx * 4) = o; }
}
__global__ __launch_bounds__(256) void nv_rope(const float* C, h16* QKV, const f32x2* CS, int chunk) {
    const size_t e = (size_t)blockIdx.x * 256 + threadIdx.x; const int m = (int)(e >> 10), j = (int)(e & 1023), d = j & 127;
    float v = C[e];
    if ((chunk % 3) != 2 && d < 32) {
        const int i = d & 15; const f32x2 cs = CS[(size_t)m * 16 + i];
        if (d < 16) v = v * cs.x - C[e + 16] * cs.y; else v = v * cs.x + C[e - 16] * cs.y;
    }
    QKV[(size_t)m * NQKV + chunk * 1024 + j] = (h16)v;
}
__global__ __launch_bounds__(256) void nv_ksum(const h16* QKV, float* KSUM) {
    const int e = blockIdx.x * 256 + threadIdx.x; const int pm = e >> 10, c = e & 1023;
    float s = 0.f;
    for (int r = 0; r < 256; ++r) s += (float)QKV[(size_t)(pm * 256 + r) * NQKV + 1024 + c];
    KSUM[(size_t)(pm * 2 + 0) * 1024 + c] = s; KSUM[(size_t)(pm * 2 + 1) * 1024 + c] = 0.f;
}
__global__ __launch_bounds__(256) void nv_cvt_ss(const float* C, int ncols, h16* Y, int col0, float* SS) {
    const int lane = threadIdx.x & 63; const size_t w = (size_t)blockIdx.x * 4 + (threadIdx.x >> 6); const int nslot = ncols / 64; const int m = (int)(w / nslot), s = (int)(w % nslot);
    const float v = C[(size_t)m * ncols + s * 64 + lane];
    Y[(size_t)m * DM + col0 + s * 64 + lane] = (h16)v;
    const float q = wave_sum(v * v);
    if (lane == 0) SS[(size_t)m * 32 + col0 / 64 + s] = q;
}
__global__ __launch_bounds__(256) void nv_conv(const float* C, h16* ACT, const float* conv_w, const float* conv_b, int g0) {
    const size_t e = (size_t)blockIdx.x * 256 + threadIdx.x; const int m = (int)(e >> 8), jj = (int)(e & 255), gi = jj >> 7, j = jj & 127;
    const int c = 128 * (g0 + gi) + j; const int s = m & (SEQ - 1);
    const float* Cg = C + (size_t)m * 512 + gi * 256 + j;
    const float g_0 = Cg[0], g_1 = (s >= 1) ? Cg[-512] : 0.f, g_2 = (s >= 2) ? Cg[-1024] : 0.f, u = Cg[128];
    const float pre = conv_b[c] + conv_w[c] * g_2 + conv_w[FF + c] * g_1 + conv_w[2 * FF + c] * g_0;
    ACT[(size_t)m * FF + c] = (h16)(gelu_tanh(pre) * u);
}
__global__ __launch_bounds__(256) void nv_attn(const h16* QKV, const float* KSUM, h16* OA, h16* OB0, h16* OB1, h16* OB2, float* LSE, int mode) {
    __shared__ float Qs[32][129]; __shared__ float Ks[32][129]; __shared__ float Vs[32][128]; __shared__ float Ps[32][33]; __shared__ float Gs[32][16]; __shared__ unsigned Sel[32];
    const int t = threadIdx.x, u = blockIdx.x, b = u >> 10, h = (u >> 7) & 7, rem = u & 127;
    int d = 1, r = 0, i0, W; const h16 *Qp, *Kp, *Vp; h16* Op; size_t pitch, opitch;
    if (mode == 0) { i0 = rem * 32; W = 1 << 30; pitch = NQKV; opitch = 1024;
        Qp = QKV + (size_t)(b * SEQ) * NQKV + 0 + h * HD; Kp = Qp + 1024; Vp = Qp + 2048; Op = OA + (size_t)(b * SEQ) * 1024 + h * HD; }
    else { d = (mode == 1) ? 1 : (mode == 2) ? 4 : 16; const int nq = (SEQ / d) / 32; r = rem / nq; i0 = (rem % nq) * 32; W = 129; pitch = (size_t)NQKV * d; opitch = (size_t)1024 * d;
        Qp = QKV + (size_t)(b * SEQ + r) * NQKV + 3072 + h * HD; Kp = Qp + 1024; Vp = Qp + 2048;
        h16* OBm = (mode == 1) ? OB0 : (mode == 2) ? OB1 : OB2; Op = OBm + (size_t)(b * SEQ + r) * 1024 + h * HD; }
    for (int e = t; e < 32 * 128; e += 256) { const int qi = e >> 7, c = e & 127; Qs[qi][c] = (float)Qp[(size_t)(i0 + qi) * pitch + c]; }
    __syncthreads();
    const int qi = t >> 3, sub = t & 7;
    if (mode == 0) {
        const int qblk = i0 >> 8;
        for (int jj = 0; jj < 2; ++jj) { const int j = sub + 8 * jj; float g = 0.f;
            if (j < qblk) { const float* k0 = KSUM + (size_t)((b * 16 + j) * 2) * 1024 + h * HD; for (int c = 0; c < 128; ++c) g += Qs[qi][c] * (k0[c] + k0[1024 + c]) * (1.0f / 256.0f); }
            Gs[qi][j] = g; }
        __syncthreads();
        if (sub == 0) { unsigned sel = 0;
            for (int rnd = 0; rnd < 3; ++rnd) { float best = -3.0e38f; int bi = -1;
                for (int j = 0; j < 16; ++j) if (j < qblk && !((sel >> j) & 1u) && Gs[qi][j] > best) { best = Gs[qi][j]; bi = j; }
                if (bi >= 0) sel |= 1u << bi; }
            sel |= 1u << qblk; Sel[qi] = sel; }
        __syncthreads();
    }
    const unsigned selmask = (mode == 0) ? Sel[qi] : 0xffffffffu;
    float o[16];
#pragma unroll
    for (int c = 0; c < 16; ++c) o[c] = 0.f;
    float mrun = -1e30f, lrun = 0.f;
    int klo = (mode == 0) ? 0 : (i0 - 128 > 0 ? i0 - 128 : 0); klo &= ~31;
    const int khi = i0 + 32;
    const int iq = i0 + qi;
    for (int k0 = klo; k0 < khi; k0 += 32) {
        __syncthreads();
        for (int e = t; e < 32 * 128; e += 256) { const int kk = e >> 7, c = e & 127; Ks[kk][c] = (float)Kp[(size_t)(k0 + kk) * pitch + c]; Vs[kk][c] = (float)Vp[(size_t)(k0 + kk) * pitch + c]; }
        __syncthreads();
        float sc[4]; float tmax = -1e30f;
#pragma unroll
        for (int j = 0; j < 4; ++j) { const int kk = sub * 4 + j, kidx = k0 + kk; float a = 0.f;
            for (int c = 0; c < 128; ++c) a += Qs[qi][c] * Ks[kk][c];
            a *= SCALE;
            bool ok = (kidx <= iq) && (iq - kidx < W);
            if (mode == 0) ok = ok && ((selmask >> (kidx >> 8)) & 1u);
            sc[j] = ok ? a : -INFINITY; tmax = fmaxf(tmax, sc[j]); }
        tmax = fmaxf(tmax, __shfl_xor(tmax, 1)); tmax = fmaxf(tmax, __shfl_xor(tmax, 2)); tmax = fmaxf(tmax, __shfl_xor(tmax, 4));
        const float mnew = fmaxf(mrun, tmax); const float alpha = __expf(mrun - mnew);
        float ps = 0.f;
#pragma unroll
        for (int j = 0; j < 4; ++j) { const float p = __expf(sc[j] - mnew); Ps[qi][sub * 4 + j] = p; ps += p; }
        ps += __shfl_xor(ps, 1); ps += __shfl_xor(ps, 2); ps += __shfl_xor(ps, 4);
        lrun = lrun * alpha + ps; mrun = mnew;
        __syncthreads();
#pragma unroll
        for (int c = 0; c < 16; ++c) o[c] *= alpha;
        for (int kk = 0; kk < 32; ++kk) { const float p = Ps[qi][kk];
#pragma unroll
            for (int c = 0; c < 16; ++c) o[c] = fmaf(p, Vs[kk][sub * 16 + c], o[c]); }
    }
    const float inv = 1.0f / lrun;
#pragma unroll
    for (int c = 0; c < 16; ++c) Op[(size_t)(i0 + qi) * opitch + sub * 16 + c] = (h16)(o[c] * inv);
    if (mode != 0 && sub == 0) LSE[((size_t)(mode - 1) * M + (size_t)(b * SEQ + r + d * (i0 + qi))) * 8 + h] = mrun + __logf(lrun);
}

namespace pg8 {
#define PG8_LAS __attribute__((address_space(3)))
constexpr int BM = 256, BK = 64, HALF = 128, HTB = HALF * BK * 2, STAGE_BYTES = 8 * HTB, NXCD = 8, WGM = 8;
__host__ __device__ __forceinline__ int lds_byte(int r, int c) { const int st = (r >> 4) * 2 + (c >> 5), rr = r & 15, cc = c & 31, ob = rr * 64 + cc * 2; return st * 1024 + (ob ^ (((ob >> 9) & 1) << 5)); }
__host__ __device__ __forceinline__ void stage_rc(int b, int& R, int& C) { const int st = b / 1024, sb = b % 1024, swz = sb ^ (((sb >> 9) & 1) << 5); R = (st >> 1) * 16 + swz / 64; C = (st & 1) * 32 + (swz % 64) / 2; }
__host__ __device__ __forceinline__ int perm32(int rho) { const int n = rho >> 4, i = rho & 15; return 8 * (i >> 2) + 4 * n + (i & 3); }
struct Unit { int pm, pn; };
struct Gemm { const void* A; const void* Bt; int M, N, K; int scale_w, scale_x; };
typedef int i32x8 __attribute__((ext_vector_type(8)));
typedef int i32x4 __attribute__((ext_vector_type(4)));
struct StaticOrder {
    int nM, nN, nwg, G, c;
    __host__ __device__ void init(int M_, int N_, int G_, int c_) { nM = M_ / BM; nN = N_ / BM; nwg = nM * nN; G = G_; c = c_; }
    __host__ __device__ bool next(int i, Unit& u) const {
        const long L = (long)i * G + c; if (L >= nwg) return false;
        int wgid = (int)L; { const int q = nwg / NXCD, r = nwg % NXCD, xcd = wgid % NXCD, off = wgid / NXCD; wgid = (xcd < r ? xcd * (q + 1) : r * (q + 1) + (xcd - r) * q) + off; }
        const int nig = WGM * nN, gid = wgid / nig, fm = gid * WGM, gsz = (nM - fm) < WGM ? (nM - fm) : WGM;
        u.pm = fm + ((wgid % nig) % gsz); u.pn = (wgid % nig) / gsz; return true;
    }
};
typedef f32x4 Acc[2][2][4][2];

__device__ __forceinline__ u32x4 pack8h(f32x4 v0, f32x4 v1) { u32x4 w; w.x = pk2h(v0[0], v0[1]); w.y = pk2h(v0[2], v0[3]); w.z = pk2h(v1[0], v1[1]); w.w = pk2h(v1[2], v1[3]); return w; }

struct EpiQKV {
    h16* O; const f32x2* CS; float* KSUM;
    __device__ __forceinline__ void operator()(Acc& acc, const Unit& u, int wr, int wc, int fr, int fq, PG8_LAS unsigned char* xlds) const {
        const int grp6 = u.pn >> 2, kind = grp6 % 3;
        const int row0 = u.pm * BM + wr * 64 + fr;
        if (kind != 2 && wc == 0) {
            const float sgn = (fq < 2) ? -1.f : 1.f;
#pragma unroll
            for (int ai = 0; ai < 2; ++ai)
#pragma unroll
                for (int m = 0; m < 4; ++m) {
                    const f32x4* cp = (const f32x4*)(CS + (size_t)(row0 + ai * HALF + m * 16) * 16 + 8 * (fq & 1));
                    const f32x4 c0 = cp[0], c1 = cp[1], c2 = cp[2], c3 = cp[3];
                    const float cs[8] = {c0[0], c0[2], c1[0], c1[2], c2[0], c2[2], c3[0], c3[2]}, sn[8] = {c0[1], c0[3], c1[1], c1[3], c2[1], c2[3], c3[1], c3[3]};
#pragma unroll
                    for (int bj = 0; bj < 2; ++bj)
#pragma unroll
                        for (int n = 0; n < 2; ++n)
#pragma unroll
                            for (int e = 0; e < 4; ++e) { const float v = acc[ai][bj][m][n][e]; const float o = __shfl_xor(v, 32);
                                acc[ai][bj][m][n][e] = v * cs[4 * n + e] + sgn * o * sn[4 * n + e]; }
                }
        }
        if (grp6 == 1) {
#pragma unroll
            for (int bj = 0; bj < 2; ++bj)
#pragma unroll
                for (int n = 0; n < 2; ++n) { f32x4 s = {0.f, 0.f, 0.f, 0.f};
#pragma unroll
                    for (int ai = 0; ai < 2; ++ai)
#pragma unroll
                        for (int m = 0; m < 4; ++m) s += acc[ai][bj][m][n];
#pragma unroll
                    for (int e = 0; e < 4; ++e) { float t = s[e]; t += __shfl_xor(t, 1); t += __shfl_xor(t, 2); t += __shfl_xor(t, 4); t += __shfl_xor(t, 8); s[e] = t; }
                    if (fr == 0) *(f32x4*)(KSUM + (size_t)(u.pm * 2 + wr) * 1024 + (u.pn - 4) * 256 + bj * HALF + wc * 32 + 8 * fq + 4 * n) = s; }
        }
        const int col0 = u.pn * BM + wc * 32 + 8 * fq;
#pragma unroll
        for (int ai = 0; ai < 2; ++ai)
#pragma unroll
            for (int m = 0; m < 4; ++m) { h16* rowp = O + (size_t)(row0 + ai * HALF + m * 16) * NQKV + col0;
#pragma unroll
                for (int bj = 0; bj < 2; ++bj) *(u32x4*)(rowp + bj * HALF) = pack8h(acc[ai][bj][m][0], acc[ai][bj][m][1]); }
    }
};
struct EpiY {
    h16* O; float* SS;
    __device__ __forceinline__ void operator()(Acc& acc, const Unit& u, int wr, int wc, int fr, int fq, PG8_LAS unsigned char* xlds) const {
        const int row0 = u.pm * BM + wr * 64 + fr, col0 = u.pn * BM + wc * 32 + 8 * fq;
#pragma unroll
        for (int ai = 0; ai < 2; ++ai)
#pragma unroll
            for (int m = 0; m < 4; ++m) { const int row = row0 + ai * HALF + m * 16; h16* rowp = O + (size_t)row * DM + col0; float q = 0.f;
#pragma unroll
                for (int bj = 0; bj < 2; ++bj) { const f32x4 v0 = acc[ai][bj][m][0], v1 = acc[ai][bj][m][1];
                    q += (v0[0] * v0[0] + v0[1] * v0[1]) + (v0[2] * v0[2] + v0[3] * v0[3]) + (v1[0] * v1[0] + v1[1] * v1[1]) + (v1[2] * v1[2] + v1[3] * v1[3]);
                    *(u32x4*)(rowp + bj * HALF) = pack8h(v0, v1); }
                q += __shfl_xor(q, 16); q += __shfl_xor(q, 32);
                if (fq == 0) SS[(size_t)row * 32 + u.pn * 4 + wc] = q; }
    }
};
template <int CTRL> __device__ __forceinline__ float dpp_mov(float old, float src) {
    return __builtin_bit_cast(float, __builtin_amdgcn_update_dpp(__builtin_bit_cast(int, old), __builtin_bit_cast(int, src), CTRL, 0xF, 0xF, false)); }
struct EpiGU {
    h16* ACT; const float* conv_w; const float* conv_b; float* HALO; float* FIXP; float* FIXU;
    __device__ __forceinline__ void operator()(Acc& acc, const Unit& u, int wr, int wc, int fr, int fq, PG8_LAS unsigned char* xlds) const {
        PG8_LAS float* xb = (PG8_LAS float*)xlds;
        const int c0 = u.pn * HALF + wc * 32 + 8 * fq;
        if (fr >= 14) {
#pragma unroll
            for (int ai = 0; ai < 2; ++ai) { PG8_LAS float* d = xb + ((((ai * 2 + wr) * 4 + wc) * 4 + fq) * 2 + (fr - 14)) * 8;
                *(PG8_LAS f32x4*)d = acc[ai][0][3][0]; *(PG8_LAS f32x4*)(d + 4) = acc[ai][0][3][1]; }
            if (wr == 1) { float* hp = HALO + ((size_t)(u.pm * 2 + (fr - 14))) * FF + c0;
                *(f32x4*)hp = acc[1][0][3][0]; *(f32x4*)(hp + 4) = acc[1][0][3][1]; }
        }
        asm volatile("s_waitcnt lgkmcnt(0)" ::: "memory"); __builtin_amdgcn_s_barrier(); asm volatile("" ::: "memory");
        f32x4 w0[2], w1[2], w2[2], bb[2];
#pragma unroll
        for (int n = 0; n < 2; ++n) { w0[n] = *(const f32x4*)(conv_w + c0 + 4 * n); w1[n] = *(const f32x4*)(conv_w + FF + c0 + 4 * n); w2[n] = *(const f32x4*)(conv_w + 2 * FF + c0 + 4 * n); bb[n] = *(const f32x4*)(conv_b + c0 + 4 * n); }
#pragma unroll
        for (int ai = 0; ai < 2; ++ai) {
            f32x4 pv[2];
            if (ai == 0 && wr == 0) { pv[0] = (f32x4){0.f, 0.f, 0.f, 0.f}; pv[1] = pv[0]; }
            else { const int sg = (wr == 1) ? (ai * 2 + 0) : (0 * 2 + 1);
                const PG8_LAS float* s = xb + (((sg * 4 + wc) * 4 + fq) * 2 + (fr & 1)) * 8;
                pv[0] = *(const PG8_LAS f32x4*)s; pv[1] = *(const PG8_LAS f32x4*)(s + 4); }
#pragma unroll
            for (int m = 0; m < 4; ++m) {
                const int row = u.pm * BM + ai * HALF + wr * 64 + m * 16 + fr;
                f32x4 o[2];
#pragma unroll
                for (int n = 0; n < 2; ++n)
#pragma unroll
                    for (int e = 0; e < 4; ++e) { const float g = acc[ai][0][m][n][e], pg = pv[n][e];
                        const float p1 = dpp_mov<0x111>(dpp_mov<0x121>(0.f, pg), g);
                        const float p2 = dpp_mov<0x112>(dpp_mov<0x122>(0.f, pg), g);
                        const float pre = bb[n][e] + w0[n][e] * p2 + w1[n][e] * p1 + w2[n][e] * g;
                        o[n][e] = pre; }
                if (ai == 0 && wr == 0 && m == 0 && fr < 2) { float* fp = FIXP + ((size_t)(u.pm * 2 + fr)) * FF + c0; float* fu = FIXU + ((size_t)(u.pm * 2 + fr)) * FF + c0;
                    *(f32x4*)fp = o[0]; *(f32x4*)(fp + 4) = o[1]; *(f32x4*)fu = acc[0][1][0][0]; *(f32x4*)(fu + 4) = acc[0][1][0][1]; }
#pragma unroll
                for (int n = 0; n < 2; ++n)
#pragma unroll
                    for (int e = 0; e < 4; ++e) o[n][e] = gelu_tanh(o[n][e]) * acc[ai][1][m][n][e];
#if F8FFN
                { u32x2 w8; w8.x = pk4f8(o[0][0] * F8_ACT_SCALE, o[0][1] * F8_ACT_SCALE, o[0][2] * F8_ACT_SCALE, o[0][3] * F8_ACT_SCALE);
                  w8.y = pk4f8(o[1][0] * F8_ACT_SCALE, o[1][1] * F8_ACT_SCALE, o[1][2] * F8_ACT_SCALE, o[1][3] * F8_ACT_SCALE);
                  *(u32x2*)((unsigned char*)ACT + (size_t)row * FF + c0) = w8; }
#else
                *(u32x4*)(ACT + (size_t)row * FF + c0) = pack8h(o[0], o[1]);
#endif
                pv[0] = acc[ai][0][m][0]; pv[1] = acc[ai][0][m][1];
            }
        }
    }
};

template <class Epi, class Sched, bool F8 = false>
__device__ __forceinline__ void gemm_phase(PG8_LAS unsigned char* lds, PG8_LAS unsigned char* xlds, const Gemm g, const Sched& S, const Epi& E) {
    const int tid = threadIdx.x, wid = __builtin_amdgcn_readfirstlane(tid >> 6), lane = tid & 63, wr = wid >> 2, wc = wid & 3, fr = lane & 15, fq = lane >> 4;
    const int RB = F8 ? g.K : g.K * 2, nt = RB / 128;
    unsigned voffA[2], voffB[2];
#pragma unroll
    for (int i = 0; i < 2; ++i) { int R, C; stage_rc(tid * 16 + i * 8192, R, C); const int Rb = (R & ~31) + perm32(R & 31);
        voffA[i] = (unsigned)(R * RB + C * 2); voffB[i] = (unsigned)(Rb * RB + C * 2); }
    const size_t kstep = (size_t)128;
    const size_t hstep = (size_t)HALF * RB;
    const size_t tstep = 2 * hstep;
    const unsigned ldsw = (unsigned)wid * 1024u;
    const int aoff = lds_byte(wr * 64 + fr, fq * 8), boff = lds_byte(wc * 32 + fr, fq * 8);
#define PG8_SA(b, h) (((b) * 2 + (h)) * HTB)
#define PG8_SB(b, h) ((4 + (b) * 2 + (h)) * HTB)
#define PG8_STAGE(bufoff, gbase, voff) do { _Pragma("unroll") for (int _i = 0; _i < 2; ++_i) \
        __builtin_amdgcn_global_load_lds((const unsigned*)((const char*)(gbase) + (voff)[_i]), (PG8_LAS unsigned*)(lds + (bufoff) + ldsw + _i * 8192), 16, 0, 0); } while (0)
#define PG8_LDA(dst, b, h) do { _Pragma("unroll") for (int m = 0; m < 4; ++m) _Pragma("unroll") for (int k = 0; k < 2; ++k) dst[m][k] = *(const PG8_LAS h16x8*)(lds + PG8_SA(b, h) + aoff + m * 2048 + k * 1024); } while (0)
#define PG8_LDB(dst, b, h) do { _Pragma("unroll") for (int n = 0; n < 2; ++n) _Pragma("unroll") for (int k = 0; k < 2; ++k) dst[n][k] = *(const PG8_LAS h16x8*)(lds + PG8_SB(b, h) + boff + n * 2048 + k * 1024); } while (0)
#define PG8_CAT(v) __builtin_shufflevector(__builtin_bit_cast(i32x4, v[0]), __builtin_bit_cast(i32x4, v[1]), 0, 1, 2, 3, 4, 5, 6, 7)
#define PG8_MMA(ai, bj, At, Bt) do { __builtin_amdgcn_s_setprio(1); \
        if constexpr (F8) { _Pragma("unroll") for (int m = 0; m < 4; ++m) _Pragma("unroll") for (int n = 0; n < 2; ++n) \
            asm volatile("v_mfma_scale_f32_16x16x128_f8f6f4 %0, %1, %2, %0, %3, %4 op_sel_hi:[0,0,0]" : "+v"(acc[ai][bj][m][n]) : "v"(PG8_CAT(Bt[n])), "v"(PG8_CAT(At[m])), "v"(sc_w), "v"(sc_x)); } \
        else { _Pragma("unroll") for (int m = 0; m < 4; ++m) _Pragma("unroll") for (int n = 0; n < 2; ++n) _Pragma("unroll") for (int k = 0; k < 2; ++k) \
            acc[ai][bj][m][n] = __builtin_amdgcn_mfma_f32_16x16x32_f16(Bt[n][k], At[m][k], acc[ai][bj][m][n], 0, 0, 0); } \
        __builtin_amdgcn_s_setprio(0); } while (0)
#define PG8_WAIT_V(n) asm volatile("s_waitcnt vmcnt(" #n ")" ::: "memory")
#define PG8_WAIT_L(n) asm volatile("s_waitcnt lgkmcnt(" #n ")" ::: "memory")
#define PG8_BAR __builtin_amdgcn_s_barrier()
#define PG8_SCHED __builtin_amdgcn_sched_barrier(0)
    Unit cur, nxt; int ui = 0;
    if (!S.next(0, cur)) return;
    const int sc_w = g.scale_w, sc_x = g.scale_x;
    Acc acc;
#pragma unroll
    for (int a = 0; a < 2; ++a)
#pragma unroll
        for (int b = 0; b < 2; ++b)
#pragma unroll
            for (int m = 0; m < 4; ++m)
#pragma unroll
                for (int n = 0; n < 2; ++n) acc[a][b][m][n] = (f32x4){0.f, 0.f, 0.f, 0.f};
    h16x8 At[4][2], B0[2][2], B1[2][2];
    const char* cA = (const char*)g.A + (size_t)cur.pm * tstep; const char* cB = (const char*)g.Bt + (size_t)cur.pn * tstep;
    PG8_STAGE(PG8_SB(0, 0), cB, voffB); PG8_STAGE(PG8_SB(0, 1), cB + hstep, voffB); PG8_STAGE(PG8_SA(0, 0), cA, voffA); PG8_STAGE(PG8_SA(0, 1), cA + hstep, voffA);
    if (wr == 1) PG8_BAR;
    PG8_WAIT_V(2); PG8_BAR;
    PG8_STAGE(PG8_SB(1, 0), cB + kstep, voffB); PG8_STAGE(PG8_SA(1, 0), cA + kstep, voffA); PG8_STAGE(PG8_SB(1, 1), cB + hstep + kstep, voffB);
    PG8_WAIT_V(6); PG8_BAR;
    for (;;) {
        const bool has_next = S.next(ui + 1, nxt);
        const char* nA = has_next ? (const char*)g.A + (size_t)nxt.pm * tstep : cA; const char* nB = has_next ? (const char*)g.Bt + (size_t)nxt.pn * tstep : cB;
        for (int t = 0; t < nt; t += 2) {
            const bool last = (t == nt - 2);
            const char* a1 = cA + (size_t)(t + 1) * kstep;
            const char* a2 = last ? nA : cA + (size_t)(t + 2) * kstep; const char* b2 = last ? nB : cB + (size_t)(t + 2) * kstep;
            const char* a3 = a2 + kstep; const char* b3 = b2 + kstep;
            PG8_LDB(B0, 0, 0); PG8_LDB(B1, 0, 1); PG8_SCHED; PG8_LDA(At, 0, 0); PG8_STAGE(PG8_SA(1, 1), a1 + hstep, voffA);
            PG8_WAIT_V(8); PG8_WAIT_L(0); PG8_BAR; PG8_MMA(0, 0, At, B0); PG8_MMA(0, 1, At, B1); PG8_BAR; PG8_SCHED;
            PG8_LDA(At, 0, 1); PG8_STAGE(PG8_SB(0, 0), b2, voffB); PG8_STAGE(PG8_SB(0, 1), b2 + hstep, voffB); PG8_STAGE(PG8_SA(0, 0), a2, voffA);
            PG8_WAIT_V(8); PG8_WAIT_L(0); PG8_BAR; PG8_MMA(1, 0, At, B0); PG8_MMA(1, 1, At, B1); PG8_BAR; PG8_SCHED;
            PG8_LDB(B0, 1, 0); PG8_LDB(B1, 1, 1); PG8_SCHED; PG8_LDA(At, 1, 0); PG8_STAGE(PG8_SA(0, 1), a2 + hstep, voffA);
            PG8_WAIT_V(8); PG8_WAIT_L(0); PG8_BAR; PG8_MMA(0, 0, At, B0); PG8_MMA(0, 1, At, B1); PG8_BAR; PG8_SCHED;
            PG8_LDA(At, 1, 1); PG8_STAGE(PG8_SB(1, 0), b3, voffB); PG8_STAGE(PG8_SB(1, 1), b3 + hstep, voffB); PG8_STAGE(PG8_SA(1, 0), a3, voffA);
            PG8_WAIT_V(8); PG8_WAIT_L(0); PG8_BAR; PG8_MMA(1, 0, At, B0); PG8_MMA(1, 1, At, B1); PG8_BAR; PG8_SCHED;
        }
        if (wr == 0) PG8_BAR;
        if constexpr (F8) asm volatile("s_nop 15\n\ts_nop 15" ::: "memory");
        E(acc, cur, wr, wc, fr, fq, xlds);
        if (!has_next) break;
#pragma unroll
        for (int a = 0; a < 2; ++a)
#pragma unroll
            for (int b = 0; b < 2; ++b)
#pragma unroll
                for (int m = 0; m < 4; ++m)
#pragma unroll
                    for (int n = 0; n < 2; ++n) acc[a][b][m][n] = (f32x4){0.f, 0.f, 0.f, 0.f};
        cur = nxt; cA = nA; cB = nB; ++ui;
        if (wr == 1) PG8_BAR;
    }
    PG8_WAIT_V(0);
    PG8_BAR;
#undef PG8_SA
#undef PG8_SB
#undef PG8_STAGE
#undef PG8_LDA
#undef PG8_LDB
#undef PG8_MMA
#undef PG8_CAT
#undef PG8_WAIT_V
#undef PG8_WAIT_L
#undef PG8_BAR
#undef PG8_SCHED
}
}

__device__ __forceinline__ void p5b_fixup(const Ptrs& P, int gtid, int nthreads) {
    const float* HALO = (const float*)(P.ws + WS_HALO); const float* FIXP = (const float*)(P.ws + WS_FIXP); const float* FIXU = (const float*)(P.ws + WS_FIXU); h16* ACT = (h16*)(P.ws + WS_ACT);
    for (int e = gtid; e < 64 * 2 * (FF / 4); e += nthreads) {
        const int c = (e % (FF / 4)) * 4, i = (e / (FF / 4)) & 1, pm = e / (2 * (FF / 4));
        if ((pm & 15) == 0) continue;
        const f32x4 p = *(const f32x4*)(FIXP + (size_t)(pm * 2 + i) * FF + c), uu = *(const f32x4*)(FIXU + (size_t)(pm * 2 + i) * FF + c);
        const f32x4 h0 = *(const f32x4*)(HALO + (size_t)((pm - 1) * 2 + 0) * FF + c), h1 = *(const f32x4*)(HALO + (size_t)((pm - 1) * 2 + 1) * FF + c);
        const f32x4 w0 = *(const f32x4*)(P.conv_w + c), w1 = *(const f32x4*)(P.conv_w + FF + c);
        f32x4 pre;
        if (i == 0) pre = p + w0 * h0 + w1 * h1; else pre = p + w0 * h1;
#if F8FFN
        *(unsigned*)((unsigned char*)ACT + (size_t)(pm * 256 + i) * FF + c) = pk4f8(gelu_tanh(pre[0]) * uu[0] * F8_ACT_SCALE, gelu_tanh(pre[1]) * uu[1] * F8_ACT_SCALE, gelu_tanh(pre[2]) * uu[2] * F8_ACT_SCALE, gelu_tanh(pre[3]) * uu[3] * F8_ACT_SCALE);
#else
        const unsigned lo = pk2h(gelu_tanh(pre[0]) * uu[0], gelu_tanh(pre[1]) * uu[1]), hi = pk2h(gelu_tanh(pre[2]) * uu[2], gelu_tanh(pre[3]) * uu[3]);
        *(unsigned long long*)(ACT + (size_t)(pm * 256 + i) * FF + c) = (unsigned long long)lo | ((unsigned long long)hi << 32);
#endif
    }
}


#define XB_TMO      128
#define XB_XCNT(j)  (256  + 64 * (j))
#define XB_XSUB(j)  (1280 + 64 * (j))
#define XB_XGEN(j)  (2304 + 64 * (j))
#define XB_TOP      3328
#define XB_TOPGEN   3392
#define XCD_BAR_WORDS 3456
#define XB_SPIN_CAP (1u << 18)
__device__ __forceinline__ unsigned xb_ld(unsigned* p)              { return __hip_atomic_load(p, __ATOMIC_RELAXED, __HIP_MEMORY_SCOPE_AGENT); }
__device__ __forceinline__ unsigned xb_add(unsigned* p, unsigned v) { return __hip_atomic_fetch_add(p, v, __ATOMIC_RELAXED, __HIP_MEMORY_SCOPE_AGENT); }
__device__ __forceinline__ unsigned xb_xcc_id() { return (unsigned)__builtin_amdgcn_s_getreg((3 << 11) | 20) & 0xFu; }
#define XB_SPIN(cond, bar) do { unsigned _sp = 0; while (cond) { __builtin_amdgcn_s_sleep(1); \
    if ((++_sp & 255u) == 0u) { if (xb_ld(&(bar)[XB_TMO])) break; if (_sp > XB_SPIN_CAP) { atomicAdd(&(bar)[XB_TMO], 1u); break; } } } } while (0)
struct XcdBarrier { unsigned* bar; unsigned x; volatile LAS unsigned* st; };
__device__ __forceinline__ XcdBarrier xcd_barrier_post(unsigned* bar, volatile LAS unsigned* st) {
    XcdBarrier b; b.bar = bar; b.x = xb_xcc_id(); b.st = st;
    if (threadIdx.x == 0) (void)xb_add(&bar[XB_XCNT(b.x)], 1u);
    return b;
}
__device__ __forceinline__ void xcd_barrier_complete(unsigned* bar, unsigned x, unsigned& nloc, unsigned& nx) {
    const unsigned G = gridDim.x * gridDim.y * gridDim.z;
    unsigned sum, cnt, mine, sp = 0u;
    for (;;) {
        sum = 0u; cnt = 0u; mine = 0u;
#pragma unroll
        for (unsigned j = 0; j < 16; ++j) { const unsigned c = xb_ld(&bar[XB_XCNT(j)]); sum += c; cnt += (c > 0u) ? 1u : 0u; mine = (j == x) ? c : mine; }
        if (sum == G) break;
        __builtin_amdgcn_s_sleep(1);
        if ((++sp & 255u) == 0u) { if (xb_ld(&bar[XB_TMO])) break; if (sp > XB_SPIN_CAP) { atomicAdd(&bar[XB_TMO], 1u); break; } }
    }
    nloc = mine > 0u ? mine : 1u; nx = cnt > 0u ? cnt : 1u;
}
__device__ __forceinline__ void xcd_barrier(const XcdBarrier& b) {
    asm volatile("s_waitcnt vmcnt(0)" ::: "memory");
    __syncthreads();
    if (threadIdx.x == 0) {
        unsigned* bar = b.bar;
        __builtin_amdgcn_s_waitcnt(0);
        unsigned nloc = b.st[0], nx = b.st[1];
        if (nloc == 0u) { xcd_barrier_complete(bar, b.x, nloc, nx); b.st[0] = nloc; b.st[1] = nx; }
        const unsigned old = xb_add(&bar[XB_XSUB(b.x)], 1u);
        const unsigned gen = old / nloc;
        if (old + 1u == (gen + 1u) * nloc) {
            __builtin_amdgcn_fence(__ATOMIC_RELEASE, "agent");
            asm volatile("s_waitcnt vmcnt(0)" ::: "memory");
            const unsigned og = xb_add(&bar[XB_TOP], 1u);
            const unsigned tg = og / nx;
            if (og + 1u == (tg + 1u) * nx) xb_add(&bar[XB_TOPGEN], 1u);
            else XB_SPIN(xb_ld(&bar[XB_TOPGEN]) == tg, bar);
            __builtin_amdgcn_fence(__ATOMIC_ACQUIRE, "agent");
            xb_add(&bar[XB_XGEN(b.x)], 1u);
            asm volatile("s_waitcnt vmcnt(0)" ::: "memory");
        } else {
            XB_SPIN(xb_ld(&bar[XB_XGEN(b.x)]) == gen, bar);
            __builtin_amdgcn_fence(__ATOMIC_ACQUIRE, "agent");
            asm volatile("s_waitcnt vmcnt(0)" ::: "memory");
        }
    }
    __syncthreads();
}

#ifndef PROBE_MASK
#define PROBE_MASK 0
#endif
namespace att {
constexpr int NW = 8, QBLK = 32, KVBLK = 64, QB = NW * QBLK;
constexpr int SHM_V = KVBLK * HD * 2, SHM_K = KVBLK * HD * 2;
constexpr int LDS_BYTES = 2 * SHM_V + 2 * SHM_K + NW * 64 * 4;
constexpr float THR = 8.f;
typedef short s16x4 __attribute__((ext_vector_type(4)));
typedef short s16x8 __attribute__((ext_vector_type(8)));
typedef float f32x16 __attribute__((ext_vector_type(16)));
#define KSWZ(row, colB) ((row) * 256 + ((colB) ^ (((row) & 7) << 4)))
#define SBAR() __builtin_amdgcn_sched_barrier(0)
__device__ __forceinline__ int v_st(int k, int c) { const int kk = (k & ~0xC) | ((k & 4) << 1) | ((k & 8) >> 1); return ((kk >> 3) * 4 + (c >> 5)) * 512 + ((kk & 7) * 32 + (c & 31)) * 2; }
__device__ __forceinline__ int v_rd_base(int lane) { return ((lane & 3) << 3) | (((lane >> 2) & 3) << 6) | (((lane >> 4) & 1) << 5) | (((lane >> 5) & 1) << 8); }
constexpr int v_rd_off(int d0, int ks, int half) { return d0 * 512 + ks * 4096 + half * 2048; }
__device__ __forceinline__ int crow(int r, int hi) { return (r & 3) + 8 * (r >> 2) + 4 * hi; }
__device__ __forceinline__ h16x8 load8(const h16* p) { return *reinterpret_cast<const h16x8*>(p); }
__device__ __forceinline__ void mask_tile(f32x16& p0, f32x16& p1, int dq, unsigned W) {
    const float NEG = -__builtin_inff();
#pragma unroll
    for (int r = 0; r < 16; ++r) {
        const int c = (r & 3) + 8 * (r >> 2);
        if ((unsigned)(dq - c) >= W) p0[r] = NEG;
        if ((unsigned)(dq - c - 32) >= W) p1[r] = NEG;
    }
}
__device__ __forceinline__ void kill_tile(f32x16& p0, f32x16& p1, bool dead) {
    const float NEG = -__builtin_inff();
#pragma unroll
    for (int r = 0; r < 16; ++r) { p0[r] = dead ? NEG : p0[r]; p1[r] = dead ? NEG : p1[r]; }
}
__device__ __forceinline__ void partialSM(f32x16& p0, f32x16& p1, float& m_reg, float& mn, float& alpha) {
    float pmax = p0[0];
#pragma unroll
    for (int r = 1; r < 16; ++r) pmax = fmaxf(pmax, p0[r]);
#pragma unroll
    for (int r = 0; r < 16; ++r) pmax = fmaxf(pmax, p1[r]);
    { auto rr = __builtin_amdgcn_permlane32_swap(__float_as_uint(pmax), __float_as_uint(pmax), false, false);
      pmax = fmaxf(__uint_as_float(rr[0]), __uint_as_float(rr[1])); }
    constexpr float C2 = 1.4426950408889634f * SCALE;
    if (__builtin_expect(__all((pmax - m_reg) * SCALE <= THR), 1)) { mn = m_reg; alpha = 1.f; }
    else { mn = fmaxf(m_reg, pmax); alpha = __builtin_amdgcn_exp2f((m_reg - mn) * C2); m_reg = mn; }
    const float mnL = -mn * C2;
#pragma unroll
    for (int r = 0; r < 16; ++r) p0[r] = fmaf(p0[r], C2, mnL);
#pragma unroll
    for (int r = 0; r < 16; ++r) p1[r] = fmaf(p1[r], C2, mnL);
#pragma unroll
    for (int r = 0; r < 16; ++r) p0[r] = __builtin_amdgcn_exp2f(p0[r]);
}
__device__ __forceinline__ void finishSM(f32x16& p0, f32x16& p1, float alpha, float& l_reg, h16x8& pa0, h16x8& pa1, h16x8& pa2, h16x8& pa3) {
#pragma unroll
    for (int r = 0; r < 16; ++r) p1[r] = __builtin_amdgcn_exp2f(p1[r]);
    float ps = 0;
#pragma unroll
    for (int r = 0; r < 16; ++r) ps += p0[r];
#pragma unroll
    for (int r = 0; r < 16; ++r) ps += p1[r];
    { auto rr = __builtin_amdgcn_permlane32_swap(__float_as_uint(ps), __float_as_uint(ps), false, false);
      ps = __uint_as_float(rr[0]) + __uint_as_float(rr[1]); }
    l_reg = l_reg * alpha + ps;
#define PK4(P, B_, OUT) do { unsigned a0 = pk2h(P[B_+0], P[B_+1]), a1 = pk2h(P[B_+2], P[B_+3]);                          \
        unsigned b0 = pk2h(P[B_+4], P[B_+5]), b1 = pk2h(P[B_+6], P[B_+7]);                                             \
        auto r0 = __builtin_amdgcn_permlane32_swap(a0, b0, false, false); auto r1 = __builtin_amdgcn_permlane32_swap(a1, b1, false, false); \
        u32x4 w = {r0[0], r1[0], r0[1], r1[1]}; OUT = __builtin_bit_cast(h16x8, w); } while (0)
    PK4(p0, 0, pa0); PK4(p0, 8, pa1); PK4(p1, 0, pa2); PK4(p1, 8, pa3);
#undef PK4
}
template <int KB>
__device__ __forceinline__ void qkt(f32x16& p0, f32x16& p1, const char* K_lds, int r32, int hi, const h16x8* qr, bool act) {
    if (!act) { const float NEG = -__builtin_inff();
#pragma unroll
        for (int r = 0; r < 16; ++r) { p0[r] = NEG; p1[r] = NEG; } return; }
    p0 = f32x16{}; p1 = f32x16{};
    const char* kb[4];
#pragma unroll
    for (int dd = 0; dd < 4; ++dd) kb[dd] = K_lds + KB * SHM_K + KSWZ(r32, (dd * 16 + hi * 8) * 2);
#pragma unroll
    for (int d0 = 0; d0 < 8; ++d0) { const char* a = kb[d0 & 3] + (d0 >> 2) * 128;
        h16x8 b0 = *reinterpret_cast<const h16x8*>(a);
        h16x8 b1 = *reinterpret_cast<const h16x8*>(a + 32 * 256);
        p0 = __builtin_amdgcn_mfma_f32_32x32x16_f16(b0, qr[d0], p0, 0, 0, 0);
        p1 = __builtin_amdgcn_mfma_f32_32x32x16_f16(b1, qr[d0], p1, 0, 0, 0); }
}
template <int VB>
__device__ __forceinline__ void pv_tile(f32x16* o, int vb0, h16x8 pa0, h16x8 pa1, h16x8 pa2, h16x8 pa3, bool act) {
    if (!act) return;
#define TRRD(dst, off) asm volatile("ds_read_b64_tr_b16 %0, %1 offset:%2" : "=&v"(dst) : "v"(vb0), "i"(off) : "memory")
#define MKB(l, h) __builtin_bit_cast(h16x8, (s16x8){l[0], l[1], l[2], l[3], h[0], h[1], h[2], h[3]})
#define PV_D0(d0) do { s16x4 l0, l1, l2, l3, h0, h1, h2, h3; constexpr int b_ = VB * SHM_V + v_rd_off(d0, 0, 0); \
        TRRD(l0, b_); TRRD(h0, b_ + 2048); TRRD(l1, b_ + 4096); TRRD(h1, b_ + 6144); TRRD(l2, b_ + 8192); TRRD(h2, b_ + 10240); TRRD(l3, b_ + 12288); TRRD(h3, b_ + 14336); \
        asm volatile("s_waitcnt lgkmcnt(0)" ::: "memory"); SBAR();   \
        o[d0] = __builtin_amdgcn_mfma_f32_32x32x16_f16(pa0, MKB(l0, h0), o[d0], 0, 0, 0);   \
        o[d0] = __builtin_amdgcn_mfma_f32_32x32x16_f16(pa1, MKB(l1, h1), o[d0], 0, 0, 0);   \
        o[d0] = __builtin_amdgcn_mfma_f32_32x32x16_f16(pa2, MKB(l2, h2), o[d0], 0, 0, 0);   \
        o[d0] = __builtin_amdgcn_mfma_f32_32x32x16_f16(pa3, MKB(l3, h3), o[d0], 0, 0, 0); } while (0)
    PV_D0(0); PV_D0(1); PV_D0(2); PV_D0(3);
#undef PV_D0
#undef MKB
#undef TRRD
}

struct BlockRef { const h16* K; h16* Ob; float* LSE; const float* KS; int P0, pitch, opitch, W, lsestride, moba; };
struct Seam { h16x8 qr[8]; h16x8 st_v0, st_v1, st_k0, st_k1; };
__device__ __forceinline__ int swa_jlo(int P0, int W) { const int lowk = P0 - W + 1; return lowk > 0 ? lowk / KVBLK : 0; }
#define VMW() asm volatile("s_waitcnt vmcnt(0)" ::: "memory")
#define VMWN(n) asm volatile("s_waitcnt vmcnt(%0)" :: "i"(n) : "memory")
#define SLOAD_H(Kt, o0, o1) do { S.st_v0 = load8((Kt) + 1024 + (o0)); S.st_v1 = load8((Kt) + 1024 + (o1));              \
                         S.st_k0 = load8((Kt) + (o0)); S.st_k1 = load8((Kt) + (o1)); } while (0)
#define SWRITE_HK(bf) do { *(h16x8*)(K_lds + (bf) * SHM_K + kws) = S.st_k0; *(h16x8*)(K_lds + (bf) * SHM_K + kws + 32 * 256) = S.st_k1; } while (0)
#define SWRITE_HV(bf) do { *(h16x8*)(V_lds + (bf) * SHM_V + vst0) = S.st_v0; *(h16x8*)(V_lds + (bf) * SHM_V + vst1) = S.st_v1; } while (0)
#define SWRITE_H(bf) do { SWRITE_HV(bf); SWRITE_HK(bf); } while (0)
__device__ __forceinline__ void attn_prime(const BlockRef& cur, char* lds, Seam& S) {
    const int tid = threadIdx.x, wid = __builtin_amdgcn_readfirstlane(tid >> 6), lane = tid & 63, r32 = lane & 31, hi = lane >> 5;
    const int sr = tid >> 4, sc = (tid & 15) * 8, kws = KSWZ(sr, sc * 2); char* K_lds = lds + 2 * SHM_V;
    const int kb0 = swa_jlo(cur.P0, cur.W) * KVBLK;
    const h16* Qw = cur.K - 1024 + (size_t)(cur.P0 + wid * QBLK) * cur.pitch;
    const unsigned qo = (unsigned)(r32 * cur.pitch + hi * 8);
#pragma unroll
    for (int d0 = 0; d0 < 8; ++d0) S.qr[d0] = load8(Qw + qo + d0 * 16);
    { const unsigned o0 = (unsigned)(sr * cur.pitch + sc), o1 = o0 + 32u * (unsigned)cur.pitch; const h16* Kt = cur.K + (size_t)kb0 * cur.pitch;
      SLOAD_H(Kt, o0, o1); } VMW(); SWRITE_HK(0);
    __syncthreads();
}
__device__ __forceinline__ void attn_block(const BlockRef& cur, const BlockRef& nxt, char* lds, Seam& S) {
    const int tid = threadIdx.x, wid = __builtin_amdgcn_readfirstlane(tid >> 6), lane = tid & 63, r32 = lane & 31, hi = lane >> 5;
    const int W = cur.W;
    const int j_lo = swa_jlo(cur.P0, W);
    const int j_hi = (cur.P0 + QB - 1) / KVBLK + 1;
    const int NT = j_hi - j_lo;
    const int kbn = swa_jlo(nxt.P0, nxt.W) * KVBLK;
    const int qlo = cur.P0 + wid * QBLK, qm = qlo + r32 - 4 * hi;
    char* V_lds = lds; char* K_lds = lds + 2 * SHM_V;
    float* ws = (float*)(lds + 2 * SHM_V + 2 * SHM_K) + wid * 64; float* li_l = ws, * al_l = ws + 32;
    float m_reg = -1e30f, l_reg = 0; f32x16 o[4] = {};
    const int sr = tid >> 4, sc = (tid & 15) * 8, vst0 = v_st(sr, sc), vst1 = v_st(32 + sr, sc), kws = KSWZ(sr, sc * 2);
    const int vb0 = (int)(uintptr_t)V_lds + v_rd_base(lane);
    const h16* Kh = cur.K; const int pitch = cur.pitch;
    const unsigned so0 = (unsigned)(sr * pitch + sc), so1 = so0 + 32u * (unsigned)pitch;
#define KTILE(t) (Kh + (size_t)KBASE(t) * pitch)
    unsigned selmask = 0xffffffffu;
    if (cur.moba) {
        const int qblk = cur.P0 >> 8;
        f32x16 gacc = f32x16{};
#pragma unroll
        for (int d0 = 0; d0 < 8; ++d0) {
            f32x4 a0 = {0.f, 0.f, 0.f, 0.f}, a1 = a0;
            if (r32 < qblk) { const float* kp = cur.KS + (size_t)(r32 * 2) * 1024 + d0 * 16 + hi * 8;
                a0 = *(const f32x4*)kp + *(const f32x4*)(kp + 1024); a1 = *(const f32x4*)(kp + 4) + *(const f32x4*)(kp + 1024 + 4); }
            a0 = a0 * (1.0f / 256.0f); a1 = a1 * (1.0f / 256.0f);
            u32x4 w = {pk2h(a0[0], a0[1]), pk2h(a0[2], a0[3]), pk2h(a1[0], a1[1]), pk2h(a1[2], a1[3])};
            gacc = __builtin_amdgcn_mfma_f32_32x32x16_f16(__builtin_bit_cast(h16x8, w), S.qr[d0], gacc, 0, 0, 0);
        }
        float gb[16];
#pragma unroll
        for (int j = 0; j < 16; ++j) { const int rj = (j & 3) + 4 * (j >> 3); const float own = gacc[rj]; const float oth = __shfl_xor(own, 32);
            gb[j] = (hi == ((j >> 2) & 1)) ? own : oth; }
        unsigned sel = 0u;
#pragma unroll
        for (int rnd = 0; rnd < 3; ++rnd) { float best = -3.0e38f; int bi = -1;
#pragma unroll
            for (int j = 0; j < 15; ++j) { const bool ok = (j < qblk) && !((sel >> j) & 1u) && (gb[j] > best); best = ok ? gb[j] : best; bi = ok ? j : bi; }
            if (bi >= 0) sel |= 1u << bi; }
        selmask = sel | (1u << qblk);
    }
#define RESC(a) do { if (__any((a) < 1.f)) { if (hi == 0) al_l[r32] = (a); asm volatile("s_waitcnt lgkmcnt(0)" ::: "memory");              \
                     _Pragma("unroll") for (int d_ = 0; d_ < 4; ++d_) _Pragma("unroll") for (int r = 0; r < 16; ++r) o[d_][r] *= al_l[crow(r, hi)]; } } while (0)
#define KBASE(t) ((j_lo + (t)) * KVBLK)
#define SELB(t) (((selmask >> (KBASE(t) >> 8)) & 1u) != 0u)
#define ACT(t) (KBASE(t) <= qlo + QBLK - 1 && KBASE(t) + KVBLK - 1 >= qlo - W + 1 && (!cur.moba || __any(SELB(t))))
#define MASKT(P0_, P1_, t) do { const int kb_ = KBASE(t); if (ACT(t)) { if (kb_ + KVBLK - 1 > qlo || kb_ <= qlo + QBLK - 1 - W) mask_tile(P0_, P1_, qm - kb_, (unsigned)W); \
                                 if (cur.moba && !__all(SELB(t))) kill_tile(P0_, P1_, !SELB(t)); } } while (0)
    constexpr int NQL = 8;
#define SEAM_K0() do { VMWN(NQL); SWRITE_HK(0); SBAR(); } while (0)
    f32x16 pA0, pA1, pB0, pB1; float mnA, mnB, alA, alB; h16x8 pa0, pa1, pa2, pa3;
    SWRITE_HV(0); SBAR();
    if (NT > 1) { SLOAD_H(KTILE(1), so0, so1); }
    SBAR(); qkt<0>(pA0, pA1, K_lds, r32, hi, S.qr, ACT(0));
    MASKT(pA0, pA1, 0); partialSM(pA0, pA1, m_reg, mnA, alA);
    if (NT > 1) { VMW(); SWRITE_H(1); }
    __syncthreads();
#define HALF_STEP(PX0, PX1, mnX, alX, PY0, PY1, alY, t, KB, VB, SB) do {                                                      \
        SBAR(); qkt<KB>(PX0, PX1, K_lds, r32, hi, S.qr, ACT(t));                                             \
        finishSM(PY0, PY1, alY, l_reg, pa0, pa1, pa2, pa3); SBAR();                                                           \
        if ((t) + 1 < NT) { SLOAD_H(KTILE((t) + 1), so0, so1); SBAR(); }                                               \
        pv_tile<VB>(o, vb0, pa0, pa1, pa2, pa3, ACT((t) - 1)); MASKT(PX0, PX1, (t)); partialSM(PX0, PX1, m_reg, mnX, alX);                                        \
        __syncthreads();                                                                                                      \
        if ((t) + 1 < NT) { VMW(); SWRITE_H(SB); }                                                                          \
        RESC(alX); __syncthreads(); } while (0)
    for (int t = 1; t + 1 < NT; t += 2) {
        HALF_STEP(pB0, pB1, mnB, alB, pA0, pA1, alA, t, 1, 0, 0);
        HALF_STEP(pA0, pA1, mnA, alA, pB0, pB1, alB, t + 1, 0, 1, 1);
    }
    const bool even = (NT & 1) == 0;
    if (even) { SBAR(); qkt<1>(pB0, pB1, K_lds, r32, hi, S.qr, ACT(NT - 1)); SBAR(); }
    { const unsigned n0 = (unsigned)(sr * nxt.pitch + sc), n1 = n0 + 32u * (unsigned)nxt.pitch; const h16* Kt = nxt.K + (size_t)kbn * nxt.pitch;
      SLOAD_H(Kt, n0, n1); SBAR();
      const h16* Qw = nxt.K - 1024 + (size_t)(nxt.P0 + wid * QBLK) * nxt.pitch; const unsigned qo = (unsigned)(r32 * nxt.pitch + hi * 8);
#pragma unroll
      for (int d0 = 0; d0 < 8; ++d0) S.qr[d0] = load8(Qw + qo + d0 * 16); }
    SBAR();
    finishSM(pA0, pA1, alA, l_reg, pa0, pa1, pa2, pa3); SBAR();
    pv_tile<0>(o, vb0, pa0, pa1, pa2, pa3, ACT(even ? NT - 2 : NT - 1));
    if (even) { MASKT(pB0, pB1, NT - 1); partialSM(pB0, pB1, m_reg, mnB, alB); __syncthreads(); RESC(alB);
        finishSM(pB0, pB1, alB, l_reg, pa0, pa1, pa2, pa3); SBAR(); pv_tile<1>(o, vb0, pa0, pa1, pa2, pa3, ACT(NT - 1)); }
    SBAR(); SEAM_K0();
    if (hi == 0) { li_l[r32] = l_reg; if (cur.LSE) cur.LSE[(size_t)(wid * QBLK + r32) * cur.lsestride] = m_reg * SCALE + __logf(l_reg); }
    asm volatile("s_waitcnt lgkmcnt(0)" ::: "memory");
    float rli[16];
#pragma unroll
    for (int r = 0; r < 16; ++r) rli[r] = __builtin_amdgcn_rcpf(li_l[crow(r, hi)]);
    h16* Ow = cur.Ob + (size_t)(cur.P0 + wid * QBLK) * cur.opitch;
    const unsigned olane = (unsigned)(4 * hi * cur.opitch + r32);
#pragma unroll
    for (int r = 0; r < 16; ++r) { h16* rp = Ow + (size_t)(((r & 3) + 8 * (r >> 2)) * cur.opitch);
#pragma unroll
        for (int d0 = 0; d0 < 4; ++d0) { const float v = o[d0][r] * rli[r];
            const float vn = __shfl_xor(v, 1);
            if ((r32 & 1) == 0) *(unsigned*)(rp + olane + d0 * 32) = pk2h(v, vn); } }
    __syncthreads();
#undef RESC
#undef KBASE
#undef SELB
#undef ACT
#undef MASKT
#undef SEAM_K0
#undef HALF_STEP
#undef KTILE
}
#undef ROWP
#undef VMW
#undef VMWN
#undef SLOAD_H
#undef SWRITE_HK
#undef SWRITE_HV
#undef SWRITE_H

__device__ __forceinline__ BlockRef unit_ref(int idx, unsigned char* ws) {
    const h16* QKV = (const h16*)(ws + WS_QKV);
    BlockRef R;
    if (idx < 512) { const int qb = 15 - (idx >> 5), bh = idx & 31, b = bh >> 3, h = bh & 7;
        const size_t tok0 = (size_t)b * SEQ;
        R.K = QKV + tok0 * NQKV + 1024 + h * HD;
        R.Ob = (h16*)(ws + WS_OA) + tok0 * 1024 + h * HD; R.LSE = nullptr; R.KS = (const float*)(ws + WS_KSUM) + (size_t)(b * 16 * 2) * 1024 + h * HD;
        R.P0 = qb * 256; R.pitch = NQKV; R.opitch = 1024; R.W = 1 << 30; R.lsestride = 0; R.moba = 1; }
    else { const int j = idx - 512, g = j >> 9, rem = j & 511, bh = rem & 31, sub = rem >> 5, b = bh >> 3, h = bh & 7;
        const int d = (g == 0) ? 1 : (g == 1) ? 4 : 16, nqb = 16 / d, r = sub / nqb, qb = sub % nqb;
        const size_t tok0 = (size_t)b * SEQ + r, tokq = tok0 + (size_t)d * qb * 256;
        R.K = QKV + tok0 * NQKV + 4096 + h * HD;
        h16* OBg = (h16*)(ws + (g == 0 ? WS_OB0 : g == 1 ? WS_OB1 : WS_OB2));
        R.Ob = OBg + tok0 * 1024 + h * HD; R.LSE = (float*)(ws + WS_LSE) + ((size_t)g * M + tokq) * 8 + h; R.KS = nullptr;
        R.P0 = qb * 256; R.pitch = NQKV * d; R.opitch = 1024 * d; R.W = 129; R.lsestride = 8 * d; R.moba = 0; }
    return R;
}
constexpr int NUNITS = 2048;
__device__ __forceinline__ int unit_pos(int k, int G, int w) { return (k & 1) ? (k + 1) * G - 1 - w : k * G + w; }
__device__ __forceinline__ void attn_phase(char* lds, unsigned char* ws, int G, int w) {
    int k = 0; int p = unit_pos(0, G, w); if (p >= NUNITS) return;
    BlockRef cur = unit_ref(p, ws);
    Seam S;
    attn_prime(cur, lds, S);
    for (;;) {
        const int pn = unit_pos(k + 1, G, w); const bool last = pn >= NUNITS;
        const BlockRef nxt = last ? cur : unit_ref(pn, ws);
        attn_block(cur, nxt, lds, S);
        if (last) break;
        cur = nxt; ++k;
    }
}
#undef KSWZ
#undef SBAR
}

constexpr int MK_LDS_BYTES = 147456, MK_XLDS_OFF = 131072;
struct MkArgs { Ptrs P; int ph_lo, ph_hi; };
namespace cg = cooperative_groups;
__global__ void __launch_bounds__(512, 2) mk_fwd(MkArgs a) {
    cg::grid_group grid = cg::this_grid();
    extern __shared__ __attribute__((aligned(16))) unsigned char lds_raw[];
    LAS unsigned char* lds = (LAS unsigned char*)lds_raw;
    const Ptrs& P = a.P;
    if (a.ph_lo < 0) grid.sync();
    volatile LAS unsigned* xst = (volatile LAS unsigned*)(lds + MK_XLDS_OFF + 8192);
    if (threadIdx.x < 4) xst[threadIdx.x] = 0u;
    __syncthreads();
    XcdBarrier xbar = xcd_barrier_post((unsigned*)(a.P.ws + WS_CTL), xst);

    const int tid = threadIdx.x, lane = tid & 63, wave = __builtin_amdgcn_readfirstlane(tid >> 6);
    const int G = gridDim.x, gw = blockIdx.x * 8 + wave, NGW = G * 8;
    unsigned char* ws = P.ws;
#define IN(k) (a.ph_lo <= (k) && (k) < a.ph_hi)
#if USE_CG_SYNC
#define SEAM(k) do { if (IN(k) && IN((k) + 1)) grid.sync(); } while (0)
#else
#define SEAM(k) do { if (IN(k) && IN((k) + 1)) xcd_barrier(xbar); } while (0)
#endif
#define PH(k) if (IN(k))
#define PHB() do { } while (0)
    PH(0) { PHB(); p0_prologue(P, (LAS float*)lds + wave * 64 * 33, gw, NGW, lane); }
    SEAM(0);
    PH(1) { PHB(); pg8::Gemm g{ws + WS_XN, ws + WS_WQKV, M, NQKV, DM, 0, 0}; pg8::StaticOrder S; S.init(M, NQKV, G, (int)blockIdx.x);
        pg8::EpiQKV E{(h16*)(ws + WS_QKV), (const f32x2*)(ws + WS_CS), (float*)(ws + WS_KSUM)};
        pg8::gemm_phase<pg8::EpiQKV, pg8::StaticOrder>(lds, lds + MK_XLDS_OFF, g, S, E); }
    SEAM(1);
    PH(2) { PHB(); att::attn_phase((char*)lds_raw, ws, G, (int)blockIdx.x); }
    SEAM(2);
    PH(3) { PHB(); for (int m = gw; m < M; m += NGW) p3_row(P, m, lane); }
    SEAM(3);
    PH(4) { PHB(); pg8::Gemm g{ws + WS_MIX, ws + WS_WO, M, DM, DM, 0, 0}; pg8::StaticOrder S; S.init(M, DM, G, (int)blockIdx.x);
        pg8::EpiY E{(h16*)(ws + WS_Y), (float*)(ws + WS_SS)};
        pg8::gemm_phase<pg8::EpiY, pg8::StaticOrder>(lds, lds + MK_XLDS_OFF, g, S, E); }
    SEAM(4);
    PH(5) { PHB(); for (int m = gw; m < M; m += NGW)
        resid_row<true>(P.x + (size_t)m * DM, (const h16*)(ws + WS_Y) + (size_t)m * DM, (const float*)(ws + WS_SS) + (size_t)m * 32, P.g_attn_post, P.g_ffn_pre,
                        P.out + (size_t)m * DM, (h16*)(ws + WS_XN2 + (size_t)m * DM * (F8FFN ? 1 : 2)), lane); }
    SEAM(5);
    PH(6) { PHB(); pg8::Gemm g{ws + WS_XN2, ws + WS_WGU, M, 2 * FF, DM, 0x76767676, 0x7f7f7f7f};   pg8::StaticOrder S; S.init(M, 2 * FF, G, (int)blockIdx.x);
        pg8::EpiGU E{(h16*)(ws + WS_ACT), P.conv_w, P.conv_b, (float*)(ws + WS_HALO), (float*)(ws + WS_FIXP), (float*)(ws + WS_FIXU)};
        pg8::gemm_phase<pg8::EpiGU, pg8::StaticOrder, (F8FFN != 0)>(lds, lds + MK_XLDS_OFF, g, S, E); }
    SEAM(6);
    PH(7) { PHB(); p5b_fixup(P, blockIdx.x * 512 + tid, G * 512); }
    SEAM(7);
    PH(8) { PHB(); pg8::Gemm g{ws + WS_ACT, ws + WS_WD, M, DM, FF, 0x75757575, 0x7c7c7c7c};   pg8::StaticOrder S; S.init(M, DM, G, (int)blockIdx.x);
        pg8::EpiY E{(h16*)(ws + WS_Y2), (float*)(ws + WS_SS)};
        pg8::gemm_phase<pg8::EpiY, pg8::StaticOrder, (F8FFN != 0)>(lds, lds + MK_XLDS_OFF, g, S, E); }
    SEAM(8);
    if (IN(9)) { for (int m = gw; m < M; m += NGW)
        resid_row<false>(P.out + (size_t)m * DM, (const h16*)(ws + WS_Y2) + (size_t)m * DM, (const float*)(ws + WS_SS) + (size_t)m * 32, P.g_ffn_post, nullptr,
                         P.out + (size_t)m * DM, nullptr, lane); }
#undef IN
#undef SEAM
#undef PH
#undef PHB
}

extern "C" void kernel_launch(void* const* d_in, const int* in_sizes, int n_in, void* d_out, int out_size, void* d_ws, size_t ws_size, hipStream_t stream) {
    if (n_in != 15 || ws_size < WS_END) { fprintf(stderr, "kernel_launch: unexpected n_in %d or ws_size %zu (need %zu)\n", n_in, ws_size, (size_t)WS_END); return; }
    static int grid = 0;
    if (grid == 0) {
        int dev = 0, cus = 0, per_cu = 0;
        (void)hipGetDevice(&dev); (void)hipDeviceGetAttribute(&cus, hipDeviceAttributeMultiprocessorCount, dev);
        (void)hipFuncSetAttribute((const void*)mk_fwd, hipFuncAttributeMaxDynamicSharedMemorySize, MK_LDS_BYTES);
        (void)hipOccupancyMaxActiveBlocksPerMultiprocessor(&per_cu, (const void*)mk_fwd, 512, MK_LDS_BYTES);
        if (per_cu < 1) per_cu = 1;
        grid = cus * per_cu;
        fprintf(stderr, "kernel_launch: cus %d per_cu %d grid %d\n", cus, per_cu, grid);
    }
    Ptrs P{};
    P.x = (const float*)d_in[0]; P.pos = (const int*)d_in[1]; P.g_attn_pre = (const float*)d_in[2]; P.w_qkv = (const float*)d_in[3]; P.g_moba = (const float*)d_in[4];
    P.g_dil = (const float*)d_in[5]; P.w_o = (const float*)d_in[6]; P.g_attn_post = (const float*)d_in[7]; P.g_ffn_pre = (const float*)d_in[8]; P.w_gate = (const float*)d_in[9];
    P.w_up = (const float*)d_in[10]; P.conv_w = (const float*)d_in[11]; P.conv_b = (const float*)d_in[12]; P.w_down = (const float*)d_in[13]; P.g_ffn_post = (const float*)d_in[14];
    P.out = (float*)d_out; P.ws = (unsigned char*)d_ws;
    unsigned char* ws = P.ws;
    MkArgs a{}; a.P = P;
    (void)hipMemsetAsync((char*)d_ws + WS_CTL, 0, 16384, stream);
#if ONE_LAUNCH
    a.ph_lo = 0; a.ph_hi = 10;
    { void* kargs[] = {&a};
      hipError_t e = hipLaunchCooperativeKernel((const void*)mk_fwd, dim3(grid), dim3(512), kargs, MK_LDS_BYTES, stream);
      if (e != hipSuccess) fprintf(stderr, "kernel_launch: cooperative launch failed: %s (grid %d)\n", hipGetErrorString(e), grid); }
    return;
#endif
#define MK(lo, hi) do { a.ph_lo = (lo); a.ph_hi = (hi); for (int rr_ = 0; rr_ < 1 + ((PROBE_MASK >> (lo)) & 1); ++rr_) hipLaunchKernelGGL(mk_fwd, dim3(grid), dim3(512), MK_LDS_BYTES, stream, a); } while (0)
    MK(0, 1);
#if OPT_P1
    MK(1, 2);
#else
    for (int c = 0; c < 6; ++c) { float* scr = (float*)(ws + WS_NSCR1);
        nv_gemm<<<dim3(1024 / 64, M / 64), 256, 0, stream>>>((const h16*)(ws + WS_XN), DM, (const h16*)(ws + WS_WQKV) + (size_t)c * 1024 * DM, DM, scr, 1024, DM);
        nv_rope<<<(M * 1024) / 256, 256, 0, stream>>>(scr, (h16*)(ws + WS_QKV), (const f32x2*)(ws + WS_CS), c); }
    nv_ksum<<<(64 * 1024) / 256, 256, 0, stream>>>((const h16*)(ws + WS_QKV), (float*)(ws + WS_KSUM));
#endif
#if OPT_P2
    MK(2, 3);
#else
    for (int mode = 0; mode < 4; ++mode)
        nv_attn<<<4096, 256, 0, stream>>>((const h16*)(ws + WS_QKV), (const float*)(ws + WS_KSUM), (h16*)(ws + WS_OA), (h16*)(ws + WS_OB0), (h16*)(ws + WS_OB1), (h16*)(ws + WS_OB2), (float*)(ws + WS_LSE), mode);
#endif
    MK(3, 4);
#if OPT_P4
    MK(4, 5);
#else
    { float* scr = (float*)(ws + WS_NSCR4);
      nv_gemm<<<dim3(DM / 64, M / 64), 256, 0, stream>>>((const h16*)(ws + WS_MIX), DM, (const h16*)(ws + WS_WO), DM, scr, DM, DM);
      nv_cvt_ss<<<(M * 32) / 4, 256, 0, stream>>>(scr, DM, (h16*)(ws + WS_Y), 0, (float*)(ws + WS_SS)); }
#endif
    MK(5, 6);
#if OPT_P5
    MK(6, 7); MK(7, 8);
#else
    for (int c = 0; c < 32; ++c) { float* scr = (float*)(ws + WS_NSCR5);
        nv_gemm<<<dim3(512 / 64, M / 64), 256, 0, stream>>>((const h16*)(ws + WS_XN2), DM, (const h16*)(ws + WS_WGU) + (size_t)c * 512 * DM, DM, scr, 512, DM);
        nv_conv<<<(M * 256) / 256, 256, 0, stream>>>(scr, (h16*)(ws + WS_ACT), P.conv_w, P.conv_b, 2 * c); }
#endif
#if OPT_P6
    MK(8, 9);
#else
    for (int c = 0; c < 2; ++c) { float* scr = (float*)(ws + WS_NSCR6);
        nv_gemm<<<dim3(1024 / 64, M / 64), 256, 0, stream>>>((const h16*)(ws + WS_ACT), FF, (const h16*)(ws + WS_WD) + (size_t)c * 1024 * FF, FF, scr, 1024, FF);
        nv_cvt_ss<<<(M * 16) / 4, 256, 0, stream>>>(scr, 1024, (h16*)(ws + WS_Y2), c * 1024, (float*)(ws + WS_SS)); }
#endif
    MK(9, 10);
#undef MK
}
```

```cpp
#define OPT_P1 1
#define OPT_P2 1
#define OPT_P4 1
#define OPT_P5 1
#define OPT_P6 1
#define ONE_LAUNCH 1
#define USE_CG_SYNC 0
#include <hip/hip_runtime.h>
#include <hip/hip_cooperative_groups.h>
#include <cstdio>
#include <cstdint>

typedef _Float16 h16;
typedef h16 h16x8 __attribute__((ext_vector_type(8)));
typedef h16 h16x2 __attribute__((ext_vector_type(2)));
typedef float f32x4 __attribute__((ext_vector_type(4)));
typedef float f32x2 __attribute__((ext_vector_type(2)));
typedef unsigned u32x4 __attribute__((ext_vector_type(4)));
#define LAS __attribute__((address_space(3)))

constexpr int BATCH = 4, SEQ = 4096, DM = 2048, M = BATCH * SEQ, NQKV = 6144, FF = 8192, HD = 128, NH = 8;
constexpr float RMS_EPS = 1e-6f;
constexpr float SCALE = 0.08838834764831845f;
constexpr size_t MiB = 1u << 20;
constexpr size_t WS_CTL = 0, WS_CS = 1 * MiB, WS_KSUM = 3 * MiB, WS_SS = 4 * MiB, WS_LSE = 6 * MiB, WS_HALO = 8 * MiB, WS_FIXP = 12 * MiB, WS_FIXU = 16 * MiB;
constexpr size_t WS_WQKV = 24 * MiB, WS_WO = 48 * MiB, WS_WGU = 56 * MiB, WS_WD = 120 * MiB;
constexpr size_t WS_XN = 152 * MiB;
constexpr size_t WS_OB0 = 152 * MiB, WS_OB1 = 184 * MiB, WS_XN2 = 152 * MiB, WS_Y2 = 152 * MiB;
constexpr size_t WS_QKV = 216 * MiB;
constexpr size_t WS_MIX = 216 * MiB, WS_Y = 280 * MiB, WS_ACT = 216 * MiB;
constexpr size_t WS_OA = 408 * MiB, WS_OB2 = 440 * MiB;
constexpr size_t WS_WQKV8 = 32 * MiB;
constexpr size_t WS_XN8 = 408 * MiB;
constexpr size_t WS_NSCR1 = 408 * MiB;
constexpr size_t WS_NSCR4 = 344 * MiB;
constexpr size_t WS_NSCR5 = 472 * MiB;
constexpr size_t WS_NSCR6 = 24 * MiB;
constexpr size_t WS_END = 512 * MiB;

struct Ptrs {
    const float* x; const int* pos; const float* g_attn_pre; const float* w_qkv; const float* g_moba; const float* g_dil; const float* w_o;
    const float* g_attn_post; const float* g_ffn_pre; const float* w_gate; const float* w_up; const float* conv_w; const float* conv_b;
    const float* w_down; const float* g_ffn_post; float* out; unsigned char* ws;
};

__device__ __forceinline__ unsigned pk2h(float lo, float hi) { f32x2 v = {lo, hi}; h16x2 b = __builtin_convertvector(v, h16x2); return __builtin_bit_cast(unsigned, b); }
__device__ __forceinline__ unsigned pk4f8(float a, float b, float c, float d) {
    a = fminf(fmaxf(a, -448.f), 448.f); b = fminf(fmaxf(b, -448.f), 448.f); c = fminf(fmaxf(c, -448.f), 448.f); d = fminf(fmaxf(d, -448.f), 448.f);
    int w = __builtin_amdgcn_cvt_pk_fp8_f32(a, b, 0, false); w = __builtin_amdgcn_cvt_pk_fp8_f32(c, d, w, true); return (unsigned)w; }
typedef unsigned u32x2 __attribute__((ext_vector_type(2)));
#ifndef F8FFN
#define F8FFN 1
#endif
#ifndef F8ATT
#define F8ATT 1
#endif
constexpr float F8_WGU_SCALE = 512.f, F8_WD_SCALE = 1024.f, F8_ACT_SCALE = 8.f;
__device__ __forceinline__ float wave_sum(float v) {
#pragma unroll
    for (int o = 1; o < 64; o <<= 1) v += __shfl_xor(v, o);
    return v;
}
__device__ __forceinline__ float gelu_tanh(float x) {
    const float t = x * x;
    const float z2 = x * (1.5957691216057308f + 0.07135481627f * t);
    const float e = __builtin_amdgcn_exp2f(-z2 * 1.4426950408889634f);
    return x * __builtin_amdgcn_rcpf(1.0f + e);
}

__device__ __forceinline__ void p0_transpose_item(const float* W, int K, int N, h16* WT, int k0, int n0, int dest_row0, LAS float* scr, int lane) {
#pragma unroll 8
    for (int i = 0; i < 32; ++i) { const int kk = 2 * i + (lane >> 5); scr[kk * 33 + (lane & 31)] = W[(size_t)(k0 + kk) * N + n0 + (lane & 31)]; }
    asm volatile("s_waitcnt lgkmcnt(0)" ::: "memory");
    const int c = lane & 7;
#pragma unroll
    for (int j = 0; j < 4; ++j) { const int n = (lane >> 3) + 8 * j; const LAS float* s = scr + (8 * c) * 33 + n;
        u32x4 o; o.x = pk2h(s[0 * 33], s[1 * 33]); o.y = pk2h(s[2 * 33], s[3 * 33]); o.z = pk2h(s[4 * 33], s[5 * 33]); o.w = pk2h(s[6 * 33], s[7 * 33]);
        *(u32x4*)(WT + (size_t)(dest_row0 + n) * K + k0 + 8 * c) = o; }
    asm volatile("s_waitcnt lgkmcnt(0)" ::: "memory");
}
__device__ __forceinline__ void p0_transpose_item_f8(const float* W, int K, int N, unsigned char* WT, int k0, int n0, int dest_row0, float scale, LAS float* scr, int lane) {
#pragma unroll 8
    for (int i = 0; i < 32; ++i) { const int kk = 2 * i + (lane >> 5); scr[kk * 33 + (lane & 31)] = W[(size_t)(k0 + kk) * N + n0 + (lane & 31)]; }
    asm volatile("s_waitcnt lgkmcnt(0)" ::: "memory");
    const int c = lane & 7;
#pragma unroll
    for (int j = 0; j < 4; ++j) { const int n = (lane >> 3) + 8 * j; const LAS float* s = scr + (8 * c) * 33 + n;
        u32x2 o; o.x = pk4f8(s[0 * 33] * scale, s[1 * 33] * scale, s[2 * 33] * scale, s[3 * 33] * scale); o.y = pk4f8(s[4 * 33] * scale, s[5 * 33] * scale, s[6 * 33] * scale, s[7 * 33] * scale);
        *(u32x2*)(WT + (size_t)(dest_row0 + n) * K + k0 + 8 * c) = o; }
    asm volatile("s_waitcnt lgkmcnt(0)" ::: "memory");
}
__device__ __forceinline__ void rms_row_to_h16(const float* xrow, const float* g, h16* orow, unsigned char* orow8, int lane) {
    f32x4 v[4][2]; float s = 0.f;
#pragma unroll
    for (int j = 0; j < 4; ++j) { const int c = (lane + 64 * j) * 8; v[j][0] = *(const f32x4*)(xrow + c); v[j][1] = *(const f32x4*)(xrow + c + 4);
#pragma unroll
        for (int q = 0; q < 2; ++q) s += (v[j][q].x * v[j][q].x + v[j][q].y * v[j][q].y) + (v[j][q].z * v[j][q].z + v[j][q].w * v[j][q].w); }
    const float rstd = 1.0f / sqrtf(wave_sum(s) * (1.0f / DM) + RMS_EPS);
#pragma unroll
    for (int j = 0; j < 4; ++j) { const int c = (lane + 64 * j) * 8; const f32x4 g0 = *(const f32x4*)(g + c), g1 = *(const f32x4*)(g + c + 4);
        u32x4 o; o.x = pk2h(v[j][0].x * rstd * g0.x, v[j][0].y * rstd * g0.y); o.y = pk2h(v[j][0].z * rstd * g0.z, v[j][0].w * rstd * g0.w);
        o.z = pk2h(v[j][1].x * rstd * g1.x, v[j][1].y * rstd * g1.y); o.w = pk2h(v[j][1].z * rstd * g1.z, v[j][1].w * rstd * g1.w);
        *(u32x4*)(orow + c) = o;
        if (orow8) { u32x2 o8; o8.x = pk4f8(v[j][0].x * rstd * g0.x, v[j][0].y * rstd * g0.y, v[j][0].z * rstd * g0.z, v[j][0].w * rstd * g0.w);
            o8.y = pk4f8(v[j][1].x * rstd * g1.x, v[j][1].y * rstd * g1.y, v[j][1].z * rstd * g1.z, v[j][1].w * rstd * g1.w); *(u32x2*)(orow8 + c) = o8; } }
}
constexpr int I_QKV = (DM / 64) * (NQKV / 32), I_O = (DM / 64) * (DM / 32), I_G = (DM / 64) * (FF / 32), I_D = (FF / 64) * (DM / 32);
constexpr int P0_ITEMS = I_QKV + I_O + 2 * I_G + I_D;
__device__ __forceinline__ void p0_prologue(const Ptrs& P, LAS float* scr  , int gw, int NGW, int lane) {
    h16* WQKV = (h16*)(P.ws + WS_WQKV); h16* WO = (h16*)(P.ws + WS_WO); h16* WGU = (h16*)(P.ws + WS_WGU); h16* WD = (h16*)(P.ws + WS_WD);
    for (int it = gw; it < P0_ITEMS; it += NGW) {
        int r = it;
#if F8ATT
        if (r < I_QKV) { const int nb = NQKV / 32, kb = r / nb, n0 = (r % nb) * 32;
            if (n0 < 2048) p0_transpose_item(P.w_qkv, DM, NQKV, WQKV, kb * 64, n0, n0, scr, lane);
            else p0_transpose_item_f8(P.w_qkv, DM, NQKV, P.ws + WS_WQKV8, kb * 64, n0, n0 - 2048, F8_WGU_SCALE, scr, lane);
            continue; } r -= I_QKV;
        if (r < I_O) { const int nb = DM / 32, kb = r / nb, n0 = (r % nb) * 32; p0_transpose_item_f8(P.w_o, DM, DM, (unsigned char*)WO, kb * 64, n0, n0, F8_WGU_SCALE, scr, lane); continue; } r -= I_O;
#else
        if (r < I_QKV) { const int nb = NQKV / 32, kb = r / nb, n0 = (r % nb) * 32; p0_transpose_item(P.w_qkv, DM, NQKV, WQKV, kb * 64, n0, n0, scr, lane); continue; } r -= I_QKV;
        if (r < I_O) { const int nb = DM / 32, kb = r / nb, n0 = (r % nb) * 32; p0_transpose_item(P.w_o, DM, DM, WO, kb * 64, n0, n0, scr, lane); continue; } r -= I_O;
#endif
#if F8FFN
        if (r < I_G) { const int nb = FF / 32, kb = r / nb, n0 = (r % nb) * 32; p0_transpose_item_f8(P.w_gate, DM, FF, (unsigned char*)WGU, kb * 64, n0, (n0 / 128) * 256 + (n0 % 128), F8_WGU_SCALE, scr, lane); continue; } r -= I_G;
        if (r < I_G) { const int nb = FF / 32, kb = r / nb, n0 = (r % nb) * 32; p0_transpose_item_f8(P.w_up, DM, FF, (unsigned char*)WGU, kb * 64, n0, (n0 / 128) * 256 + 128 + (n0 % 128), F8_WGU_SCALE, scr, lane); continue; } r -= I_G;
        { const int nb = DM / 32, kb = r / nb, n0 = (r % nb) * 32; p0_transpose_item_f8(P.w_down, FF, DM, (unsigned char*)WD, kb * 64, n0, n0, F8_WD_SCALE, scr, lane); }
#else
        if (r < I_G) { const int nb = FF / 32, kb = r / nb, n0 = (r % nb) * 32; p0_transpose_item(P.w_gate, DM, FF, WGU, kb * 64, n0, (n0 / 128) * 256 + (n0 % 128), scr, lane); continue; } r -= I_G;
        if (r < I_G) { const int nb = FF / 32, kb = r / nb, n0 = (r % nb) * 32; p0_transpose_item(P.w_up, DM, FF, WGU, kb * 64, n0, (n0 / 128) * 256 + 128 + (n0 % 128), scr, lane); continue; } r -= I_G;
        { const int nb = DM / 32, kb = r / nb, n0 = (r % nb) * 32; p0_transpose_item(P.w_down, FF, DM, WD, kb * 64, n0, n0, scr, lane); }
#endif
    }
    h16* XN = (h16*)(P.ws + WS_XN);
    for (int m = gw; m < M; m += NGW) rms_row_to_h16(P.x + (size_t)m * DM, P.g_attn_pre, XN + (size_t)m * DM, F8ATT ? P.ws + WS_XN8 + (size_t)m * DM : nullptr, lane);
    f32x2* CS = (f32x2*)(P.ws + WS_CS);
    for (int e = gw * 64 + lane; e < M * 16; e += NGW * 64) { const int m = e >> 4, i = e & 15;
        const float inv_freq = powf(500000.0f, -(float)i / 16.0f); const float ang = (float)P.pos[m] * inv_freq;
        float sn, cs; sincosf(ang, &sn, &cs); CS[e] = (f32x2){cs, sn}; }
}

__device__ __forceinline__ void p3_row(const Ptrs& P, int m, int lane) {
    const h16* OA = (const h16*)(P.ws + WS_OA) + (size_t)m * 1024;
    const h16* OB[3] = {(const h16*)(P.ws + WS_OB0) + (size_t)m * 1024, (const h16*)(P.ws + WS_OB1) + (size_t)m * 1024, (const h16*)(P.ws + WS_OB2) + (size_t)m * 1024};
    const float* LSE = (const float*)(P.ws + WS_LSE);
    h16* MIX = (h16*)(P.ws + WS_MIX) + (size_t)m * DM; unsigned char* MIX8 = P.ws + WS_MIX + (size_t)m * DM; (void)MIX; (void)MIX8;
    {   float v[2][8]; float s = 0.f;
#pragma unroll
        for (int j = 0; j < 2; ++j) { const h16x8 a = *(const h16x8*)(OA + (lane + 64 * j) * 8);
#pragma unroll
            for (int e = 0; e < 8; ++e) { v[j][e] = (float)a[e]; s += v[j][e] * v[j][e]; } }
        const float rstd = 1.0f / sqrtf(wave_sum(s) * (1.0f / 1024.0f) + RMS_EPS);
#pragma unroll
        for (int j = 0; j < 2; ++j) { const int c = (lane + 64 * j) * 8; const f32x4 g0 = *(const f32x4*)(P.g_moba + c), g1 = *(const f32x4*)(P.g_moba + c + 4);
#if F8ATT
            u32x2 o; o.x = pk4f8(v[j][0] * rstd * g0.x, v[j][1] * rstd * g0.y, v[j][2] * rstd * g0.z, v[j][3] * rstd * g0.w);
            o.y = pk4f8(v[j][4] * rstd * g1.x, v[j][5] * rstd * g1.y, v[j][6] * rstd * g1.z, v[j][7] * rstd * g1.w);
            *(u32x2*)(MIX8 + c) = o; } }
#else
            u32x4 o; o.x = pk2h(v[j][0] * rstd * g0.x, v[j][1] * rstd * g0.y); o.y = pk2h(v[j][2] * rstd * g0.z, v[j][3] * rstd * g0.w);
            o.z = pk2h(v[j][4] * rstd * g1.x, v[j][5] * rstd * g1.y); o.w = pk2h(v[j][6] * rstd * g1.z, v[j][7] * rstd * g1.w);
            *(u32x4*)(MIX + c) = o; } }
#endif
    {   float v[2][8]; float s = 0.f;
#pragma unroll
        for (int j = 0; j < 2; ++j) { const int hh = (lane >> 4) + 4 * j;
            const float l0 = LSE[((size_t)0 * M + m) * 8 + hh], l1 = LSE[((size_t)1 * M + m) * 8 + hh], l2 = LSE[((size_t)2 * M + m) * 8 + hh];
            const float mx = fmaxf(l0, fmaxf(l1, l2)); const float e0 = __expf(l0 - mx), e1 = __expf(l1 - mx), e2 = __expf(l2 - mx); const float inv = 1.0f / (e0 + e1 + e2);
            const float w0 = e0 * inv, w1 = e1 * inv, w2 = e2 * inv;
            const h16x8 a0 = *(const h16x8*)(OB[0] + (lane + 64 * j) * 8), a1 = *(const h16x8*)(OB[1] + (lane + 64 * j) * 8), a2 = *(const h16x8*)(OB[2] + (lane + 64 * j) * 8);
#pragma unroll
            for (int e = 0; e < 8; ++e) { v[j][e] = w0 * (float)a0[e] + w1 * (float)a1[e] + w2 * (float)a2[e]; s += v[j][e] * v[j][e]; } }
        const float rstd = 1.0f / sqrtf(wave_sum(s) * (1.0f / 1024.0f) + RMS_EPS);
#pragma unroll
        for (int j = 0; j < 2; ++j) { const int c = (lane + 64 * j) * 8; const f32x4 g0 = *(const f32x4*)(P.g_dil + c), g1 = *(const f32x4*)(P.g_dil + c + 4);
#if F8ATT
            u32x2 o; o.x = pk4f8(v[j][0] * rstd * g0.x, v[j][1] * rstd * g0.y, v[j][2] * rstd * g0.z, v[j][3] * rstd * g0.w);
            o.y = pk4f8(v[j][4] * rstd * g1.x, v[j][5] * rstd * g1.y, v[j][6] * rstd * g1.z, v[j][7] * rstd * g1.w);
            *(u32x2*)(MIX8 + 1024 + c) = o; } }
#else
            u32x4 o; o.x = pk2h(v[j][0] * rstd * g0.x, v[j][1] * rstd * g0.y); o.y = pk2h(v[j][2] * rstd * g0.z, v[j][3] * rstd * g0.w);
            o.z = pk2h(v[j][4] * rstd * g1.x, v[j][5] * rstd * g1.y); o.w = pk2h(v[j][6] * rstd * g1.z, v[j][7] * rstd * g1.w);
            *(u32x4*)(MIX + 1024 + c) = o; } }
#endif
}
template <bool NEXT>
__device__ __forceinline__ void resid_row(const float* base, const h16* y, const float* ss, const float* gpost, const float* gnext, float* out, h16* xn2, int lane) {
    const float part = (lane < 32) ? ss[lane] : 0.f;
    const float rstd_y = 1.0f / sqrtf(wave_sum(part) * (1.0f / DM) + RMS_EPS);
    f32x4 v[4][2]; float s = 0.f;
#pragma unroll
    for (int j = 0; j < 4; ++j) { const int c = (lane + 64 * j) * 8; const h16x8 yy = *(const h16x8*)(y + c);
#pragma unroll
        for (int q = 0; q < 2; ++q) { const f32x4 b = *(const f32x4*)(base + c + 4 * q), g = *(const f32x4*)(gpost + c + 4 * q);
            f32x4 o; o.x = b.x + (float)yy[4 * q + 0] * rstd_y * g.x; o.y = b.y + (float)yy[4 * q + 1] * rstd_y * g.y; o.z = b.z + (float)yy[4 * q + 2] * rstd_y * g.z; o.w = b.w + (float)yy[4 * q + 3] * rstd_y * g.w;
            v[j][q] = o; s += (o.x * o.x + o.y * o.y) + (o.z * o.z + o.w * o.w); *(f32x4*)(out + c + 4 * q) = o; } }
    if (NEXT) { const float rstd = 1.0f / sqrtf(wave_sum(s) * (1.0f / DM) + RMS_EPS);
#pragma unroll
        for (int j = 0; j < 4; ++j) { const int c = (lane + 64 * j) * 8; const f32x4 g0 = *(const f32x4*)(gnext + c), g1 = *(const f32x4*)(gnext + c + 4);
#if F8FFN
            u32x2 o; o.x = pk4f8(v[j][0].x * rstd * g0.x, v[j][0].y * rstd * g0.y, v[j][0].z * rstd * g0.z, v[j][0].w * rstd * g0.w);
            o.y = pk4f8(v[j][1].x * rstd * g1.x, v[j][1].y * rstd * g1.y, v[j][1].z * rstd * g1.z, v[j][1].w * rstd * g1.w);
            *(u32x2*)((unsigned char*)xn2 + c) = o; } }
#else
            u32x4 o; o.x = pk2h(v[j][0].x * rstd * g0.x, v[j][0].y * rstd * g0.y); o.y = pk2h(v[j][0].z * rstd * g0.z, v[j][0].w * rstd * g0.w);
            o.z = pk2h(v[j][1].x * rstd * g1.x, v[j][1].y * rstd * g1.y); o.w = pk2h(v[j][1].z * rstd * g1.z, v[j][1].w * rstd * g1.w);
            *(u32x4*)(xn2 + c) = o; } }
#endif
}

__global__ __launch_bounds__(256) void k_p0(Ptrs P) {
    __shared__ float scr_all[4 * 64 * 33];
    const int lane = threadIdx.x & 63, wave = threadIdx.x >> 6;
    p0_prologue(P, (LAS float*)scr_all + wave * 64 * 33, blockIdx.x * 4 + wave, gridDim.x * 4, lane);
}
__global__ __launch_bounds__(512) void k_p3(Ptrs P) {
    const int lane = threadIdx.x & 63, gw = blockIdx.x * 8 + (threadIdx.x >> 6), NGW = gridDim.x * 8;
    for (int m = gw; m < M; m += NGW) p3_row(P, m, lane);
}
__global__ __launch_bounds__(512) void k_p4b(Ptrs P) {
    const int lane = threadIdx.x & 63, gw = blockIdx.x * 8 + (threadIdx.x >> 6), NGW = gridDim.x * 8;
    for (int m = gw; m < M; m += NGW)
        resid_row<true>(P.x + (size_t)m * DM, (const h16*)(P.ws + WS_Y) + (size_t)m * DM, (const float*)(P.ws + WS_SS) + (size_t)m * 32, P.g_attn_post, P.g_ffn_pre,
                        P.out + (size_t)m * DM, (h16*)(P.ws + WS_XN2) + (size_t)m * DM, lane);
}
__global__ __launch_bounds__(512) void k_p6b(Ptrs P) {
    const int lane = threadIdx.x & 63, gw = blockIdx.x * 8 + (threadIdx.x >> 6), NGW = gridDim.x * 8;
    for (int m = gw; m < M; m += NGW)
        resid_row<false>(P.out + (size_t)m * DM, (const h16*)(P.ws + WS_Y2) + (size_t)m * DM, (const float*)(P.ws + WS_SS) + (size_t)m * 32, P.g_ffn_post, nullptr,
                         P.out + (size_t)m * DM, nullptr, lane);
}

__global__ __launch_bounds__(256) void nv_gemm(const h16* A, int lda, const h16* Bt, int ldb, float* C, int ldc, int K) {
    __shared__ float As[32][65]; __shared__ float Bs[32][65];
    const int t = threadIdx.x, m0 = blockIdx.y * 64, n0 = blockIdx.x * 64, lr = t >> 2, lk = (t & 3) * 8, ty = t >> 4, tx = t & 15;
    float acc[4][4];
#pragma unroll
    for (int i = 0; i < 4; ++i)
#pragma unroll
        for (int j = 0; j < 4; ++j) acc[i][j] = 0.f;
    for (int k0 = 0; k0 < K; k0 += 32) {
        const h16x8 a = *(const h16x8*)(A + (size_t)(m0 + lr) * lda + k0 + lk);
        const h16x8 b = *(const h16x8*)(Bt + (size_t)(n0 + lr) * ldb + k0 + lk);
#pragma unroll
        for (int e = 0; e < 8; ++e) { As[lk + e][lr] = (float)a[e]; Bs[lk + e][lr] = (float)b[e]; }
        __syncthreads();
#pragma unroll 8
        for (int kk = 0; kk < 32; ++kk) {
            float av[4], bv[4];
#pragma unroll
            for (int i = 0; i < 4; ++i) { av[i] = As[kk][ty * 4 + i]; bv[i] = Bs[kk][tx * 4 + i]; }
#pragma unroll
            for (int i = 0; i < 4; ++i)
#pragma unroll
                for (int j = 0; j < 4; ++j) acc[i][j] = fmaf(av[i], bv[j], acc[i][j]);
        }
        __syncthreads();
    }
#pragma unroll
    for (int i = 0; i < 4; ++i) { f32x4 o = {acc[i][0], acc[i][1], acc[i][2], acc[i][3]}; *(f32x4*)(C + (size_t)(m0 + ty * 4 + i) * ldc + n0 + tx * 4) = o; }
}
__global__ __launch_bounds__(256) void nv_rope(const float* C, h16* QKV, const f32x2* CS, int chunk) {
    const size_t e = (size_t)blockIdx.x * 256 + threadIdx.x; const int m = (int)(e >> 10), j = (int)(e & 1023), d = j & 127;
    float v = C[e];
    if ((chunk % 3) != 2 && d < 32) {
        const int i = d & 15; const f32x2 cs = CS[(size_t)m * 16 + i];
        if (d < 16) v = v * cs.x - C[e + 16] * cs.y; else v = v * cs.x + C[e - 16] * cs.y;
    }
    QKV[(size_t)m * NQKV + chunk * 1024 + j] = (h16)v;
}
__global__ __launch_bounds__(256) void nv_ksum(const h16* QKV, float* KSUM) {
    const int e = blockIdx.x * 256 + threadIdx.x; const int pm = e >> 10, c = e & 1023;
    float s = 0.f;
    for (int r = 0; r < 256; ++r) s += (float)QKV[(size_t)(pm * 256 + r) * NQKV + 1024 + c];
    KSUM[(size_t)(pm * 2 + 0) * 1024 + c] = s; KSUM[(size_t)(pm * 2 + 1) * 1024 + c] = 0.f;
}
__global__ __launch_bounds__(256) void nv_cvt_ss(const float* C, int ncols, h16* Y, int col0, float* SS) {
    const int lane = threadIdx.x & 63; const size_t w = (size_t)blockIdx.x * 4 + (threadIdx.x >> 6); const int nslot = ncols / 64; const int m = (int)(w / nslot), s = (int)(w % nslot);
    const float v = C[(size_t)m * ncols + s * 64 + lane];
    Y[(size_t)m * DM + col0 + s * 64 + lane] = (h16)v;
    const float q = wave_sum(v * v);
    if (lane == 0) SS[(size_t)m * 32 + col0 / 64 + s] = q;
}
__global__ __launch_bounds__(256) void nv_conv(const float* C, h16* ACT, const float* conv_w, const float* conv_b, int g0) {
    const size_t e = (size_t)blockIdx.x * 256 + threadIdx.x; const int m = (int)(e >> 8), jj = (int)(e & 255), gi = jj >> 7, j = jj & 127;
    const int c = 128 * (g0 + gi) + j; const int s = m & (SEQ - 1);
    const float* Cg = C + (size_t)m * 512 + gi * 256 + j;
    const float g_0 = Cg[0], g_1 = (s >= 1) ? Cg[-512] : 0.f, g_2 = (s >= 2) ? Cg[-1024] : 0.f, u = Cg[128];
    const float pre = conv_b[c] + conv_w[c] * g_2 + conv_w[FF + c] * g_1 + conv_w[2 * FF + c] * g_0;
    ACT[(size_t)m * FF + c] = (h16)(gelu_tanh(pre) * u);
}
__global__ __launch_bounds__(256) void nv_attn(const h16* QKV, const float* KSUM, h16* OA, h16* OB0, h16* OB1, h16* OB2, float* LSE, int mode) {
    __shared__ float Qs[32][129]; __shared__ float Ks[32][129]; __shared__ float Vs[32][128]; __shared__ float Ps[32][33]; __shared__ float Gs[32][16]; __shared__ unsigned Sel[32];
    const int t = threadIdx.x, u = blockIdx.x, b = u >> 10, h = (u >> 7) & 7, rem = u & 127;
    int d = 1, r = 0, i0, W; const h16 *Qp, *Kp, *Vp; h16* Op; size_t pitch, opitch;
    if (mode == 0) { i0 = rem * 32; W = 1 << 30; pitch = NQKV; opitch = 1024;
        Qp = QKV + (size_t)(b * SEQ) * NQKV + 0 + h * HD; Kp = Qp + 1024; Vp = Qp + 2048; Op = OA + (size_t)(b * SEQ) * 1024 + h * HD; }
    else { d = (mode == 1) ? 1 : (mode == 2) ? 4 : 16; const int nq = (SEQ / d) / 32; r = rem / nq; i0 = (rem % nq) * 32; W = 129; pitch = (size_t)NQKV * d; opitch = (size_t)1024 * d;
        Qp = QKV + (size_t)(b * SEQ + r) * NQKV + 3072 + h * HD; Kp = Qp + 1024; Vp = Qp + 2048;
        h16* OBm = (mode == 1) ? OB0 : (mode == 2) ? OB1 : OB2; Op = OBm + (size_t)(b * SEQ + r) * 1024 + h * HD; }
    for (int e = t; e < 32 * 128; e += 256) { const int qi = e >> 7, c = e & 127; Qs[qi][c] = (float)Qp[(size_t)(i0 + qi) * pitch + c]; }
    __syncthreads();
    const int qi = t >> 3, sub = t & 7;
    if (mode == 0) {
        const int qblk = i0 >> 8;
        for (int jj = 0; jj < 2; ++jj) { const int j = sub + 8 * jj; float g = 0.f;
            if (j < qblk) { const float* k0 = KSUM + (size_t)((b * 16 + j) * 2) * 1024 + h * HD; for (int c = 0; c < 128; ++c) g += Qs[qi][c] * (k0[c] + k0[1024 + c]) * (1.0f / 256.0f); }
            Gs[qi][j] = g; }
        __syncthreads();
        if (sub == 0) { unsigned sel = 0;
            for (int rnd = 0; rnd < 3; ++rnd) { float best = -3.0e38f; int bi = -1;
                for (int j = 0; j < 16; ++j) if (j < qblk && !((sel >> j) & 1u) && Gs[qi][j] > best) { best = Gs[qi][j]; bi = j; }
                if (bi >= 0) sel |= 1u << bi; }
            sel |= 1u << qblk; Sel[qi] = sel; }
        __syncthreads();
    }
    const unsigned selmask = (mode == 0) ? Sel[qi] : 0xffffffffu;
    float o[16];
#pragma unroll
    for (int c = 0; c < 16; ++c) o[c] = 0.f;
    float mrun = -1e30f, lrun = 0.f;
    int klo = (mode == 0) ? 0 : (i0 - 128 > 0 ? i0 - 128 : 0); klo &= ~31;
    const int khi = i0 + 32;
    const int iq = i0 + qi;
    for (int k0 = klo; k0 < khi; k0 += 32) {
        __syncthreads();
        for (int e = t; e < 32 * 128; e += 256) { const int kk = e >> 7, c = e & 127; Ks[kk][c] = (float)Kp[(size_t)(k0 + kk) * pitch + c]; Vs[kk][c] = (float)Vp[(size_t)(k0 + kk) * pitch + c]; }
        __syncthreads();
        float sc[4]; float tmax = -1e30f;
#pragma unroll
        for (int j = 0; j < 4; ++j) { const int kk = sub * 4 + j, kidx = k0 + kk; float a = 0.f;
            for (int c = 0; c < 128; ++c) a += Qs[qi][c] * Ks[kk][c];
            a *= SCALE;
            bool ok = (kidx <= iq) && (iq - kidx < W);
            if (mode == 0) ok = ok && ((selmask >> (kidx >> 8)) & 1u);
            sc[j] = ok ? a : -INFINITY; tmax = fmaxf(tmax, sc[j]); }
        tmax = fmaxf(tmax, __shfl_xor(tmax, 1)); tmax = fmaxf(tmax, __shfl_xor(tmax, 2)); tmax = fmaxf(tmax, __shfl_xor(tmax, 4));
        const float mnew = fmaxf(mrun, tmax); const float alpha = __expf(mrun - mnew);
        float ps = 0.f;
#pragma unroll
        for (int j = 0; j < 4; ++j) { const float p = __expf(sc[j] - mnew); Ps[qi][sub * 4 + j] = p; ps += p; }
        ps += __shfl_xor(ps, 1); ps += __shfl_xor(ps, 2); ps += __shfl_xor(ps, 4);
        lrun = lrun * alpha + ps; mrun = mnew;
        __syncthreads();
#pragma unroll
        for (int c = 0; c < 16; ++c) o[c] *= alpha;
        for (int kk = 0; kk < 32; ++kk) { const float p = Ps[qi][kk];
#pragma unroll
            for (int c = 0; c < 16; ++c) o[c] = fmaf(p, Vs[kk][sub * 16 + c], o[c]); }
    }
    const float inv = 1.0f / lrun;
#pragma unroll
    for (int c = 0; c < 16; ++c) Op[(size_t)(i0 + qi) * opitch + sub * 16 + c] = (h16)(o[c] * inv);
    if (mode != 0 && sub == 0) LSE[((size_t)(mode - 1) * M + (size_t)(b * SEQ + r + d * (i0 + qi))) * 8 + h] = mrun + __logf(lrun);
}

namespace pg8 {
#define PG8_LAS __attribute__((address_space(3)))
constexpr int BM = 256, BK = 64, HALF = 128, HTB = HALF * BK * 2, STAGE_BYTES = 8 * HTB, NXCD = 8, WGM = 8;
__host__ __device__ __forceinline__ int lds_byte(int r, int c) { const int st = (r >> 4) * 2 + (c >> 5), rr = r & 15, cc = c & 31, ob = rr * 64 + cc * 2; return st * 1024 + (ob ^ (((ob >> 9) & 1) << 5)); }
__host__ __device__ __forceinline__ void stage_rc(int b, int& R, int& C) { const int st = b / 1024, sb = b % 1024, swz = sb ^ (((sb >> 9) & 1) << 5); R = (st >> 1) * 16 + swz / 64; C = (st & 1) * 32 + (swz % 64) / 2; }
__host__ __device__ __forceinline__ int perm32(int rho) { const int n = rho >> 4, i = rho & 15; return 8 * (i >> 2) + 4 * n + (i & 3); }
struct Unit { int pm, pn; };
struct Gemm { const void* A; const void* Bt; int M, N, K; int scale_w, scale_x; };
typedef int i32x8 __attribute__((ext_vector_type(8)));
typedef int i32x4 __attribute__((ext_vector_type(4)));
struct StaticOrder {
    int nM, nN, nwg, G, c;
    __host__ __device__ void init(int M_, int N_, int G_, int c_) { nM = M_ / BM; nN = N_ / BM; nwg = nM * nN; G = G_; c = c_; }
    __host__ __device__ bool next(int i, Unit& u) const {
        const long L = (long)i * G + c; if (L >= nwg) return false;
        int wgid = (int)L; { const int q = nwg / NXCD, r = nwg % NXCD, xcd = wgid % NXCD, off = wgid / NXCD; wgid = (xcd < r ? xcd * (q + 1) : r * (q + 1) + (xcd - r) * q) + off; }
        const int nig = WGM * nN, gid = wgid / nig, fm = gid * WGM, gsz = (nM - fm) < WGM ? (nM - fm) : WGM;
        u.pm = fm + ((wgid % nig) % gsz); u.pn = (wgid % nig) / gsz; return true;
    }
};
typedef f32x4 Acc[2][2][4][2];

__device__ __forceinline__ u32x4 pack8h(f32x4 v0, f32x4 v1) { u32x4 w; w.x = pk2h(v0[0], v0[1]); w.y = pk2h(v0[2], v0[3]); w.z = pk2h(v1[0], v1[1]); w.w = pk2h(v1[2], v1[3]); return w; }

struct EpiQKV {
    h16* O; const f32x2* CS; float* KSUM; int pn_off;
    __device__ __forceinline__ void operator()(Acc& acc, const Unit& u0, int wr, int wc, int fr, int fq, PG8_LAS unsigned char* xlds) const {
        Unit u = u0; u.pn += pn_off;
        const int grp6 = u.pn >> 2, kind = grp6 % 3;
        const int row0 = u.pm * BM + wr * 64 + fr;
        if (kind != 2 && wc == 0) {
            const float sgn = (fq < 2) ? -1.f : 1.f;
#pragma unroll
            for (int ai = 0; ai < 2; ++ai)
#pragma unroll
                for (int m = 0; m < 4; ++m) {
                    const f32x4* cp = (const f32x4*)(CS + (size_t)(row0 + ai * HALF + m * 16) * 16 + 8 * (fq & 1));
                    const f32x4 c0 = cp[0], c1 = cp[1], c2 = cp[2], c3 = cp[3];
                    const float cs[8] = {c0[0], c0[2], c1[0], c1[2], c2[0], c2[2], c3[0], c3[2]}, sn[8] = {c0[1], c0[3], c1[1], c1[3], c2[1], c2[3], c3[1], c3[3]};
#pragma unroll
                    for (int bj = 0; bj < 2; ++bj)
#pragma unroll
                        for (int n = 0; n < 2; ++n)
#pragma unroll
                            for (int e = 0; e < 4; ++e) { const float v = acc[ai][bj][m][n][e]; const float o = __shfl_xor(v, 32);
                                acc[ai][bj][m][n][e] = v * cs[4 * n + e] + sgn * o * sn[4 * n + e]; }
                }
        }
        if (grp6 == 1) {
#pragma unroll
            for (int bj = 0; bj < 2; ++bj)
#pragma unroll
                for (int n = 0; n < 2; ++n) { f32x4 s = {0.f, 0.f, 0.f, 0.f};
#pragma unroll
                    for (int ai = 0; ai < 2; ++ai)
#pragma unroll
                        for (int m = 0; m < 4; ++m) s += acc[ai][bj][m][n];
#pragma unroll
                    for (int e = 0; e < 4; ++e) { float t = s[e]; t += __shfl_xor(t, 1); t += __shfl_xor(t, 2); t += __shfl_xor(t, 4); t += __shfl_xor(t, 8); s[e] = t; }
                    if (fr == 0) *(f32x4*)(KSUM + (size_t)(u.pm * 2 + wr) * 1024 + (u.pn - 4) * 256 + bj * HALF + wc * 32 + 8 * fq + 4 * n) = s; }
        }
        const int col0 = u.pn * BM + wc * 32 + 8 * fq;
#pragma unroll
        for (int ai = 0; ai < 2; ++ai)
#pragma unroll
            for (int m = 0; m < 4; ++m) { h16* rowp = O + (size_t)(row0 + ai * HALF + m * 16) * NQKV + col0;
#pragma unroll
                for (int bj = 0; bj < 2; ++bj) *(u32x4*)(rowp + bj * HALF) = pack8h(acc[ai][bj][m][0], acc[ai][bj][m][1]); }
    }
};
struct EpiY {
    h16* O; float* SS;
    __device__ __forceinline__ void operator()(Acc& acc, const Unit& u, int wr, int wc, int fr, int fq, PG8_LAS unsigned char* xlds) const {
        const int row0 = u.pm * BM + wr * 64 + fr, col0 = u.pn * BM + wc * 32 + 8 * fq;
#pragma unroll
        for (int ai = 0; ai < 2; ++ai)
#pragma unroll
            for (int m = 0; m < 4; ++m) { const int row = row0 + ai * HALF + m * 16; h16* rowp = O + (size_t)row * DM + col0; float q = 0.f;
#pragma unroll
                for (int bj = 0; bj < 2; ++bj) { const f32x4 v0 = acc[ai][bj][m][0], v1 = acc[ai][bj][m][1];
                    q += (v0[0] * v0[0] + v0[1] * v0[1]) + (v0[2] * v0[2] + v0[3] * v0[3]) + (v1[0] * v1[0] + v1[1] * v1[1]) + (v1[2] * v1[2] + v1[3] * v1[3]);
                    *(u32x4*)(rowp + bj * HALF) = pack8h(v0, v1); }
                q += __shfl_xor(q, 16); q += __shfl_xor(q, 32);
                if (fq == 0) SS[(size_t)row * 32 + u.pn * 4 + wc] = q; }
    }
};
template <int CTRL> __device__ __forceinline__ float dpp_mov(float old, float src) {
    return __builtin_bit_cast(float, __builtin_amdgcn_update_dpp(__builtin_bit_cast(int, old), __builtin_bit_cast(int, src), CTRL, 0xF, 0xF, false)); }
struct EpiGU {
    h16* ACT; const float* conv_w; const float* conv_b; float* HALO; float* FIXP; float* FIXU;
    __device__ __forceinline__ void operator()(Acc& acc, const Unit& u, int wr, int wc, int fr, int fq, PG8_LAS unsigned char* xlds) const {
        PG8_LAS float* xb = (PG8_LAS float*)xlds;
        const int c0 = u.pn * HALF + wc * 32 + 8 * fq;
        if (fr >= 14) {
#pragma unroll
            for (int ai = 0; ai < 2; ++ai) { PG8_LAS float* d = xb + ((((ai * 2 + wr) * 4 + wc) * 4 + fq) * 2 + (fr - 14)) * 8;
                *(PG8_LAS f32x4*)d = acc[ai][0][3][0]; *(PG8_LAS f32x4*)(d + 4) = acc[ai][0][3][1]; }
            if (wr == 1) { float* hp = HALO + ((size_t)(u.pm * 2 + (fr - 14))) * FF + c0;
                *(f32x4*)hp = acc[1][0][3][0]; *(f32x4*)(hp + 4) = acc[1][0][3][1]; }
        }
        asm volatile("s_waitcnt lgkmcnt(0)" ::: "memory"); __builtin_amdgcn_s_barrier(); asm volatile("" ::: "memory");
        f32x4 w0[2], w1[2], w2[2], bb[2];
#pragma unroll
        for (int n = 0; n < 2; ++n) { w0[n] = *(const f32x4*)(conv_w + c0 + 4 * n); w1[n] = *(const f32x4*)(conv_w + FF + c0 + 4 * n); w2[n] = *(const f32x4*)(conv_w + 2 * FF + c0 + 4 * n); bb[n] = *(const f32x4*)(conv_b + c0 + 4 * n); }
#pragma unroll
        for (int ai = 0; ai < 2; ++ai) {
            f32x4 pv[2];
            if (ai == 0 && wr == 0) { pv[0] = (f32x4){0.f, 0.f, 0.f, 0.f}; pv[1] = pv[0]; }
            else { const int sg = (wr == 1) ? (ai * 2 + 0) : (0 * 2 + 1);
                const PG8_LAS float* s = xb + (((sg * 4 + wc) * 4 + fq) * 2 + (fr & 1)) * 8;
                pv[0] = *(const PG8_LAS f32x4*)s; pv[1] = *(const PG8_LAS f32x4*)(s + 4); }
#pragma unroll
            for (int m = 0; m < 4; ++m) {
                const int row = u.pm * BM + ai * HALF + wr * 64 + m * 16 + fr;
                f32x4 o[2];
#pragma unroll
                for (int n = 0; n < 2; ++n)
#pragma unroll
                    for (int e = 0; e < 4; ++e) { const float g = acc[ai][0][m][n][e], pg = pv[n][e];
                        const float p1 = dpp_mov<0x111>(dpp_mov<0x121>(0.f, pg), g);
                        const float p2 = dpp_mov<0x112>(dpp_mov<0x122>(0.f, pg), g);
                        const float pre = bb[n][e] + w0[n][e] * p2 + w1[n][e] * p1 + w2[n][e] * g;
                        o[n][e] = pre; }
                if (ai == 0 && wr == 0 && m == 0 && fr < 2) { float* fp = FIXP + ((size_t)(u.pm * 2 + fr)) * FF + c0; float* fu = FIXU + ((size_t)(u.pm * 2 + fr)) * FF + c0;
                    *(f32x4*)fp = o[0]; *(f32x4*)(fp + 4) = o[1]; *(f32x4*)fu = acc[0][1][0][0]; *(f32x4*)(fu + 4) = acc[0][1][0][1]; }
#pragma unroll
                for (int n = 0; n < 2; ++n)
#pragma unroll
                    for (int e = 0; e < 4; ++e) o[n][e] = gelu_tanh(o[n][e]) * acc[ai][1][m][n][e];
#if F8FFN
                { u32x2 w8; w8.x = pk4f8(o[0][0] * F8_ACT_SCALE, o[0][1] * F8_ACT_SCALE, o[0][2] * F8_ACT_SCALE, o[0][3] * F8_ACT_SCALE);
                  w8.y = pk4f8(o[1][0] * F8_ACT_SCALE, o[1][1] * F8_ACT_SCALE, o[1][2] * F8_ACT_SCALE, o[1][3] * F8_ACT_SCALE);
                  *(u32x2*)((unsigned char*)ACT + (size_t)row * FF + c0) = w8; }
#else
                *(u32x4*)(ACT + (size_t)row * FF + c0) = pack8h(o[0], o[1]);
#endif
                pv[0] = acc[ai][0][m][0]; pv[1] = acc[ai][0][m][1];
            }
        }
    }
};

template <class Epi, class Sched, bool F8 = false>
__device__ __forceinline__ void gemm_phase(PG8_LAS unsigned char* lds, PG8_LAS unsigned char* xlds, const Gemm g, const Sched& S, const Epi& E) {
    const int tid = threadIdx.x, wid = __builtin_amdgcn_readfirstlane(tid >> 6), lane = tid & 63, wr = wid >> 2, wc = wid & 3, fr = lane & 15, fq = lane >> 4;
    const int RB = F8 ? g.K : g.K * 2, nt = RB / 128;
    unsigned voffA[2], voffB[2];
#pragma unroll
    for (int i = 0; i < 2; ++i) { int R, C; stage_rc(tid * 16 + i * 8192, R, C); const int Rb = (R & ~31) + perm32(R & 31);
        voffA[i] = (unsigned)(R * RB + C * 2); voffB[i] = (unsigned)(Rb * RB + C * 2); }
    const size_t kstep = (size_t)128;
    const size_t hstep = (size_t)HALF * RB;
    const size_t tstep = 2 * hstep;
    const unsigned ldsw = (unsigned)wid * 1024u;
    const int aoff = lds_byte(wr * 64 + fr, fq * 8), boff = lds_byte(wc * 32 + fr, fq * 8);
#define PG8_SA(b, h) (((b) * 2 + (h)) * HTB)
#define PG8_SB(b, h) ((4 + (b) * 2 + (h)) * HTB)
#define PG8_STAGE(bufoff, gbase, voff) do { _Pragma("unroll") for (int _i = 0; _i < 2; ++_i) \
        __builtin_amdgcn_global_load_lds((const unsigned*)((const char*)(gbase) + (voff)[_i]), (PG8_LAS unsigned*)(lds + (bufoff) + ldsw + _i * 8192), 16, 0, 0); } while (0)
#define PG8_LDA(dst, b, h) do { _Pragma("unroll") for (int m = 0; m < 4; ++m) _Pragma("unroll") for (int k = 0; k < 2; ++k) dst[m][k] = *(const PG8_LAS h16x8*)(lds + PG8_SA(b, h) + aoff + m * 2048 + k * 1024); } while (0)
#define PG8_LDB(dst, b, h) do { _Pragma("unroll") for (int n = 0; n < 2; ++n) _Pragma("unroll") for (int k = 0; k < 2; ++k) dst[n][k] = *(const PG8_LAS h16x8*)(lds + PG8_SB(b, h) + boff + n * 2048 + k * 1024); } while (0)
#define PG8_CAT(v) __builtin_shufflevector(__builtin_bit_cast(i32x4, v[0]), __builtin_bit_cast(i32x4, v[1]), 0, 1, 2, 3, 4, 5, 6, 7)
#define PG8_MMA(ai, bj, At, Bt) do { __builtin_amdgcn_s_setprio(1); \
        if constexpr (F8) { _Pragma("unroll") for (int m = 0; m < 4; ++m) _Pragma("unroll") for (int n = 0; n < 2; ++n) \
            asm volatile("v_mfma_scale_f32_16x16x128_f8f6f4 %0, %1, %2, %0, %3, %4 op_sel_hi:[0,0,0]" : "+v"(acc[ai][bj][m][n]) : "v"(PG8_CAT(Bt[n])), "v"(PG8_CAT(At[m])), "v"(sc_w), "v"(sc_x)); } \
        else { _Pragma("unroll") for (int m = 0; m < 4; ++m) _Pragma("unroll") for (int n = 0; n < 2; ++n) _Pragma("unroll") for (int k = 0; k < 2; ++k) \
            acc[ai][bj][m][n] = __builtin_amdgcn_mfma_f32_16x16x32_f16(Bt[n][k], At[m][k], acc[ai][bj][m][n], 0, 0, 0); } \
        __builtin_amdgcn_s_setprio(0); } while (0)
#define PG8_WAIT_V(n) asm volatile("s_waitcnt vmcnt(" #n ")" ::: "memory")
#define PG8_WAIT_L(n) asm volatile("s_waitcnt lgkmcnt(" #n ")" ::: "memory")
#define PG8_BAR __builtin_amdgcn_s_barrier()
#define PG8_SCHED __builtin_amdgcn_sched_barrier(0)
    Unit cur, nxt; int ui = 0;
    if (!S.next(0, cur)) return;
    const int sc_w = g.scale_w, sc_x = g.scale_x;
    Acc acc;
#pragma unroll
    for (int a = 0; a < 2; ++a)
#pragma unroll
        for (int b = 0; b < 2; ++b)
#pragma unroll
            for (int m = 0; m < 4; ++m)
#pragma unroll
                for (int n = 0; n < 2; ++n) acc[a][b][m][n] = (f32x4){0.f, 0.f, 0.f, 0.f};
    h16x8 At[4][2], B0[2][2], B1[2][2];
    const char* cA = (const char*)g.A + (size_t)cur.pm * tstep; const char* cB = (const char*)g.Bt + (size_t)cur.pn * tstep;
    PG8_STAGE(PG8_SB(0, 0), cB, voffB); PG8_STAGE(PG8_SB(0, 1), cB + hstep, voffB); PG8_STAGE(PG8_SA(0, 0), cA, voffA); PG8_STAGE(PG8_SA(0, 1), cA + hstep, voffA);
    if (wr == 1) PG8_BAR;
    PG8_WAIT_V(2); PG8_BAR;
    PG8_STAGE(PG8_SB(1, 0), cB + kstep, voffB); PG8_STAGE(PG8_SA(1, 0), cA + kstep, voffA); PG8_STAGE(PG8_SB(1, 1), cB + hstep + kstep, voffB);
    PG8_WAIT_V(6); PG8_BAR;
    for (;;) {
        const bool has_next = S.next(ui + 1, nxt);
        const char* nA = has_next ? (const char*)g.A + (size_t)nxt.pm * tstep : cA; const char* nB = has_next ? (const char*)g.Bt + (size_t)nxt.pn * tstep : cB;
        for (int t = 0; t < nt; t += 2) {
            const bool last = (t == nt - 2);
            const char* a1 = cA + (size_t)(t + 1) * kstep;
            const char* a2 = last ? nA : cA + (size_t)(t + 2) * kstep; const char* b2 = last ? nB : cB + (size_t)(t + 2) * kstep;
            const char* a3 = a2 + kstep; const char* b3 = b2 + kstep;
            PG8_LDB(B0, 0, 0); PG8_LDB(B1, 0, 1); PG8_SCHED; PG8_LDA(At, 0, 0); PG8_STAGE(PG8_SA(1, 1), a1 + hstep, voffA);
            PG8_WAIT_V(8); PG8_WAIT_L(0); PG8_BAR; PG8_MMA(0, 0, At, B0); PG8_MMA(0, 1, At, B1); PG8_BAR; PG8_SCHED;
            PG8_LDA(At, 0, 1); PG8_STAGE(PG8_SB(0, 0), b2, voffB); PG8_STAGE(PG8_SB(0, 1), b2 + hstep, voffB); PG8_STAGE(PG8_SA(0, 0), a2, voffA);
            PG8_WAIT_V(8); PG8_WAIT_L(0); PG8_BAR; PG8_MMA(1, 0, At, B0); PG8_MMA(1, 1, At, B1); PG8_BAR; PG8_SCHED;
            PG8_LDB(B0, 1, 0); PG8_LDB(B1, 1, 1); PG8_SCHED; PG8_LDA(At, 1, 0); PG8_STAGE(PG8_SA(0, 1), a2 + hstep, voffA);
            PG8_WAIT_V(8); PG8_WAIT_L(0); PG8_BAR; PG8_MMA(0, 0, At, B0); PG8_MMA(0, 1, At, B1); PG8_BAR; PG8_SCHED;
            PG8_LDA(At, 1, 1); PG8_STAGE(PG8_SB(1, 0), b3, voffB); PG8_STAGE(PG8_SB(1, 1), b3 + hstep, voffB); PG8_STAGE(PG8_SA(1, 0), a3, voffA);
            PG8_WAIT_V(8); PG8_WAIT_L(0); PG8_BAR; PG8_MMA(1, 0, At, B0); PG8_MMA(1, 1, At, B1); PG8_BAR; PG8_SCHED;
        }
        if (wr == 0) PG8_BAR;
        if constexpr (F8) asm volatile("s_nop 15\n\ts_nop 15" ::: "memory");
        E(acc, cur, wr, wc, fr, fq, xlds);
        if (!has_next) break;
#pragma unroll
        for (int a = 0; a < 2; ++a)
#pragma unroll
            for (int b = 0; b < 2; ++b)
#pragma unroll
                for (int m = 0; m < 4; ++m)
#pragma unroll
                    for (int n = 0; n < 2; ++n) acc[a][b][m][n] = (f32x4){0.f, 0.f, 0.f, 0.f};
        cur = nxt; cA = nA; cB = nB; ++ui;
        if (wr == 1) PG8_BAR;
    }
    PG8_WAIT_V(0);
    PG8_BAR;
#undef PG8_SA
#undef PG8_SB
#undef PG8_STAGE
#undef PG8_LDA
#undef PG8_LDB
#undef PG8_MMA
#undef PG8_CAT
#undef PG8_WAIT_V
#undef PG8_WAIT_L
#undef PG8_BAR
#undef PG8_SCHED
}
}

__device__ __forceinline__ void p5b_fixup(const Ptrs& P, int gtid, int nthreads) {
    const float* HALO = (const float*)(P.ws + WS_HALO); const float* FIXP = (const float*)(P.ws + WS_FIXP); const float* FIXU = (const float*)(P.ws + WS_FIXU); h16* ACT = (h16*)(P.ws + WS_ACT);
    for (int e = gtid; e < 64 * 2 * (FF / 4); e += nthreads) {
        const int c = (e % (FF / 4)) * 4, i = (e / (FF / 4)) & 1, pm = e / (2 * (FF / 4));
        if ((pm & 15) == 0) continue;
        const f32x4 p = *(const f32x4*)(FIXP + (size_t)(pm * 2 + i) * FF + c), uu = *(const f32x4*)(FIXU + (size_t)(pm * 2 + i) * FF + c);
        const f32x4 h0 = *(const f32x4*)(HALO + (size_t)((pm - 1) * 2 + 0) * FF + c), h1 = *(const f32x4*)(HALO + (size_t)((pm - 1) * 2 + 1) * FF + c);
        const f32x4 w0 = *(const f32x4*)(P.conv_w + c), w1 = *(const f32x4*)(P.conv_w + FF + c);
        f32x4 pre;
        if (i == 0) pre = p + w0 * h0 + w1 * h1; else pre = p + w0 * h1;
#if F8FFN
        *(unsigned*)((unsigned char*)ACT + (size_t)(pm * 256 + i) * FF + c) = pk4f8(gelu_tanh(pre[0]) * uu[0] * F8_ACT_SCALE, gelu_tanh(pre[1]) * uu[1] * F8_ACT_SCALE, gelu_tanh(pre[2]) * uu[2] * F8_ACT_SCALE, gelu_tanh(pre[3]) * uu[3] * F8_ACT_SCALE);
#else
        const unsigned lo = pk2h(gelu_tanh(pre[0]) * uu[0], gelu_tanh(pre[1]) * uu[1]), hi = pk2h(gelu_tanh(pre[2]) * uu[2], gelu_tanh(pre[3]) * uu[3]);
        *(unsigned long long*)(ACT + (size_t)(pm * 256 + i) * FF + c) = (unsigned long long)lo | ((unsigned long long)hi << 32);
#endif
    }
}


#define XB_TMO      128
#define XB_XCNT(j)  (256  + 64 * (j))
#define XB_XSUB(j)  (1280 + 64 * (j))
#define XB_XGEN(j)  (2304 + 64 * (j))
#define XB_TOP      3328
#define XB_TOPGEN   3392
#define XCD_BAR_WORDS 3456
#define XB_SPIN_CAP (1u << 18)
__device__ __forceinline__ unsigned xb_ld(unsigned* p)              { return __hip_atomic_load(p, __ATOMIC_RELAXED, __HIP_MEMORY_SCOPE_AGENT); }
__device__ __forceinline__ unsigned xb_add(unsigned* p, unsigned v) { return __hip_atomic_fetch_add(p, v, __ATOMIC_RELAXED, __HIP_MEMORY_SCOPE_AGENT); }
__device__ __forceinline__ unsigned xb_xcc_id() { return (unsigned)__builtin_amdgcn_s_getreg((3 << 11) | 20) & 0xFu; }
#define XB_SPIN(cond, bar) do { unsigned _sp = 0; while (cond) { __builtin_amdgcn_s_sleep(1); \
    if ((++_sp & 255u) == 0u) { if (xb_ld(&(bar)[XB_TMO])) break; if (_sp > XB_SPIN_CAP) { atomicAdd(&(bar)[XB_TMO], 1u); break; } } } } while (0)
struct XcdBarrier { unsigned* bar; unsigned x; volatile LAS unsigned* st; };
__device__ __forceinline__ XcdBarrier xcd_barrier_post(unsigned* bar, volatile LAS unsigned* st) {
    XcdBarrier b; b.bar = bar; b.x = xb_xcc_id(); b.st = st;
    if (threadIdx.x == 0) (void)xb_add(&bar[XB_XCNT(b.x)], 1u);
    return b;
}
__device__ __forceinline__ void xcd_barrier_complete(unsigned* bar, unsigned x, unsigned& nloc, unsigned& nx) {
    const unsigned G = gridDim.x * gridDim.y * gridDim.z;
    unsigned sum, cnt, mine, sp = 0u;
    for (;;) {
        sum = 0u; cnt = 0u; mine = 0u;
#pragma unroll
        for (unsigned j = 0; j < 16; ++j) { const unsigned c = xb_ld(&bar[XB_XCNT(j)]); sum += c; cnt += (c > 0u) ? 1u : 0u; mine = (j == x) ? c : mine; }
        if (sum == G) break;
        __builtin_amdgcn_s_sleep(1);
        if ((++sp & 255u) == 0u) { if (xb_ld(&bar[XB_TMO])) break; if (sp > XB_SPIN_CAP) { atomicAdd(&bar[XB_TMO], 1u); break; } }
    }
    nloc = mine > 0u ? mine : 1u; nx = cnt > 0u ? cnt : 1u;
}
__device__ __forceinline__ void xcd_barrier(const XcdBarrier& b) {
    asm volatile("s_waitcnt vmcnt(0)" ::: "memory");
    __syncthreads();
    if (threadIdx.x == 0) {
        unsigned* bar = b.bar;
        __builtin_amdgcn_s_waitcnt(0);
        unsigned nloc = b.st[0], nx = b.st[1];
        if (nloc == 0u) { xcd_barrier_complete(bar, b.x, nloc, nx); b.st[0] = nloc; b.st[1] = nx; }
        const unsigned old = xb_add(&bar[XB_XSUB(b.x)], 1u);
        const unsigned gen = old / nloc;
        if (old + 1u == (gen + 1u) * nloc) {
            __builtin_amdgcn_fence(__ATOMIC_RELEASE, "agent");
            asm volatile("s_waitcnt vmcnt(0)" ::: "memory");
            const unsigned og = xb_add(&bar[XB_TOP], 1u);
            const unsigned tg = og / nx;
            if (og + 1u == (tg + 1u) * nx) xb_add(&bar[XB_TOPGEN], 1u);
            else XB_SPIN(xb_ld(&bar[XB_TOPGEN]) == tg, bar);
            __builtin_amdgcn_fence(__ATOMIC_ACQUIRE, "agent");
            xb_add(&bar[XB_XGEN(b.x)], 1u);
            asm volatile("s_waitcnt vmcnt(0)" ::: "memory");
        } else {
            XB_SPIN(xb_ld(&bar[XB_XGEN(b.x)]) == gen, bar);
            __builtin_amdgcn_fence(__ATOMIC_ACQUIRE, "agent");
            asm volatile("s_waitcnt vmcnt(0)" ::: "memory");
        }
    }
    __syncthreads();
}

#ifndef PROBE_MASK
#define PROBE_MASK 0
#endif
namespace att {
constexpr int NW = 8, QBLK = 32, KVBLK = 64, QB = NW * QBLK;
constexpr int SHM_V = KVBLK * HD * 2, SHM_K = KVBLK * HD * 2;
constexpr int LDS_BYTES = 2 * SHM_V + 2 * SHM_K + NW * 64 * 4;
constexpr float THR = 8.f;
typedef short s16x4 __attribute__((ext_vector_type(4)));
typedef short s16x8 __attribute__((ext_vector_type(8)));
typedef float f32x16 __attribute__((ext_vector_type(16)));
#define KSWZ(row, colB) ((row) * 256 + ((colB) ^ (((row) & 7) << 4)))
#define SBAR() __builtin_amdgcn_sched_barrier(0)
__device__ __forceinline__ int v_st(int k, int c) { const int kk = (k & ~0xC) | ((k & 4) << 1) | ((k & 8) >> 1); return ((kk >> 3) * 4 + (c >> 5)) * 512 + ((kk & 7) * 32 + (c & 31)) * 2; }
__device__ __forceinline__ int v_rd_base(int lane) { return ((lane & 3) << 3) | (((lane >> 2) & 3) << 6) | (((lane >> 4) & 1) << 5) | (((lane >> 5) & 1) << 8); }
constexpr int v_rd_off(int d0, int ks, int half) { return d0 * 512 + ks * 4096 + half * 2048; }
__device__ __forceinline__ int crow(int r, int hi) { return (r & 3) + 8 * (r >> 2) + 4 * hi; }
__device__ __forceinline__ h16x8 load8(const h16* p) { return *reinterpret_cast<const h16x8*>(p); }
__device__ __forceinline__ void mask_tile(f32x16& p0, f32x16& p1, int dq, unsigned W) {
    const float NEG = -__builtin_inff();
#pragma unroll
    for (int r = 0; r < 16; ++r) {
        const int c = (r & 3) + 8 * (r >> 2);
        if ((unsigned)(dq - c) >= W) p0[r] = NEG;
        if ((unsigned)(dq - c - 32) >= W) p1[r] = NEG;
    }
}
__device__ __forceinline__ void kill_tile(f32x16& p0, f32x16& p1, bool dead) {
    const float NEG = -__builtin_inff();
#pragma unroll
    for (int r = 0; r < 16; ++r) { p0[r] = dead ? NEG : p0[r]; p1[r] = dead ? NEG : p1[r]; }
}
__device__ __forceinline__ void partialSM(f32x16& p0, f32x16& p1, float& m_reg, float& mn, float& alpha) {
    float pmax = p0[0];
#pragma unroll
    for (int r = 1; r < 16; ++r) pmax = fmaxf(pmax, p0[r]);
#pragma unroll
    for (int r = 0; r < 16; ++r) pmax = fmaxf(pmax, p1[r]);
    { auto rr = __builtin_amdgcn_permlane32_swap(__float_as_uint(pmax), __float_as_uint(pmax), false, false);
      pmax = fmaxf(__uint_as_float(rr[0]), __uint_as_float(rr[1])); }
    constexpr float C2 = 1.4426950408889634f * SCALE;
    if (__builtin_expect(__all((pmax - m_reg) * SCALE <= THR), 1)) { mn = m_reg; alpha = 1.f; }
    else { mn = fmaxf(m_reg, pmax); alpha = __builtin_amdgcn_exp2f((m_reg - mn) * C2); m_reg = mn; }
    const float mnL = -mn * C2;
#pragma unroll
    for (int r = 0; r < 16; ++r) p0[r] = fmaf(p0[r], C2, mnL);
#pragma unroll
    for (int r = 0; r < 16; ++r) p1[r] = fmaf(p1[r], C2, mnL);
#pragma unroll
    for (int r = 0; r < 16; ++r) p0[r] = __builtin_amdgcn_exp2f(p0[r]);
}
__device__ __forceinline__ void finishSM(f32x16& p0, f32x16& p1, float alpha, float& l_reg, h16x8& pa0, h16x8& pa1, h16x8& pa2, h16x8& pa3) {
#pragma unroll
    for (int r = 0; r < 16; ++r) p1[r] = __builtin_amdgcn_exp2f(p1[r]);
    float ps = 0;
#pragma unroll
    for (int r = 0; r < 16; ++r) ps += p0[r];
#pragma unroll
    for (int r = 0; r < 16; ++r) ps += p1[r];
    { auto rr = __builtin_amdgcn_permlane32_swap(__float_as_uint(ps), __float_as_uint(ps), false, false);
      ps = __uint_as_float(rr[0]) + __uint_as_float(rr[1]); }
    l_reg = l_reg * alpha + ps;
#define PK4(P, B_, OUT) do { unsigned a0 = pk2h(P[B_+0], P[B_+1]), a1 = pk2h(P[B_+2], P[B_+3]);                          \
        unsigned b0 = pk2h(P[B_+4], P[B_+5]), b1 = pk2h(P[B_+6], P[B_+7]);                                             \
        auto r0 = __builtin_amdgcn_permlane32_swap(a0, b0, false, false); auto r1 = __builtin_amdgcn_permlane32_swap(a1, b1, false, false); \
        u32x4 w = {r0[0], r1[0], r0[1], r1[1]}; OUT = __builtin_bit_cast(h16x8, w); } while (0)
    PK4(p0, 0, pa0); PK4(p0, 8, pa1); PK4(p1, 0, pa2); PK4(p1, 8, pa3);
#undef PK4
}
template <int KB>
__device__ __forceinline__ void qkt(f32x16& p0, f32x16& p1, const char* K_lds, int r32, int hi, const h16x8* qr, bool act) {
    if (!act) { const float NEG = -__builtin_inff();
#pragma unroll
        for (int r = 0; r < 16; ++r) { p0[r] = NEG; p1[r] = NEG; } return; }
    p0 = f32x16{}; p1 = f32x16{};
    const char* kb[4];
#pragma unroll
    for (int dd = 0; dd < 4; ++dd) kb[dd] = K_lds + KB * SHM_K + KSWZ(r32, (dd * 16 + hi * 8) * 2);
#pragma unroll
    for (int d0 = 0; d0 < 8; ++d0) { const char* a = kb[d0 & 3] + (d0 >> 2) * 128;
        h16x8 b0 = *reinterpret_cast<const h16x8*>(a);
        h16x8 b1 = *reinterpret_cast<const h16x8*>(a + 32 * 256);
        p0 = __builtin_amdgcn_mfma_f32_32x32x16_f16(b0, qr[d0], p0, 0, 0, 0);
        p1 = __builtin_amdgcn_mfma_f32_32x32x16_f16(b1, qr[d0], p1, 0, 0, 0); }
}
template <int VB>
__device__ __forceinline__ void pv_tile(f32x16* o, int vb0, h16x8 pa0, h16x8 pa1, h16x8 pa2, h16x8 pa3, bool act) {
    if (!act) return;
#define TRRD(dst, off) asm volatile("ds_read_b64_tr_b16 %0, %1 offset:%2" : "=&v"(dst) : "v"(vb0), "i"(off) : "memory")
#define MKB(l, h) __builtin_bit_cast(h16x8, (s16x8){l[0], l[1], l[2], l[3], h[0], h[1], h[2], h[3]})
#define PV_D0(d0) do { s16x4 l0, l1, l2, l3, h0, h1, h2, h3; constexpr int b_ = VB * SHM_V + v_rd_off(d0, 0, 0); \
        TRRD(l0, b_); TRRD(h0, b_ + 2048); TRRD(l1, b_ + 4096); TRRD(h1, b_ + 6144); TRRD(l2, b_ + 8192); TRRD(h2, b_ + 10240); TRRD(l3, b_ + 12288); TRRD(h3, b_ + 14336); \
        asm volatile("s_waitcnt lgkmcnt(0)" ::: "memory"); SBAR();   \
        o[d0] = __builtin_amdgcn_mfma_f32_32x32x16_f16(pa0, MKB(l0, h0), o[d0], 0, 0, 0);   \
        o[d0] = __builtin_amdgcn_mfma_f32_32x32x16_f16(pa1, MKB(l1, h1), o[d0], 0, 0, 0);   \
        o[d0] = __builtin_amdgcn_mfma_f32_32x32x16_f16(pa2, MKB(l2, h2), o[d0], 0, 0, 0);   \
        o[d0] = __builtin_amdgcn_mfma_f32_32x32x16_f16(pa3, MKB(l3, h3), o[d0], 0, 0, 0); } while (0)
    PV_D0(0); PV_D0(1); PV_D0(2); PV_D0(3);
#undef PV_D0
#undef MKB
#undef TRRD
}

struct BlockRef { const h16* K; h16* Ob; float* LSE; const float* KS; int P0, pitch, opitch, W, lsestride, moba; };
struct Seam { h16x8 qr[8]; h16x8 st_v0, st_v1, st_k0, st_k1; };
__device__ __forceinline__ int swa_jlo(int P0, int W) { const int lowk = P0 - W + 1; return lowk > 0 ? lowk / KVBLK : 0; }
#define VMW() asm volatile("s_waitcnt vmcnt(0)" ::: "memory")
#define VMWN(n) asm volatile("s_waitcnt vmcnt(%0)" :: "i"(n) : "memory")
#define SLOAD_H(Kt, o0, o1) do { S.st_v0 = load8((Kt) + 1024 + (o0)); S.st_v1 = load8((Kt) + 1024 + (o1));              \
                         S.st_k0 = load8((Kt) + (o0)); S.st_k1 = load8((Kt) + (o1)); } while (0)
#define SWRITE_HK(bf) do { *(h16x8*)(K_lds + (bf) * SHM_K + kws) = S.st_k0; *(h16x8*)(K_lds + (bf) * SHM_K + kws + 32 * 256) = S.st_k1; } while (0)
#define SWRITE_HV(bf) do { *(h16x8*)(V_lds + (bf) * SHM_V + vst0) = S.st_v0; *(h16x8*)(V_lds + (bf) * SHM_V + vst1) = S.st_v1; } while (0)
#define SWRITE_H(bf) do { SWRITE_HV(bf); SWRITE_HK(bf); } while (0)
__device__ __forceinline__ void attn_prime(const BlockRef& cur, char* lds, Seam& S) {
    const int tid = threadIdx.x, wid = __builtin_amdgcn_readfirstlane(tid >> 6), lane = tid & 63, r32 = lane & 31, hi = lane >> 5;
    const int sr = tid >> 4, sc = (tid & 15) * 8, kws = KSWZ(sr, sc * 2); char* K_lds = lds + 2 * SHM_V;
    const int kb0 = swa_jlo(cur.P0, cur.W) * KVBLK;
    const h16* Qw = cur.K - 1024 + (size_t)(cur.P0 + wid * QBLK) * cur.pitch;
    const unsigned qo = (unsigned)(r32 * cur.pitch + hi * 8);
#pragma unroll
    for (int d0 = 0; d0 < 8; ++d0) S.qr[d0] = load8(Qw + qo + d0 * 16);
    { const unsigned o0 = (unsigned)(sr * cur.pitch + sc), o1 = o0 + 32u * (unsigned)cur.pitch; const h16* Kt = cur.K + (size_t)kb0 * cur.pitch;
      SLOAD_H(Kt, o0, o1); } VMW(); SWRITE_HK(0);
    __syncthreads();
}
__device__ __forceinline__ void attn_block(const BlockRef& cur, const BlockRef& nxt, char* lds, Seam& S) {
    const int tid = threadIdx.x, wid = __builtin_amdgcn_readfirstlane(tid >> 6), lane = tid & 63, r32 = lane & 31, hi = lane >> 5;
    const int W = cur.W;
    const int j_lo = swa_jlo(cur.P0, W);
    const int j_hi = (cur.P0 + QB - 1) / KVBLK + 1;
    const int NT = j_hi - j_lo;
    const int kbn = swa_jlo(nxt.P0, nxt.W) * KVBLK;
    const int qlo = cur.P0 + wid * QBLK, qm = qlo + r32 - 4 * hi;
    char* V_lds = lds; char* K_lds = lds + 2 * SHM_V;
    float* ws = (float*)(lds + 2 * SHM_V + 2 * SHM_K) + wid * 64; float* li_l = ws, * al_l = ws + 32;
    float m_reg = -1e30f, l_reg = 0; f32x16 o[4] = {};
    const int sr = tid >> 4, sc = (tid & 15) * 8, vst0 = v_st(sr, sc), vst1 = v_st(32 + sr, sc), kws = KSWZ(sr, sc * 2);
    const int vb0 = (int)(uintptr_t)V_lds + v_rd_base(lane);
    const h16* Kh = cur.K; const int pitch = cur.pitch;
    const unsigned so0 = (unsigned)(sr * pitch + sc), so1 = so0 + 32u * (unsigned)pitch;
#define KTILE(t) (Kh + (size_t)KBASE(t) * pitch)
    unsigned selmask = 0xffffffffu;
    if (cur.moba) {
        const int qblk = cur.P0 >> 8;
        f32x16 gacc = f32x16{};
#pragma unroll
        for (int d0 = 0; d0 < 8; ++d0) {
            f32x4 a0 = {0.f, 0.f, 0.f, 0.f}, a1 = a0;
            if (r32 < qblk) { const float* kp = cur.KS + (size_t)(r32 * 2) * 1024 + d0 * 16 + hi * 8;
                a0 = *(const f32x4*)kp + *(const f32x4*)(kp + 1024); a1 = *(const f32x4*)(kp + 4) + *(const f32x4*)(kp + 1024 + 4); }
            a0 = a0 * (1.0f / 256.0f); a1 = a1 * (1.0f / 256.0f);
            u32x4 w = {pk2h(a0[0], a0[1]), pk2h(a0[2], a0[3]), pk2h(a1[0], a1[1]), pk2h(a1[2], a1[3])};
            gacc = __builtin_amdgcn_mfma_f32_32x32x16_f16(__builtin_bit_cast(h16x8, w), S.qr[d0], gacc, 0, 0, 0);
        }
        float gb[16];
#pragma unroll
        for (int j = 0; j < 16; ++j) { const int rj = (j & 3) + 4 * (j >> 3); const float own = gacc[rj]; const float oth = __shfl_xor(own, 32);
            gb[j] = (hi == ((j >> 2) & 1)) ? own : oth; }
        unsigned sel = 0u;
#pragma unroll
        for (int rnd = 0; rnd < 3; ++rnd) { float best = -3.0e38f; int bi = -1;
#pragma unroll
            for (int j = 0; j < 15; ++j) { const bool ok = (j < qblk) && !((sel >> j) & 1u) && (gb[j] > best); best = ok ? gb[j] : best; bi = ok ? j : bi; }
            if (bi >= 0) sel |= 1u << bi; }
        selmask = sel | (1u << qblk);
    }
#define RESC(a) do { if (__any((a) < 1.f)) { if (hi == 0) al_l[r32] = (a); asm volatile("s_waitcnt lgkmcnt(0)" ::: "memory");              \
                     _Pragma("unroll") for (int d_ = 0; d_ < 4; ++d_) _Pragma("unroll") for (int r = 0; r < 16; ++r) o[d_][r] *= al_l[crow(r, hi)]; } } while (0)
#define KBASE(t) ((j_lo + (t)) * KVBLK)
#define SELB(t) (((selmask >> (KBASE(t) >> 8)) & 1u) != 0u)
#define ACT(t) (KBASE(t) <= qlo + QBLK - 1 && KBASE(t) + KVBLK - 1 >= qlo - W + 1 && (!cur.moba || __any(SELB(t))))
#define MASKT(P0_, P1_, t) do { const int kb_ = KBASE(t); if (ACT(t)) { if (kb_ + KVBLK - 1 > qlo || kb_ <= qlo + QBLK - 1 - W) mask_tile(P0_, P1_, qm - kb_, (unsigned)W); \
                                 if (cur.moba && !__all(SELB(t))) kill_tile(P0_, P1_, !SELB(t)); } } while (0)
    constexpr int NQL = 8;
#define SEAM_K0() do { VMWN(NQL); SWRITE_HK(0); SBAR(); } while (0)
    f32x16 pA0, pA1, pB0, pB1; float mnA, mnB, alA, alB; h16x8 pa0, pa1, pa2, pa3;
    SWRITE_HV(0); SBAR();
    if (NT > 1) { SLOAD_H(KTILE(1), so0, so1); }
    SBAR(); qkt<0>(pA0, pA1, K_lds, r32, hi, S.qr, ACT(0));
    MASKT(pA0, pA1, 0); partialSM(pA0, pA1, m_reg, mnA, alA);
    if (NT > 1) { VMW(); SWRITE_H(1); }
    __syncthreads();
#define HALF_STEP(PX0, PX1, mnX, alX, PY0, PY1, alY, t, KB, VB, SB) do {                                                      \
        SBAR(); qkt<KB>(PX0, PX1, K_lds, r32, hi, S.qr, ACT(t));                                             \
        finishSM(PY0, PY1, alY, l_reg, pa0, pa1, pa2, pa3); SBAR();                                                           \
        if ((t) + 1 < NT) { SLOAD_H(KTILE((t) + 1), so0, so1); SBAR(); }                                               \
        pv_tile<VB>(o, vb0, pa0, pa1, pa2, pa3, ACT((t) - 1)); MASKT(PX0, PX1, (t)); partialSM(PX0, PX1, m_reg, mnX, alX);                                        \
        __syncthreads();                                                                                                      \
        if ((t) + 1 < NT) { VMW(); SWRITE_H(SB); }                                                                          \
        RESC(alX); __syncthreads(); } while (0)
    for (int t = 1; t + 1 < NT; t += 2) {
        HALF_STEP(pB0, pB1, mnB, alB, pA0, pA1, alA, t, 1, 0, 0);
        HALF_STEP(pA0, pA1, mnA, alA, pB0, pB1, alB, t + 1, 0, 1, 1);
    }
    const bool even = (NT & 1) == 0;
    if (even) { SBAR(); qkt<1>(pB0, pB1, K_lds, r32, hi, S.qr, ACT(NT - 1)); SBAR(); }
    { const unsigned n0 = (unsigned)(sr * nxt.pitch + sc), n1 = n0 + 32u * (unsigned)nxt.pitch; const h16* Kt = nxt.K + (size_t)kbn * nxt.pitch;
      SLOAD_H(Kt, n0, n1); SBAR();
      const h16* Qw = nxt.K - 1024 + (size_t)(nxt.P0 + wid * QBLK) * nxt.pitch; const unsigned qo = (unsigned)(r32 * nxt.pitch + hi * 8);
#pragma unroll
      for (int d0 = 0; d0 < 8; ++d0) S.qr[d0] = load8(Qw + qo + d0 * 16); }
    SBAR();
    finishSM(pA0, pA1, alA, l_reg, pa0, pa1, pa2, pa3); SBAR();
    pv_tile<0>(o, vb0, pa0, pa1, pa2, pa3, ACT(even ? NT - 2 : NT - 1));
    if (even) { MASKT(pB0, pB1, NT - 1); partialSM(pB0, pB1, m_reg, mnB, alB); __syncthreads(); RESC(alB);
        finishSM(pB0, pB1, alB, l_reg, pa0, pa1, pa2, pa3); SBAR(); pv_tile<1>(o, vb0, pa0, pa1, pa2, pa3, ACT(NT - 1)); }
    SBAR(); SEAM_K0();
    if (hi == 0) { li_l[r32] = l_reg; if (cur.LSE) cur.LSE[(size_t)(wid * QBLK + r32) * cur.lsestride] = m_reg * SCALE + __logf(l_reg); }
    asm volatile("s_waitcnt lgkmcnt(0)" ::: "memory");
    float rli[16];
#pragma unroll
    for (int r = 0; r < 16; ++r) rli[r] = __builtin_amdgcn_rcpf(li_l[crow(r, hi)]);
    h16* Ow = cur.Ob + (size_t)(cur.P0 + wid * QBLK) * cur.opitch;
    const unsigned olane = (unsigned)(4 * hi * cur.opitch + r32);
#pragma unroll
    for (int r = 0; r < 16; ++r) { h16* rp = Ow + (size_t)(((r & 3) + 8 * (r >> 2)) * cur.opitch);
#pragma unroll
        for (int d0 = 0; d0 < 4; ++d0) { const float v = o[d0][r] * rli[r];
            const float vn = __shfl_xor(v, 1);
            if ((r32 & 1) == 0) *(unsigned*)(rp + olane + d0 * 32) = pk2h(v, vn); } }
    __syncthreads();
#undef RESC
#undef KBASE
#undef SELB
#undef ACT
#undef MASKT
#undef SEAM_K0
#undef HALF_STEP
#undef KTILE
}
#undef ROWP
#undef VMW
#undef VMWN
#undef SLOAD_H
#undef SWRITE_HK
#undef SWRITE_HV
#undef SWRITE_H

__device__ __forceinline__ BlockRef unit_ref(int idx, unsigned char* ws) {
    const h16* QKV = (const h16*)(ws + WS_QKV);
    BlockRef R;
    if (idx < 512) { const int qb = 15 - (idx >> 5), bh = idx & 31, b = bh >> 3, h = bh & 7;
        const size_t tok0 = (size_t)b * SEQ;
        R.K = QKV + tok0 * NQKV + 1024 + h * HD;
        R.Ob = (h16*)(ws + WS_OA) + tok0 * 1024 + h * HD; R.LSE = nullptr; R.KS = (const float*)(ws + WS_KSUM) + (size_t)(b * 16 * 2) * 1024 + h * HD;
        R.P0 = qb * 256; R.pitch = NQKV; R.opitch = 1024; R.W = 1 << 30; R.lsestride = 0; R.moba = 1; }
    else { const int j = idx - 512, g = j >> 9, rem = j & 511, bh = rem & 31, sub = rem >> 5, b = bh >> 3, h = bh & 7;
        const int d = (g == 0) ? 1 : (g == 1) ? 4 : 16, nqb = 16 / d, r = sub / nqb, qb = sub % nqb;
        const size_t tok0 = (size_t)b * SEQ + r, tokq = tok0 + (size_t)d * qb * 256;
        R.K = QKV + tok0 * NQKV + 4096 + h * HD;
        h16* OBg = (h16*)(ws + (g == 0 ? WS_OB0 : g == 1 ? WS_OB1 : WS_OB2));
        R.Ob = OBg + tok0 * 1024 + h * HD; R.LSE = (float*)(ws + WS_LSE) + ((size_t)g * M + tokq) * 8 + h; R.KS = nullptr;
        R.P0 = qb * 256; R.pitch = NQKV * d; R.opitch = 1024 * d; R.W = 129; R.lsestride = 8 * d; R.moba = 0; }
    return R;
}
constexpr int NUNITS = 2048;
__device__ __forceinline__ int unit_pos(int k, int G, int w) { return (k & 1) ? (k + 1) * G - 1 - w : k * G + w; }
__device__ __forceinline__ void attn_phase(char* lds, unsigned char* ws, int G, int w) {
    int k = 0; int p = unit_pos(0, G, w); if (p >= NUNITS) return;
    BlockRef cur = unit_ref(p, ws);
    Seam S;
    attn_prime(cur, lds, S);
    for (;;) {
        const int pn = unit_pos(k + 1, G, w); const bool last = pn >= NUNITS;
        const BlockRef nxt = last ? cur : unit_ref(pn, ws);
        attn_block(cur, nxt, lds, S);
        if (last) break;
        cur = nxt; ++k;
    }
}
#undef KSWZ
#undef SBAR
}

constexpr int MK_LDS_BYTES = 147456, MK_XLDS_OFF = 131072;
struct MkArgs { Ptrs P; int ph_lo, ph_hi; };
namespace cg = cooperative_groups;
__global__ void __launch_bounds__(512, 2) mk_fwd(MkArgs a) {
    cg::grid_group grid = cg::this_grid();
    extern __shared__ __attribute__((aligned(16))) unsigned char lds_raw[];
    LAS unsigned char* lds = (LAS unsigned char*)lds_raw;
    const Ptrs& P = a.P;
    if (a.ph_lo < 0) grid.sync();
    volatile LAS unsigned* xst = (volatile LAS unsigned*)(lds + MK_XLDS_OFF + 8192);
    if (threadIdx.x < 4) xst[threadIdx.x] = 0u;
    __syncthreads();
    XcdBarrier xbar = xcd_barrier_post((unsigned*)(a.P.ws + WS_CTL), xst);

    const int tid = threadIdx.x, lane = tid & 63, wave = __builtin_amdgcn_readfirstlane(tid >> 6);
    const int G = gridDim.x, gw = blockIdx.x * 8 + wave, NGW = G * 8;
    unsigned char* ws = P.ws;
#define IN(k) (a.ph_lo <= (k) && (k) < a.ph_hi)
#if USE_CG_SYNC
#define SEAM(k) do { if (IN(k) && IN((k) + 1)) grid.sync(); } while (0)
#else
#define SEAM(k) do { if (IN(k) && IN((k) + 1)) xcd_barrier(xbar); } while (0)
#endif
#define PH(k) if (IN(k))
#define PHB() do { } while (0)
    PH(0) { PHB(); p0_prologue(P, (LAS float*)lds + wave * 64 * 33, gw, NGW, lane); }
    SEAM(0);
    PH(1) { PHB();
#if F8ATT
        { pg8::Gemm g{ws + WS_XN, ws + WS_WQKV, M, 2048, DM, 0, 0}; pg8::StaticOrder S; S.init(M, 2048, G, (int)blockIdx.x);
          pg8::EpiQKV E{(h16*)(ws + WS_QKV), (const f32x2*)(ws + WS_CS), (float*)(ws + WS_KSUM), 0};
          pg8::gemm_phase<pg8::EpiQKV, pg8::StaticOrder, false>(lds, lds + MK_XLDS_OFF, g, S, E); }
        { pg8::Gemm g{ws + WS_XN8, ws + WS_WQKV8, M, 4096, DM, 0x76767676, 0x7f7f7f7f}; pg8::StaticOrder S; S.init(M, 4096, G, (int)blockIdx.x);
          pg8::EpiQKV E{(h16*)(ws + WS_QKV), (const f32x2*)(ws + WS_CS), (float*)(ws + WS_KSUM), 8};
          pg8::gemm_phase<pg8::EpiQKV, pg8::StaticOrder, true>(lds, lds + MK_XLDS_OFF, g, S, E); }
#else
        { pg8::Gemm g{ws + WS_XN, ws + WS_WQKV, M, NQKV, DM, 0, 0}; pg8::StaticOrder S; S.init(M, NQKV, G, (int)blockIdx.x);
          pg8::EpiQKV E{(h16*)(ws + WS_QKV), (const f32x2*)(ws + WS_CS), (float*)(ws + WS_KSUM), 0};
          pg8::gemm_phase<pg8::EpiQKV, pg8::StaticOrder>(lds, lds + MK_XLDS_OFF, g, S, E); }
#endif
    }
    SEAM(1);
    PH(2) { PHB(); att::attn_phase((char*)lds_raw, ws, G, (int)blockIdx.x); }
    SEAM(2);
    PH(3) { PHB(); for (int m = gw; m < M; m += NGW) p3_row(P, m, lane); }
    SEAM(3);
    PH(4) { PHB();
#if F8ATT
        pg8::Gemm g{ws + WS_MIX, ws + WS_WO, M, DM, DM, 0x76767676, 0x7f7f7f7f}; pg8::StaticOrder S; S.init(M, DM, G, (int)blockIdx.x);
        pg8::EpiY E{(h16*)(ws + WS_Y), (float*)(ws + WS_SS)};
        pg8::gemm_phase<pg8::EpiY, pg8::StaticOrder, true>(lds, lds + MK_XLDS_OFF, g, S, E);
#else
        pg8::Gemm g{ws + WS_MIX, ws + WS_WO, M, DM, DM, 0, 0}; pg8::StaticOrder S; S.init(M, DM, G, (int)blockIdx.x);
        pg8::EpiY E{(h16*)(ws + WS_Y), (float*)(ws + WS_SS)};
        pg8::gemm_phase<pg8::EpiY, pg8::StaticOrder>(lds, lds + MK_XLDS_OFF, g, S, E);
#endif
    }
    SEAM(4);
    PH(5) { PHB(); for (int m = gw; m < M; m += NGW)
        resid_row<true>(P.x + (size_t)m * DM, (const h16*)(ws + WS_Y) + (size_t)m * DM, (const float*)(ws + WS_SS) + (size_t)m * 32, P.g_attn_post, P.g_ffn_pre,
                        P.out + (size_t)m * DM, (h16*)(ws + WS_XN2 + (size_t)m * DM * (F8FFN ? 1 : 2)), lane); }
    SEAM(5);
    PH(6) { PHB(); pg8::Gemm g{ws + WS_XN2, ws + WS_WGU, M, 2 * FF, DM, 0x76767676, 0x7f7f7f7f};   pg8::StaticOrder S; S.init(M, 2 * FF, G, (int)blockIdx.x);
        pg8::EpiGU E{(h16*)(ws + WS_ACT), P.conv_w, P.conv_b, (float*)(ws + WS_HALO), (float*)(ws + WS_FIXP), (float*)(ws + WS_FIXU)};
        pg8::gemm_phase<pg8::EpiGU, pg8::StaticOrder, (F8FFN != 0)>(lds, lds + MK_XLDS_OFF, g, S, E); }
    SEAM(6);
    PH(7) { PHB(); p5b_fixup(P, blockIdx.x * 512 + tid, G * 512); }
    SEAM(7);
    PH(8) { PHB(); pg8::Gemm g{ws + WS_ACT, ws + WS_WD, M, DM, FF, 0x75757575, 0x7c7c7c7c};   pg8::StaticOrder S; S.init(M, DM, G, (int)blockIdx.x);
        pg8::EpiY E{(h16*)(ws + WS_Y2), (float*)(ws + WS_SS)};
        pg8::gemm_phase<pg8::EpiY, pg8::StaticOrder, (F8FFN != 0)>(lds, lds + MK_XLDS_OFF, g, S, E); }
    SEAM(8);
    if (IN(9)) { for (int m = gw; m < M; m += NGW)
        resid_row<false>(P.out + (size_t)m * DM, (const h16*)(ws + WS_Y2) + (size_t)m * DM, (const float*)(ws + WS_SS) + (size_t)m * 32, P.g_ffn_post, nullptr,
                         P.out + (size_t)m * DM, nullptr, lane); }
#undef IN
#undef SEAM
#undef PH
#undef PHB
}

extern "C" void kernel_launch(void* const* d_in, const int* in_sizes, int n_in, void* d_out, int out_size, void* d_ws, size_t ws_size, hipStream_t stream) {
    if (n_in != 15 || ws_size < WS_END) { fprintf(stderr, "kernel_launch: unexpected n_in %d or ws_size %zu (need %zu)\n", n_in, ws_size, (size_t)WS_END); return; }
    static int grid = 0;
    if (grid == 0) {
        int dev = 0, cus = 0, per_cu = 0;
        (void)hipGetDevice(&dev); (void)hipDeviceGetAttribute(&cus, hipDeviceAttributeMultiprocessorCount, dev);
        (void)hipFuncSetAttribute((const void*)mk_fwd, hipFuncAttributeMaxDynamicSharedMemorySize, MK_LDS_BYTES);
        (void)hipOccupancyMaxActiveBlocksPerMultiprocessor(&per_cu, (const void*)mk_fwd, 512, MK_LDS_BYTES);
        if (per_cu < 1) per_cu = 1;
        grid = cus * per_cu;
        fprintf(stderr, "kernel_launch: cus %d per_cu %d grid %d\n", cus, per_cu, grid);
    }
    Ptrs P{};
    P.x = (const float*)d_in[0]; P.pos = (const int*)d_in[1]; P.g_attn_pre = (const float*)d_in[2]; P.w_qkv = (const float*)d_in[3]; P.g_moba = (const float*)d_in[4];
    P.g_dil = (const float*)d_in[5]; P.w_o = (const float*)d_in[6]; P.g_attn_post = (const float*)d_in[7]; P.g_ffn_pre = (const float*)d_in[8]; P.w_gate = (const float*)d_in[9];
    P.w_up = (const float*)d_in[10]; P.conv_w = (const float*)d_in[11]; P.conv_b = (const float*)d_in[12]; P.w_down = (const float*)d_in[13]; P.g_ffn_post = (const float*)d_in[14];
    P.out = (float*)d_out; P.ws = (unsigned char*)d_ws;
    unsigned char* ws = P.ws;
    MkArgs a{}; a.P = P;
    (void)hipMemsetAsync((char*)d_ws + WS_CTL, 0, 16384, stream);
#if ONE_LAUNCH
    a.ph_lo = 0; a.ph_hi = 10;
    { void* kargs[] = {&a};
      hipError_t e = hipLaunchCooperativeKernel((const void*)mk_fwd, dim3(grid), dim3(512), kargs, MK_LDS_BYTES, stream);
      if (e != hipSuccess) fprintf(stderr, "kernel_launch: cooperative launch failed: %s (grid %d)\n", hipGetErrorString(e), grid); }
    return;
#endif
#define MK(lo, hi) do { a.ph_lo = (lo); a.ph_hi = (hi); for (int rr_ = 0; rr_ < 1 + ((PROBE_MASK >> (lo)) & 1); ++rr_) hipLaunchKernelGGL(mk_fwd, dim3(grid), dim3(512), MK_LDS_BYTES, stream, a); } while (0)
    MK(0, 1);
#if OPT_P1
    MK(1, 2);
#else
    for (int c = 0; c < 6; ++c) { float* scr = (float*)(ws + WS_NSCR1);
        nv_gemm<<<dim3(1024 / 64, M / 64), 256, 0, stream>>>((const h16*)(ws + WS_XN), DM, (const h16*)(ws + WS_WQKV) + (size_t)c * 1024 * DM, DM, scr, 1024, DM);
        nv_rope<<<(M * 1024) / 256, 256, 0, stream>>>(scr, (h16*)(ws + WS_QKV), (const f32x2*)(ws + WS_CS), c); }
    nv_ksum<<<(64 * 1024) / 256, 256, 0, stream>>>((const h16*)(ws + WS_QKV), (float*)(ws + WS_KSUM));
#endif
#if OPT_P2
    MK(2, 3);
#else
    for (int mode = 0; mode < 4; ++mode)
        nv_attn<<<4096, 256, 0, stream>>>((const h16*)(ws + WS_QKV), (const float*)(ws + WS_KSUM), (h16*)(ws + WS_OA), (h16*)(ws + WS_OB0), (h16*)(ws + WS_OB1), (h16*)(ws + WS_OB2), (float*)(ws + WS_LSE), mode);
#endif
    MK(3, 4);
#if OPT_P4
    MK(4, 5);
#else
    { float* scr = (float*)(ws + WS_NSCR4);
      nv_gemm<<<dim3(DM / 64, M / 64), 256, 0, stream>>>((const h16*)(ws + WS_MIX), DM, (const h16*)(ws + WS_WO), DM, scr, DM, DM);
      nv_cvt_ss<<<(M * 32) / 4, 256, 0, stream>>>(scr, DM, (h16*)(ws + WS_Y), 0, (float*)(ws + WS_SS)); }
#endif
    MK(5, 6);
#if OPT_P5
    MK(6, 7); MK(7, 8);
#else
    for (int c = 0; c < 32; ++c) { float* scr = (float*)(ws + WS_NSCR5);
        nv_gemm<<<dim3(512 / 64, M / 64), 256, 0, stream>>>((const h16*)(ws + WS_XN2), DM, (const h16*)(ws + WS_WGU) + (size_t)c * 512 * DM, DM, scr, 512, DM);
        nv_conv<<<(M * 256) / 256, 256, 0, stream>>>(scr, (h16*)(ws + WS_ACT), P.conv_w, P.conv_b, 2 * c); }
#endif
#if OPT_P6
    MK(8, 9);
#else
    for (int c = 0; c < 2; ++c) { float* scr = (float*)(ws + WS_NSCR6);
        nv_gemm<<<dim3(1024 / 64, M / 64), 256, 0, stream>>>((const h16*)(ws + WS_ACT), FF, (const h16*)(ws + WS_WD) + (size_t)c * 1024 * FF, FF, scr, 1024, FF);
        nv_cvt_ss<<<(M * 16) / 4, 256, 0, stream>>>(scr, 1024, (h16*)(ws + WS_Y2), c * 1024, (float*)(ws + WS_SS)); }
#endif
    MK(9, 10);
#undef MK
}
```

```cpp
#define OPT_P1 1
#define OPT_P2 1
#define OPT_P4 1
#define OPT_P5 1
#define OPT_P6 1
#define ONE_LAUNCH 1
#define USE_CG_SYNC 0
#include <hip/hip_runtime.h>
#include <hip/hip_cooperative_groups.h>
#include <cstdio>
#include <cstdint>

typedef _Float16 h16;
typedef h16 h16x8 __attribute__((ext_vector_type(8)));
typedef h16 h16x2 __attribute__((ext_vector_type(2)));
typedef float f32x4 __attribute__((ext_vector_type(4)));
typedef float f32x2 __attribute__((ext_vector_type(2)));
typedef unsigned u32x4 __attribute__((ext_vector_type(4)));
#define LAS __attribute__((address_space(3)))

constexpr int BATCH = 4, SEQ = 4096, DM = 2048, M = BATCH * SEQ, NQKV = 6144, FF = 8192, HD = 128, NH = 8;
constexpr float RMS_EPS = 1e-6f;
constexpr float SCALE = 0.08838834764831845f;
constexpr size_t MiB = 1u << 20;
constexpr size_t WS_CTL = 0, WS_CS = 1 * MiB, WS_KSUM = 3 * MiB, WS_SS = 4 * MiB, WS_LSE = 6 * MiB, WS_HALO = 8 * MiB, WS_FIXP = 12 * MiB, WS_FIXU = 16 * MiB;
constexpr size_t WS_WQKV = 24 * MiB, WS_WO = 48 * MiB, WS_WGU = 56 * MiB, WS_WD = 120 * MiB;
constexpr size_t WS_XN = 152 * MiB;
constexpr size_t WS_OB0 = 152 * MiB, WS_OB1 = 184 * MiB, WS_XN2 = 152 * MiB, WS_Y2 = 152 * MiB;
constexpr size_t WS_QKV = 216 * MiB;
constexpr size_t WS_MIX = 216 * MiB, WS_Y = 280 * MiB, WS_ACT = 216 * MiB;
constexpr size_t WS_OA = 408 * MiB, WS_OB2 = 440 * MiB;
constexpr size_t WS_WQKV8 = 32 * MiB;
constexpr size_t WS_XN8 = 408 * MiB;
constexpr size_t WS_NSCR1 = 408 * MiB;
constexpr size_t WS_NSCR4 = 344 * MiB;
constexpr size_t WS_NSCR5 = 472 * MiB;
constexpr size_t WS_NSCR6 = 24 * MiB;
constexpr size_t WS_END = 512 * MiB;

struct Ptrs {
    const float* x; const int* pos; const float* g_attn_pre; const float* w_qkv; const float* g_moba; const float* g_dil; const float* w_o;
    const float* g_attn_post; const float* g_ffn_pre; const float* w_gate; const float* w_up; const float* conv_w; const float* conv_b;
    const float* w_down; const float* g_ffn_post; float* out; unsigned char* ws;
};

__device__ __forceinline__ unsigned pk2h(float lo, float hi) { f32x2 v = {lo, hi}; h16x2 b = __builtin_convertvector(v, h16x2); return __builtin_bit_cast(unsigned, b); }
__device__ __forceinline__ unsigned pk4f8(float a, float b, float c, float d) {
    a = fminf(fmaxf(a, -448.f), 448.f); b = fminf(fmaxf(b, -448.f), 448.f); c = fminf(fmaxf(c, -448.f), 448.f); d = fminf(fmaxf(d, -448.f), 448.f);
    int w = __builtin_amdgcn_cvt_pk_fp8_f32(a, b, 0, false); w = __builtin_amdgcn_cvt_pk_fp8_f32(c, d, w, true); return (unsigned)w; }
typedef unsigned u32x2 __attribute__((ext_vector_type(2)));
#ifndef F8FFN
#define F8FFN 1
#endif
#ifndef F8ATT
#define F8ATT 1
#endif
constexpr float F8_WGU_SCALE = 512.f, F8_WD_SCALE = 1024.f, F8_ACT_SCALE = 8.f;
__device__ __forceinline__ float wave_sum(float v) {
#pragma unroll
    for (int o = 1; o < 64; o <<= 1) v += __shfl_xor(v, o);
    return v;
}
__device__ __forceinline__ float gelu_tanh(float x) {
    const float t = x * x;
    const float z2 = x * (1.5957691216057308f + 0.07135481627f * t);
    const float e = __builtin_amdgcn_exp2f(-z2 * 1.4426950408889634f);
    return x * __builtin_amdgcn_rcpf(1.0f + e);
}

__device__ __forceinline__ void p0_transpose_item(const float* W, int K, int N, h16* WT, int k0, int n0, int dest_row0, LAS float* scr, int lane) {
#pragma unroll 8
    for (int i = 0; i < 32; ++i) { const int kk = 2 * i + (lane >> 5); scr[kk * 33 + (lane & 31)] = W[(size_t)(k0 + kk) * N + n0 + (lane & 31)]; }
    asm volatile("s_waitcnt lgkmcnt(0)" ::: "memory");
    const int c = lane & 7;
#pragma unroll
    for (int j = 0; j < 4; ++j) { const int n = (lane >> 3) + 8 * j; const LAS float* s = scr + (8 * c) * 33 + n;
        u32x4 o; o.x = pk2h(s[0 * 33], s[1 * 33]); o.y = pk2h(s[2 * 33], s[3 * 33]); o.z = pk2h(s[4 * 33], s[5 * 33]); o.w = pk2h(s[6 * 33], s[7 * 33]);
        *(u32x4*)(WT + (size_t)(dest_row0 + n) * K + k0 + 8 * c) = o; }
    asm volatile("s_waitcnt lgkmcnt(0)" ::: "memory");
}
__device__ __forceinline__ void p0_transpose_item_f8(const float* W, int K, int N, unsigned char* WT, int k0, int n0, int dest_row0, float scale, LAS float* scr, int lane) {
#pragma unroll 8
    for (int i = 0; i < 32; ++i) { const int kk = 2 * i + (lane >> 5); scr[kk * 33 + (lane & 31)] = W[(size_t)(k0 + kk) * N + n0 + (lane & 31)]; }
    asm volatile("s_waitcnt lgkmcnt(0)" ::: "memory");
    const int c = lane & 7;
#pragma unroll
    for (int j = 0; j < 4; ++j) { const int n = (lane >> 3) + 8 * j; const LAS float* s = scr + (8 * c) * 33 + n;
        u32x2 o; o.x = pk4f8(s[0 * 33] * scale, s[1 * 33] * scale, s[2 * 33] * scale, s[3 * 33] * scale); o.y = pk4f8(s[4 * 33] * scale, s[5 * 33] * scale, s[6 * 33] * scale, s[7 * 33] * scale);
        *(u32x2*)(WT + (size_t)(dest_row0 + n) * K + k0 + 8 * c) = o; }
    asm volatile("s_waitcnt lgkmcnt(0)" ::: "memory");
}
__device__ __forceinline__ void rms_row_to_h16(const float* xrow, const float* g, h16* orow, unsigned char* orow8, int lane) {
    f32x4 v[4][2]; float s = 0.f;
#pragma unroll
    for (int j = 0; j < 4; ++j) { const int c = (lane + 64 * j) * 8; v[j][0] = *(const f32x4*)(xrow + c); v[j][1] = *(const f32x4*)(xrow + c + 4);
#pragma unroll
        for (int q = 0; q < 2; ++q) s += (v[j][q].x * v[j][q].x + v[j][q].y * v[j][q].y) + (v[j][q].z * v[j][q].z + v[j][q].w * v[j][q].w); }
    const float rstd = 1.0f / sqrtf(wave_sum(s) * (1.0f / DM) + RMS_EPS);
#pragma unroll
    for (int j = 0; j < 4; ++j) { const int c = (lane + 64 * j) * 8; const f32x4 g0 = *(const f32x4*)(g + c), g1 = *(const f32x4*)(g + c + 4);
        u32x4 o; o.x = pk2h(v[j][0].x * rstd * g0.x, v[j][0].y * rstd * g0.y); o.y = pk2h(v[j][0].z * rstd * g0.z, v[j][0].w * rstd * g0.w);
        o.z = pk2h(v[j][1].x * rstd * g1.x, v[j][1].y * rstd * g1.y); o.w = pk2h(v[j][1].z * rstd * g1.z, v[j][1].w * rstd * g1.w);
        *(u32x4*)(orow + c) = o;
        if (orow8) { u32x2 o8; o8.x = pk4f8(v[j][0].x * rstd * g0.x, v[j][0].y * rstd * g0.y, v[j][0].z * rstd * g0.z, v[j][0].w * rstd * g0.w);
            o8.y = pk4f8(v[j][1].x * rstd * g1.x, v[j][1].y * rstd * g1.y, v[j][1].z * rstd * g1.z, v[j][1].w * rstd * g1.w); *(u32x2*)(orow8 + c) = o8; } }
}
constexpr int I_QKV = (DM / 64) * (NQKV / 32), I_O = (DM / 64) * (DM / 32), I_G = (DM / 64) * (FF / 32), I_D = (FF / 64) * (DM / 32);
constexpr int P0_ITEMS = I_QKV + I_O + 2 * I_G + I_D;
__device__ __forceinline__ void p0_prologue(const Ptrs& P, LAS float* scr  , int gw, int NGW, int lane) {
    h16* WQKV = (h16*)(P.ws + WS_WQKV); h16* WO = (h16*)(P.ws + WS_WO); h16* WGU = (h16*)(P.ws + WS_WGU); h16* WD = (h16*)(P.ws + WS_WD);
    for (int it = gw; it < P0_ITEMS; it += NGW) {
        int r = it;
#if F8ATT
        if (r < I_QKV) { const int nb = NQKV / 32, kb = r / nb, n0 = (r % nb) * 32;
            if (n0 < 2048) p0_transpose_item(P.w_qkv, DM, NQKV, WQKV, kb * 64, n0, n0, scr, lane);
            else p0_transpose_item_f8(P.w_qkv, DM, NQKV, P.ws + WS_WQKV8, kb * 64, n0, n0 - 2048, F8_WGU_SCALE, scr, lane);
            continue; } r -= I_QKV;
        if (r < I_O) { const int nb = DM / 32, kb = r / nb, n0 = (r % nb) * 32; p0_transpose_item_f8(P.w_o, DM, DM, (unsigned char*)WO, kb * 64, n0, n0, F8_WGU_SCALE, scr, lane); continue; } r -= I_O;
#else
        if (r < I_QKV) { const int nb = NQKV / 32, kb = r / nb, n0 = (r % nb) * 32; p0_transpose_item(P.w_qkv, DM, NQKV, WQKV, kb * 64, n0, n0, scr, lane); continue; } r -= I_QKV;
        if (r < I_O) { const int nb = DM / 32, kb = r / nb, n0 = (r % nb) * 32; p0_transpose_item(P.w_o, DM, DM, WO, kb * 64, n0, n0, scr, lane); continue; } r -= I_O;
#endif
#if F8FFN
        if (r < I_G) { const int nb = FF / 32, kb = r / nb, n0 = (r % nb) * 32; p0_transpose_item_f8(P.w_gate, DM, FF, (unsigned char*)WGU, kb * 64, n0, (n0 / 128) * 256 + (n0 % 128), F8_WGU_SCALE, scr, lane); continue; } r -= I_G;
        if (r < I_G) { const int nb = FF / 32, kb = r / nb, n0 = (r % nb) * 32; p0_transpose_item_f8(P.w_up, DM, FF, (unsigned char*)WGU, kb * 64, n0, (n0 / 128) * 256 + 128 + (n0 % 128), F8_WGU_SCALE, scr, lane); continue; } r -= I_G;
        { const int nb = DM / 32, kb = r / nb, n0 = (r % nb) * 32; p0_transpose_item_f8(P.w_down, FF, DM, (unsigned char*)WD, kb * 64, n0, n0, F8_WD_SCALE, scr, lane); }
#else
        if (r < I_G) { const int nb = FF / 32, kb = r / nb, n0 = (r % nb) * 32; p0_transpose_item(P.w_gate, DM, FF, WGU, kb * 64, n0, (n0 / 128) * 256 + (n0 % 128), scr, lane); continue; } r -= I_G;
        if (r < I_G) { const int nb = FF / 32, kb = r / nb, n0 = (r % nb) * 32; p0_transpose_item(P.w_up, DM, FF, WGU, kb * 64, n0, (n0 / 128) * 256 + 128 + (n0 % 128), scr, lane); continue; } r -= I_G;
        { const int nb = DM / 32, kb = r / nb, n0 = (r % nb) * 32; p0_transpose_item(P.w_down, FF, DM, WD, kb * 64, n0, n0, scr, lane); }
#endif
    }
    h16* XN = (h16*)(P.ws + WS_XN);
    for (int m = gw; m < M; m += NGW) rms_row_to_h16(P.x + (size_t)m * DM, P.g_attn_pre, XN + (size_t)m * DM, F8ATT ? P.ws + WS_XN8 + (size_t)m * DM : nullptr, lane);
    f32x2* CS = (f32x2*)(P.ws + WS_CS);
    for (int e = gw * 64 + lane; e < M * 16; e += NGW * 64) { const int m = e >> 4, i = e & 15;
        const float inv_freq = powf(500000.0f, -(float)i / 16.0f); const float ang = (float)P.pos[m] * inv_freq;
        float sn, cs; sincosf(ang, &sn, &cs); CS[e] = (f32x2){cs, sn}; }
}

__device__ __forceinline__ void p3_row(const Ptrs& P, int m, int lane) {
    const h16* OA = (const h16*)(P.ws + WS_OA) + (size_t)m * 1024;
    const h16* OB[3] = {(const h16*)(P.ws + WS_OB0) + (size_t)m * 1024, (const h16*)(P.ws + WS_OB1) + (size_t)m * 1024, (const h16*)(P.ws + WS_OB2) + (size_t)m * 1024};
    const float* LSE = (const float*)(P.ws + WS_LSE);
    h16* MIX = (h16*)(P.ws + WS_MIX) + (size_t)m * DM; unsigned char* MIX8 = P.ws + WS_MIX + (size_t)m * DM; (void)MIX; (void)MIX8;
    {   float v[2][8]; float s = 0.f;
#pragma unroll
        for (int j = 0; j < 2; ++j) { const h16x8 a = *(const h16x8*)(OA + (lane + 64 * j) * 8);
#pragma unroll
            for (int e = 0; e < 8; ++e) { v[j][e] = (float)a[e]; s += v[j][e] * v[j][e]; } }
        const float rstd = 1.0f / sqrtf(wave_sum(s) * (1.0f / 1024.0f) + RMS_EPS);
#pragma unroll
        for (int j = 0; j < 2; ++j) { const int c = (lane + 64 * j) * 8; const f32x4 g0 = *(const f32x4*)(P.g_moba + c), g1 = *(const f32x4*)(P.g_moba + c + 4);
#if F8ATT
            u32x2 o; o.x = pk4f8(v[j][0] * rstd * g0.x, v[j][1] * rstd * g0.y, v[j][2] * rstd * g0.z, v[j][3] * rstd * g0.w);
            o.y = pk4f8(v[j][4] * rstd * g1.x, v[j][5] * rstd * g1.y, v[j][6] * rstd * g1.z, v[j][7] * rstd * g1.w);
            *(u32x2*)(MIX8 + c) = o; } }
#else
            u32x4 o; o.x = pk2h(v[j][0] * rstd * g0.x, v[j][1] * rstd * g0.y); o.y = pk2h(v[j][2] * rstd * g0.z, v[j][3] * rstd * g0.w);
            o.z = pk2h(v[j][4] * rstd * g1.x, v[j][5] * rstd * g1.y); o.w = pk2h(v[j][6] * rstd * g1.z, v[j][7] * rstd * g1.w);
            *(u32x4*)(MIX + c) = o; } }
#endif
    {   float v[2][8]; float s = 0.f;
#pragma unroll
        for (int j = 0; j < 2; ++j) { const int hh = (lane >> 4) + 4 * j;
            const float l0 = LSE[((size_t)0 * M + m) * 8 + hh], l1 = LSE[((size_t)1 * M + m) * 8 + hh], l2 = LSE[((size_t)2 * M + m) * 8 + hh];
            const float mx = fmaxf(l0, fmaxf(l1, l2)); const float e0 = __expf(l0 - mx), e1 = __expf(l1 - mx), e2 = __expf(l2 - mx); const float inv = 1.0f / (e0 + e1 + e2);
            const float w0 = e0 * inv, w1 = e1 * inv, w2 = e2 * inv;
            const h16x8 a0 = *(const h16x8*)(OB[0] + (lane + 64 * j) * 8), a1 = *(const h16x8*)(OB[1] + (lane + 64 * j) * 8), a2 = *(const h16x8*)(OB[2] + (lane + 64 * j) * 8);
#pragma unroll
            for (int e = 0; e < 8; ++e) { v[j][e] = w0 * (float)a0[e] + w1 * (float)a1[e] + w2 * (float)a2[e]; s += v[j][e] * v[j][e]; } }
        const float rstd = 1.0f / sqrtf(wave_sum(s) * (1.0f / 1024.0f) + RMS_EPS);
#pragma unroll
        for (int j = 0; j < 2; ++j) { const int c = (lane + 64 * j) * 8; const f32x4 g0 = *(const f32x4*)(P.g_dil + c), g1 = *(const f32x4*)(P.g_dil + c + 4);
#if F8ATT
            u32x2 o; o.x = pk4f8(v[j][0] * rstd * g0.x, v[j][1] * rstd * g0.y, v[j][2] * rstd * g0.z, v[j][3] * rstd * g0.w);
            o.y = pk4f8(v[j][4] * rstd * g1.x, v[j][5] * rstd * g1.y, v[j][6] * rstd * g1.z, v[j][7] * rstd * g1.w);
            *(u32x2*)(MIX8 + 1024 + c) = o; } }
#else
            u32x4 o; o.x = pk2h(v[j][0] * rstd * g0.x, v[j][1] * rstd * g0.y); o.y = pk2h(v[j][2] * rstd * g0.z, v[j][3] * rstd * g0.w);
            o.z = pk2h(v[j][4] * rstd * g1.x, v[j][5] * rstd * g1.y); o.w = pk2h(v[j][6] * rstd * g1.z, v[j][7] * rstd * g1.w);
            *(u32x4*)(MIX + 1024 + c) = o; } }
#endif
}
template <bool NEXT>
__device__ __forceinline__ void resid_row(const float* base, const h16* y, const float* ss, const float* gpost, const float* gnext, float* out, h16* xn2, int lane) {
    const float part = (lane < 32) ? ss[lane] : 0.f;
    const float rstd_y = 1.0f / sqrtf(wave_sum(part) * (1.0f / DM) + RMS_EPS);
    f32x4 v[4][2]; float s = 0.f;
#pragma unroll
    for (int j = 0; j < 4; ++j) { const int c = (lane + 64 * j) * 8; const h16x8 yy = *(const h16x8*)(y + c);
#pragma unroll
        for (int q = 0; q < 2; ++q) { const f32x4 b = *(const f32x4*)(base + c + 4 * q), g = *(const f32x4*)(gpost + c + 4 * q);
            f32x4 o; o.x = b.x + (float)yy[4 * q + 0] * rstd_y * g.x; o.y = b.y + (float)yy[4 * q + 1] * rstd_y * g.y; o.z = b.z + (float)yy[4 * q + 2] * rstd_y * g.z; o.w = b.w + (float)yy[4 * q + 3] * rstd_y * g.w;
            v[j][q] = o; s += (o.x * o.x + o.y * o.y) + (o.z * o.z + o.w * o.w); *(f32x4*)(out + c + 4 * q) = o; } }
    if (NEXT) { const float rstd = 1.0f / sqrtf(wave_sum(s) * (1.0f / DM) + RMS_EPS);
#pragma unroll
        for (int j = 0; j < 4; ++j) { const int c = (lane + 64 * j) * 8; const f32x4 g0 = *(const f32x4*)(gnext + c), g1 = *(const f32x4*)(gnext + c + 4);
#if F8FFN
            u32x2 o; o.x = pk4f8(v[j][0].x * rstd * g0.x, v[j][0].y * rstd * g0.y, v[j][0].z * rstd * g0.z, v[j][0].w * rstd * g0.w);
            o.y = pk4f8(v[j][1].x * rstd * g1.x, v[j][1].y * rstd * g1.y, v[j][1].z * rstd * g1.z, v[j][1].w * rstd * g1.w);
            *(u32x2*)((unsigned char*)xn2 + c) = o; } }
#else
            u32x4 o; o.x = pk2h(v[j][0].x * rstd * g0.x, v[j][0].y * rstd * g0.y); o.y = pk2h(v[j][0].z * rstd * g0.z, v[j][0].w * rstd * g0.w);
            o.z = pk2h(v[j][1].x * rstd * g1.x, v[j][1].y * rstd * g1.y); o.w = pk2h(v[j][1].z * rstd * g1.z, v[j][1].w * rstd * g1.w);
            *(u32x4*)(xn2 + c) = o; } }
#endif
}

__global__ __launch_bounds__(256) void k_p0(Ptrs P) {
    __shared__ float scr_all[4 * 64 * 33];
    const int lane = threadIdx.x & 63, wave = threadIdx.x >> 6;
    p0_prologue(P, (LAS float*)scr_all + wave * 64 * 33, blockIdx.x * 4 + wave, gridDim.x * 4, lane);
}
__global__ __launch_bounds__(512) void k_p3(Ptrs P) {
    const int lane = threadIdx.x & 63, gw = blockIdx.x * 8 + (threadIdx.x >> 6), NGW = gridDim.x * 8;
    for (int m = gw; m < M; m += NGW) p3_row(P, m, lane);
}
__global__ __launch_bounds__(512) void k_p4b(Ptrs P) {
    const int lane = threadIdx.x & 63, gw = blockIdx.x * 8 + (threadIdx.x >> 6), NGW = gridDim.x * 8;
    for (int m = gw; m < M; m += NGW)
        resid_row<true>(P.x + (size_t)m * DM, (const h16*)(P.ws + WS_Y) + (size_t)m * DM, (const float*)(P.ws + WS_SS) + (size_t)m * 32, P.g_attn_post, P.g_ffn_pre,
                        P.out + (size_t)m * DM, (h16*)(P.ws + WS_XN2) + (size_t)m * DM, lane);
}
__global__ __launch_bounds__(512) void k_p6b(Ptrs P) {
    const int lane = threadIdx.x & 63, gw = blockIdx.x * 8 + (threadIdx.x >> 6), NGW = gridDim.x * 8;
    for (int m = gw; m < M; m += NGW)
        resid_row<false>(P.out + (size_t)m * DM, (const h16*)(P.ws + WS_Y2) + (size_t)m * DM, (const float*)(P.ws + WS_SS) + (size_t)m * 32, P.g_ffn_post, nullptr,
                         P.out + (size_t)m * DM, nullptr, lane);
}

__global__ __launch_bounds__(256) void nv_gemm(const h16* A, int lda, const h16* Bt, int ldb, float* C, int ldc, int K) {
    __shared__ float As[32][65]; __shared__ float Bs[32][65];
    const int t = threadIdx.x, m0 = blockIdx.y * 64, n0 = blockIdx.x * 64, lr = t >> 2, lk = (t & 3) * 8, ty = t >> 4, tx = t & 15;
    float acc[4][4];
#pragma unroll
    for (int i = 0; i < 4; ++i)
#pragma unroll
        for (int j = 0; j < 4; ++j) acc[i][j] = 0.f;
    for (int k0 = 0; k0 < K; k0 += 32) {
        const h16x8 a = *(const h16x8*)(A + (size_t)(m0 + lr) * lda + k0 + lk);
        const h16x8 b = *(const h16x8*)(Bt + (size_t)(n0 + lr) * ldb + k0 + lk);
#pragma unroll
        for (int e = 0; e < 8; ++e) { As[lk + e][lr] = (float)a[e]; Bs[lk + e][lr] = (float)b[e]; }
        __syncthreads();
#pragma unroll 8
        for (int kk = 0; kk < 32; ++kk) {
            float av[4], bv[4];
#pragma unroll
            for (int i = 0; i < 4; ++i) { av[i] = As[kk][ty * 4 + i]; bv[i] = Bs[kk][tx * 4 + i]; }
#pragma unroll
            for (int i = 0; i < 4; ++i)
#pragma unroll
                for (int j = 0; j < 4; ++j) acc[i][j] = fmaf(av[i], bv[j], acc[i][j]);
        }
        __syncthreads();
    }
#pragma unroll
    for (int i = 0; i < 4; ++i) { f32x4 o = {acc[i][0], acc[i][1], acc[i][2], acc[i][3]}; *(f32x4*)(C + (size_t)(m0 + ty * 4 + i) * ldc + n0 + tx * 4) = o; }
}
__global__ __launch_bounds__(256) void nv_rope(const float* C, h16* QKV, const f32x2* CS, int chunk) {
    const size_t e = (size_t)blockIdx.x * 256 + threadIdx.x; const int m = (int)(e >> 10), j = (int)(e & 1023), d = j & 127;
    float v = C[e];
    if ((chunk % 3) != 2 && d < 32) {
        const int i = d & 15; const f32x2 cs = CS[(size_t)m * 16 + i];
        if (d < 16) v = v * cs.x - C[e + 16] * cs.y; else v = v * cs.x + C[e - 16] * cs.y;
    }
    QKV[(size_t)m * NQKV + chunk * 1024 + j] = (h16)v;
}
__global__ __launch_bounds__(256) void nv_ksum(const h16* QKV, float* KSUM) {
    const int e = blockIdx.x * 256 + threadIdx.x; const int pm = e >> 10, c = e & 1023;
    float s = 0.f;
    for (int r = 0; r < 256; ++r) s += (float)QKV[(size_t)(pm * 256 + r) * NQKV + 1024 + c];
    KSUM[(size_t)(pm * 2 + 0) * 1024 + c] = s; KSUM[(size_t)(pm * 2 + 1) * 1024 + c] = 0.f;
}
__global__ __launch_bounds__(256) void nv_cvt_ss(const float* C, int ncols, h16* Y, int col0, float* SS) {
    const int lane = threadIdx.x & 63; const size_t w = (size_t)blockIdx.x * 4 + (threadIdx.x >> 6); const int nslot = ncols / 64; const int m = (int)(w / nslot), s = (int)(w % nslot);
    const float v = C[(size_t)m * ncols + s * 64 + lane];
    Y[(size_t)m * DM + col0 + s * 64 + lane] = (h16)v;
    const float q = wave_sum(v * v);
    if (lane == 0) SS[(size_t)m * 32 + col0 / 64 + s] = q;
}
__global__ __launch_bounds__(256) void nv_conv(const float* C, h16* ACT, const float* conv_w, const float* conv_b, int g0) {
    const size_t e = (size_t)blockIdx.x * 256 + threadIdx.x; const int m = (int)(e >> 8), jj = (int)(e & 255), gi = jj >> 7, j = jj & 127;
    const int c = 128 * (g0 + gi) + j; const int s = m & (SEQ - 1);
    const float* Cg = C + (size_t)m * 512 + gi * 256 + j;
    const float g_0 = Cg[0], g_1 = (s >= 1) ? Cg[-512] : 0.f, g_2 = (s >= 2) ? Cg[-1024] : 0.f, u = Cg[128];
    const float pre = conv_b[c] + conv_w[c] * g_2 + conv_w[FF + c] * g_1 + conv_w[2 * FF + c] * g_0;
    ACT[(size_t)m * FF + c] = (h16)(gelu_tanh(pre) * u);
}
__global__ __launch_bounds__(256) void nv_attn(const h16* QKV, const float* KSUM, h16* OA, h16* OB0, h16* OB1, h16* OB2, float* LSE, int mode) {
    __shared__ float Qs[32][129]; __shared__ float Ks[32][129]; __shared__ float Vs[32][128]; __shared__ float Ps[32][33]; __shared__ float Gs[32][16]; __shared__ unsigned Sel[32];
    const int t = threadIdx.x, u = blockIdx.x, b = u >> 10, h = (u >> 7) & 7, rem = u & 127;
    int d = 1, r = 0, i0, W; const h16 *Qp, *Kp, *Vp; h16* Op; size_t pitch, opitch;
    if (mode == 0) { i0 = rem * 32; W = 1 << 30; pitch = NQKV; opitch = 1024;
        Qp = QKV + (size_t)(b * SEQ) * NQKV + 0 + h * HD; Kp = Qp + 1024; Vp = Qp + 2048; Op = OA + (size_t)(b * SEQ) * 1024 + h * HD; }
    else { d = (mode == 1) ? 1 : (mode == 2) ? 4 : 16; const int nq = (SEQ / d) / 32; r = rem / nq; i0 = (rem % nq) * 32; W = 129; pitch = (size_t)NQKV * d; opitch = (size_t)1024 * d;
        Qp = QKV + (size_t)(b * SEQ + r) * NQKV + 3072 + h * HD; Kp = Qp + 1024; Vp = Qp + 2048;
        h16* OBm = (mode == 1) ? OB0 : (mode == 2) ? OB1 : OB2; Op = OBm + (size_t)(b * SEQ + r) * 1024 + h * HD; }
    for (int e = t; e < 32 * 128; e += 256) { const int qi = e >> 7, c = e & 127; Qs[qi][c] = (float)Qp[(size_t)(i0 + qi) * pitch + c]; }
    __syncthreads();
    const int qi = t >> 3, sub = t & 7;
    if (mode == 0) {
        const int qblk = i0 >> 8;
        for (int jj = 0; jj < 2; ++jj) { const int j = sub + 8 * jj; float g = 0.f;
            if (j < qblk) { const float* k0 = KSUM + (size_t)((b * 16 + j) * 2) * 1024 + h * HD; for (int c = 0; c < 128; ++c) g += Qs[qi][c] * (k0[c] + k0[1024 + c]) * (1.0f / 256.0f); }
            Gs[qi][j] = g; }
        __syncthreads();
        if (sub == 0) { unsigned sel = 0;
            for (int rnd = 0; rnd < 3; ++rnd) { float best = -3.0e38f; int bi = -1;
                for (int j = 0; j < 16; ++j) if (j < qblk && !((sel >> j) & 1u) && Gs[qi][j] > best) { best = Gs[qi][j]; bi = j; }
                if (bi >= 0) sel |= 1u << bi; }
            sel |= 1u << qblk; Sel[qi] = sel; }
        __syncthreads();
    }
    const unsigned selmask = (mode == 0) ? Sel[qi] : 0xffffffffu;
    float o[16];
#pragma unroll
    for (int c = 0; c < 16; ++c) o[c] = 0.f;
    float mrun = -1e30f, lrun = 0.f;
    int klo = (mode == 0) ? 0 : (i0 - 128 > 0 ? i0 - 128 : 0); klo &= ~31;
    const int khi = i0 + 32;
    const int iq = i0 + qi;
    for (int k0 = klo; k0 < khi; k0 += 32) {
        __syncthreads();
        for (int e = t; e < 32 * 128; e += 256) { const int kk = e >> 7, c = e & 127; Ks[kk][c] = (float)Kp[(size_t)(k0 + kk) * pitch + c]; Vs[kk][c] = (float)Vp[(size_t)(k0 + kk) * pitch + c]; }
        __syncthreads();
        float sc[4]; float tmax = -1e30f;
#pragma unroll
        for (int j = 0; j < 4; ++j) { const int kk = sub * 4 + j, kidx = k0 + kk; float a = 0.f;
            for (int c = 0; c < 128; ++c) a += Qs[qi][c] * Ks[kk][c];
            a *= SCALE;
            bool ok = (kidx <= iq) && (iq - kidx < W);
            if (mode == 0) ok = ok && ((selmask >> (kidx >> 8)) & 1u);
            sc[j] = ok ? a : -INFINITY; tmax = fmaxf(tmax, sc[j]); }
        tmax = fmaxf(tmax, __shfl_xor(tmax, 1)); tmax = fmaxf(tmax, __shfl_xor(tmax, 2)); tmax = fmaxf(tmax, __shfl_xor(tmax, 4));
        const float mnew = fmaxf(mrun, tmax); const float alpha = __expf(mrun - mnew);
        float ps = 0.f;
#pragma unroll
        for (int j = 0; j < 4; ++j) { const float p = __expf(sc[j] - mnew); Ps[qi][sub * 4 + j] = p; ps += p; }
        ps += __shfl_xor(ps, 1); ps += __shfl_xor(ps, 2); ps += __shfl_xor(ps, 4);
        lrun = lrun * alpha + ps; mrun = mnew;
        __syncthreads();
#pragma unroll
        for (int c = 0; c < 16; ++c) o[c] *= alpha;
        for (int kk = 0; kk < 32; ++kk) { const float p = Ps[qi][kk];
#pragma unroll
            for (int c = 0; c < 16; ++c) o[c] = fmaf(p, Vs[kk][sub * 16 + c], o[c]); }
    }
    const float inv = 1.0f / lrun;
#pragma unroll
    for (int c = 0; c < 16; ++c) Op[(size_t)(i0 + qi) * opitch + sub * 16 + c] = (h16)(o[c] * inv);
    if (mode != 0 && sub == 0) LSE[((size_t)(mode - 1) * M + (size_t)(b * SEQ + r + d * (i0 + qi))) * 8 + h] = mrun + __logf(lrun);
}

namespace pg8 {
#define PG8_LAS __attribute__((address_space(3)))
constexpr int BM = 256, BK = 64, HALF = 128, HTB = HALF * BK * 2, STAGE_BYTES = 8 * HTB, NXCD = 8, WGM = 8;
__host__ __device__ __forceinline__ int lds_byte(int r, int c) { const int st = (r >> 4) * 2 + (c >> 5), rr = r & 15, cc = c & 31, ob = rr * 64 + cc * 2; return st * 1024 + (ob ^ (((ob >> 9) & 1) << 5)); }
__host__ __device__ __forceinline__ void stage_rc(int b, int& R, int& C) { const int st = b / 1024, sb = b % 1024, swz = sb ^ (((sb >> 9) & 1) << 5); R = (st >> 1) * 16 + swz / 64; C = (st & 1) * 32 + (swz % 64) / 2; }
__host__ __device__ __forceinline__ int perm32(int rho) { const int n = rho >> 4, i = rho & 15; return 8 * (i >> 2) + 4 * n + (i & 3); }
struct Unit { int pm, pn; };
struct Gemm { const void* A; const void* Bt; int M, N, K; int scale_w, scale_x; };
typedef int i32x8 __attribute__((ext_vector_type(8)));
typedef int i32x4 __attribute__((ext_vector_type(4)));
struct StaticOrder {
    int nM, nN, nwg, G, c;
    __host__ __device__ void init(int M_, int N_, int G_, int c_) { nM = M_ / BM; nN = N_ / BM; nwg = nM * nN; G = G_; c = c_; }
    __host__ __device__ bool next(int i, Unit& u) const {
        const long L = (long)i * G + c; if (L >= nwg) return false;
        int wgid = (int)L; { const int q = nwg / NXCD, r = nwg % NXCD, xcd = wgid % NXCD, off = wgid / NXCD; wgid = (xcd < r ? xcd * (q + 1) : r * (q + 1) + (xcd - r) * q) + off; }
        const int nig = WGM * nN, gid = wgid / nig, fm = gid * WGM, gsz = (nM - fm) < WGM ? (nM - fm) : WGM;
        u.pm = fm + ((wgid % nig) % gsz); u.pn = (wgid % nig) / gsz; return true;
    }
};
typedef f32x4 Acc[2][2][4][2];

__device__ __forceinline__ u32x4 pack8h(f32x4 v0, f32x4 v1) { u32x4 w; w.x = pk2h(v0[0], v0[1]); w.y = pk2h(v0[2], v0[3]); w.z = pk2h(v1[0], v1[1]); w.w = pk2h(v1[2], v1[3]); return w; }

struct EpiQKV {
    static constexpr bool IDEMPOTENT = false;
    __device__ __forceinline__ void prefetch(const Unit&, int, int, PG8_LAS unsigned char*) const {}
    h16* O; const f32x2* CS; float* KSUM; int pn_off;
    __device__ __forceinline__ void operator()(Acc& acc, const Unit& u0, int wr, int wc, int fr, int fq, PG8_LAS unsigned char* xlds) const {
        Unit u = u0; u.pn += pn_off;
        const int grp6 = u.pn >> 2, kind = grp6 % 3;
        const int row0 = u.pm * BM + wr * 64 + fr;
        if (kind != 2 && wc == 0) {
            const float sgn = (fq < 2) ? -1.f : 1.f;
#pragma unroll
            for (int ai = 0; ai < 2; ++ai)
#pragma unroll
                for (int m = 0; m < 4; ++m) {
                    const f32x4* cp = (const f32x4*)(CS + (size_t)(row0 + ai * HALF + m * 16) * 16 + 8 * (fq & 1));
                    const f32x4 c0 = cp[0], c1 = cp[1], c2 = cp[2], c3 = cp[3];
                    const float cs[8] = {c0[0], c0[2], c1[0], c1[2], c2[0], c2[2], c3[0], c3[2]}, sn[8] = {c0[1], c0[3], c1[1], c1[3], c2[1], c2[3], c3[1], c3[3]};
#pragma unroll
                    for (int bj = 0; bj < 2; ++bj)
#pragma unroll
                        for (int n = 0; n < 2; ++n)
#pragma unroll
                            for (int e = 0; e < 4; ++e) { const float v = acc[ai][bj][m][n][e]; const float o = __shfl_xor(v, 32);
                                acc[ai][bj][m][n][e] = v * cs[4 * n + e] + sgn * o * sn[4 * n + e]; }
                }
        }
        if (grp6 == 1) {
#pragma unroll
            for (int bj = 0; bj < 2; ++bj)
#pragma unroll
                for (int n = 0; n < 2; ++n) { f32x4 s = {0.f, 0.f, 0.f, 0.f};
#pragma unroll
                    for (int ai = 0; ai < 2; ++ai)
#pragma unroll
                        for (int m = 0; m < 4; ++m) s += acc[ai][bj][m][n];
#pragma unroll
                    for (int e = 0; e < 4; ++e) { float t = s[e]; t += __shfl_xor(t, 1); t += __shfl_xor(t, 2); t += __shfl_xor(t, 4); t += __shfl_xor(t, 8); s[e] = t; }
                    if (fr == 0) *(f32x4*)(KSUM + (size_t)(u.pm * 2 + wr) * 1024 + (u.pn - 4) * 256 + bj * HALF + wc * 32 + 8 * fq + 4 * n) = s; }
        }
        const int col0 = u.pn * BM + wc * 32 + 8 * fq;
#pragma unroll
        for (int ai = 0; ai < 2; ++ai)
#pragma unroll
            for (int m = 0; m < 4; ++m) { h16* rowp = O + (size_t)(row0 + ai * HALF + m * 16) * NQKV + col0;
#pragma unroll
                for (int bj = 0; bj < 2; ++bj) *(u32x4*)(rowp + bj * HALF) = pack8h(acc[ai][bj][m][0], acc[ai][bj][m][1]); }
    }
};
struct EpiY {
    static constexpr bool IDEMPOTENT = false;
    __device__ __forceinline__ void prefetch(const Unit&, int, int, PG8_LAS unsigned char*) const {}
    h16* O; float* SS;
    __device__ __forceinline__ void operator()(Acc& acc, const Unit& u, int wr, int wc, int fr, int fq, PG8_LAS unsigned char* xlds) const {
        const int row0 = u.pm * BM + wr * 64 + fr, col0 = u.pn * BM + wc * 32 + 8 * fq;
#pragma unroll
        for (int ai = 0; ai < 2; ++ai)
#pragma unroll
            for (int m = 0; m < 4; ++m) { const int row = row0 + ai * HALF + m * 16; h16* rowp = O + (size_t)row * DM + col0; float q = 0.f;
#pragma unroll
                for (int bj = 0; bj < 2; ++bj) { const f32x4 v0 = acc[ai][bj][m][0], v1 = acc[ai][bj][m][1];
                    q += (v0[0] * v0[0] + v0[1] * v0[1]) + (v0[2] * v0[2] + v0[3] * v0[3]) + (v1[0] * v1[0] + v1[1] * v1[1]) + (v1[2] * v1[2] + v1[3] * v1[3]);
                    *(u32x4*)(rowp + bj * HALF) = pack8h(v0, v1); }
                q += __shfl_xor(q, 16); q += __shfl_xor(q, 32);
                if (fq == 0) SS[(size_t)row * 32 + u.pn * 4 + wc] = q; }
    }
};
template <int CTRL> __device__ __forceinline__ float dpp_mov(float old, float src) {
    return __builtin_bit_cast(float, __builtin_amdgcn_update_dpp(__builtin_bit_cast(int, old), __builtin_bit_cast(int, src), CTRL, 0xF, 0xF, false)); }
struct EpiGU {
    static constexpr bool IDEMPOTENT = true;
    h16* ACT; const float* conv_w; const float* conv_b; float* HALO; float* FIXP; float* FIXU;
    __device__ __forceinline__ void prefetch(const Unit& u, int wid, int lane, PG8_LAS unsigned char* xlds) const {
        const int wc = wid & 3, col = u.pn * HALF + wc * 32 + (lane & 31), v = lane >> 5;
        const float* s0 = conv_w + (size_t)v * FF + col;
        const float* s1 = v ? conv_b + col : conv_w + (size_t)2 * FF + col;
        PG8_LAS unsigned* d = (PG8_LAS unsigned*)(xlds + 4096 + wid * 512);
        __builtin_amdgcn_global_load_lds((const unsigned*)s0, d, 4, 0, 0);
        __builtin_amdgcn_global_load_lds((const unsigned*)s1, d + 64, 4, 0, 0);
    }
    __device__ __forceinline__ void operator()(Acc& acc, const Unit& u, int wr, int wc, int fr, int fq, PG8_LAS unsigned char* xlds) const {
#if F8FFN
        typedef h16x2 hh;
        PG8_LAS u32x4* xb = (PG8_LAS u32x4*)xlds;
        const int c0 = u.pn * HALF + wc * 32 + 8 * fq;
#define CV2(a, b) __builtin_bit_cast(hh, pk2h((a), (b)))
#define DPPI(ctrl, oldv, srcv) __builtin_amdgcn_update_dpp((int)(oldv), (int)(srcv), ctrl, 0xF, 0xF, false)
        if (fr >= 14) {
#pragma unroll
            for (int ai = 0; ai < 2; ++ai) xb[(((ai * 2 + wr) * 4 + wc) * 4 + fq) * 2 + (fr - 14)] = pack8h(acc[ai][0][3][0], acc[ai][0][3][1]);
            if (wr == 1) { float* hp = HALO + ((size_t)(u.pm * 2 + (fr - 14))) * FF + c0;
                *(f32x4*)hp = acc[1][0][3][0]; *(f32x4*)(hp + 4) = acc[1][0][3][1]; }
        }
        asm volatile("s_waitcnt lgkmcnt(0)" ::: "memory"); __builtin_amdgcn_s_barrier(); asm volatile("" ::: "memory");
        hh w0[4], w1[4], w2[4], bb[4];
        { const PG8_LAS float* cw = (const PG8_LAS float*)(xlds + 4096 + (wr * 4 + wc) * 512) + 8 * fq;
#pragma unroll
          for (int n = 0; n < 2; ++n) { const f32x4 a = *(const PG8_LAS f32x4*)(cw + 4 * n), b = *(const PG8_LAS f32x4*)(cw + 32 + 4 * n), c = *(const PG8_LAS f32x4*)(cw + 64 + 4 * n), d = *(const PG8_LAS f32x4*)(cw + 96 + 4 * n);
              w0[2 * n] = CV2(a[0], a[1]); w0[2 * n + 1] = CV2(a[2], a[3]); w1[2 * n] = CV2(b[0], b[1]); w1[2 * n + 1] = CV2(b[2], b[3]);
              w2[2 * n] = CV2(c[0], c[1]); w2[2 * n + 1] = CV2(c[2], c[3]); bb[2 * n] = CV2(d[0], d[1]); bb[2 * n + 1] = CV2(d[2], d[3]); } }
        const hh zero2 = {(h16)0.f, (h16)0.f}, one2 = {(h16)1.f, (h16)1.f}, c1 = {(h16)-2.3022082f, (h16)-2.3022082f}, c2 = {(h16)-0.1029432f, (h16)-0.1029432f};
        const hh s8 = {(h16)F8_ACT_SCALE, (h16)F8_ACT_SCALE}, hi448 = {(h16)448.f, (h16)448.f}, lo448 = {(h16)-448.f, (h16)-448.f};
#pragma unroll
        for (int ai = 0; ai < 2; ++ai) {
            int pv[4];
            if (ai == 0 && wr == 0) { pv[0] = 0; pv[1] = 0; pv[2] = 0; pv[3] = 0; }
            else { const int sg = (wr == 1) ? (ai * 2 + 0) : (0 * 2 + 1);
                const u32x4 t = xb[((sg * 4 + wc) * 4 + fq) * 2 + (fr & 1)];
                pv[0] = (int)t.x; pv[1] = (int)t.y; pv[2] = (int)t.z; pv[3] = (int)t.w; }
#pragma unroll
            for (int m = 0; m < 4; ++m) {
                const int row = u.pm * BM + ai * HALF + wr * 64 + m * 16 + fr;
                hh gg[4], pre[4], o[4];
#pragma unroll
                for (int q = 0; q < 4; ++q) { gg[q] = CV2(acc[ai][0][m][q >> 1][2 * (q & 1)], acc[ai][0][m][q >> 1][2 * (q & 1) + 1]);
                    const int gi = __builtin_bit_cast(int, gg[q]);
                    const hh p1 = __builtin_bit_cast(hh, DPPI(0x111, DPPI(0x121, 0, pv[q]), gi));
                    const hh p2 = __builtin_bit_cast(hh, DPPI(0x112, DPPI(0x122, 0, pv[q]), gi));
                    pre[q] = w2[q] * gg[q] + (w1[q] * p1 + (w0[q] * p2 + bb[q])); }
                if (ai == 0 && wr == 0 && m == 0 && fr < 2) { float* fp = FIXP + ((size_t)(u.pm * 2 + fr)) * FF + c0; float* fu = FIXU + ((size_t)(u.pm * 2 + fr)) * FF + c0;
                    *(f32x4*)fp = (f32x4){(float)pre[0][0], (float)pre[0][1], (float)pre[1][0], (float)pre[1][1]}; *(f32x4*)(fp + 4) = (f32x4){(float)pre[2][0], (float)pre[2][1], (float)pre[3][0], (float)pre[3][1]};
                    *(f32x4*)fu = acc[0][1][0][0]; *(f32x4*)(fu + 4) = acc[0][1][0][1]; }
#pragma unroll
                for (int q = 0; q < 4; ++q) { const hh x = pre[q]; const hh a = x * (x * x * c2 + c1);
                    hh e; e[0] = __builtin_exp2f16(a[0]); e[1] = __builtin_exp2f16(a[1]);
                    const hh d = e + one2; hh r; r[0] = __builtin_amdgcn_rcph(d[0]); r[1] = __builtin_amdgcn_rcph(d[1]);
                    const hh uu = CV2(acc[ai][1][m][q >> 1][2 * (q & 1)], acc[ai][1][m][q >> 1][2 * (q & 1) + 1]);
                    hh y = (x * r) * uu * s8; y = __builtin_elementwise_max(__builtin_elementwise_min(y, hi448), lo448); o[q] = y; }
                typedef short s16x2 __attribute__((ext_vector_type(2)));
                s16x2 wl = {0, 0}, wh = {0, 0};
                wl = __builtin_amdgcn_cvt_scalef32_pk_fp8_f16(wl, o[0], 1.0f, false); wl = __builtin_amdgcn_cvt_scalef32_pk_fp8_f16(wl, o[1], 1.0f, true);
                wh = __builtin_amdgcn_cvt_scalef32_pk_fp8_f16(wh, o[2], 1.0f, false); wh = __builtin_amdgcn_cvt_scalef32_pk_fp8_f16(wh, o[3], 1.0f, true);
                u32x2 w8; w8.x = __builtin_bit_cast(unsigned, wl); w8.y = __builtin_bit_cast(unsigned, wh);
                *(u32x2*)((unsigned char*)ACT + (size_t)row * FF + c0) = w8;
#pragma unroll
                for (int q = 0; q < 4; ++q) pv[q] = __builtin_bit_cast(int, gg[q]);
            }
        }
#undef CV2
#undef DPPI
#else
        PG8_LAS float* xb = (PG8_LAS float*)xlds;
        const int c0 = u.pn * HALF + wc * 32 + 8 * fq;
        if (fr >= 14) {
#pragma unroll
            for (int ai = 0; ai < 2; ++ai) { PG8_LAS float* d = xb + ((((ai * 2 + wr) * 4 + wc) * 4 + fq) * 2 + (fr - 14)) * 8;
                *(PG8_LAS f32x4*)d = acc[ai][0][3][0]; *(PG8_LAS f32x4*)(d + 4) = acc[ai][0][3][1]; }
            if (wr == 1) { float* hp = HALO + ((size_t)(u.pm * 2 + (fr - 14))) * FF + c0;
                *(f32x4*)hp = acc[1][0][3][0]; *(f32x4*)(hp + 4) = acc[1][0][3][1]; }
        }
        asm volatile("s_waitcnt lgkmcnt(0)" ::: "memory"); __builtin_amdgcn_s_barrier(); asm volatile("" ::: "memory");
        f32x4 w0[2], w1[2], w2[2], bb[2];
        { const PG8_LAS float* cw = (const PG8_LAS float*)(xlds + 4096 + (wr * 4 + wc) * 512) + 8 * fq;
#pragma unroll
          for (int n = 0; n < 2; ++n) { w0[n] = *(const PG8_LAS f32x4*)(cw + 4 * n); w1[n] = *(const PG8_LAS f32x4*)(cw + 32 + 4 * n); w2[n] = *(const PG8_LAS f32x4*)(cw + 64 + 4 * n); bb[n] = *(const PG8_LAS f32x4*)(cw + 96 + 4 * n); } }
#pragma unroll
        for (int ai = 0; ai < 2; ++ai) {
            f32x4 pv[2];
            if (ai == 0 && wr == 0) { pv[0] = (f32x4){0.f, 0.f, 0.f, 0.f}; pv[1] = pv[0]; }
            else { const int sg = (wr == 1) ? (ai * 2 + 0) : (0 * 2 + 1);
                const PG8_LAS float* s = xb + (((sg * 4 + wc) * 4 + fq) * 2 + (fr & 1)) * 8;
                pv[0] = *(const PG8_LAS f32x4*)s; pv[1] = *(const PG8_LAS f32x4*)(s + 4); }
#pragma unroll
            for (int m = 0; m < 4; ++m) {
                const int row = u.pm * BM + ai * HALF + wr * 64 + m * 16 + fr;
                f32x4 o[2];
#pragma unroll
                for (int n = 0; n < 2; ++n)
#pragma unroll
                    for (int e = 0; e < 4; ++e) { const float g = acc[ai][0][m][n][e], pg = pv[n][e];
                        const float p1 = dpp_mov<0x111>(dpp_mov<0x121>(0.f, pg), g);
                        const float p2 = dpp_mov<0x112>(dpp_mov<0x122>(0.f, pg), g);
                        o[n][e] = bb[n][e] + w0[n][e] * p2 + w1[n][e] * p1 + w2[n][e] * g; }
                if (ai == 0 && wr == 0 && m == 0 && fr < 2) { float* fp = FIXP + ((size_t)(u.pm * 2 + fr)) * FF + c0; float* fu = FIXU + ((size_t)(u.pm * 2 + fr)) * FF + c0;
                    *(f32x4*)fp = o[0]; *(f32x4*)(fp + 4) = o[1]; *(f32x4*)fu = acc[0][1][0][0]; *(f32x4*)(fu + 4) = acc[0][1][0][1]; }
#pragma unroll
                for (int n = 0; n < 2; ++n)
#pragma unroll
                    for (int e = 0; e < 4; ++e) o[n][e] = gelu_tanh(o[n][e]) * acc[ai][1][m][n][e];
                *(u32x4*)(ACT + (size_t)row * FF + c0) = pack8h(o[0], o[1]);
                pv[0] = acc[ai][0][m][0]; pv[1] = acc[ai][0][m][1];
            }
        }
#endif
    }
};

template <class Epi, class Sched, bool F8 = false>
__device__ __forceinline__ void gemm_phase(PG8_LAS unsigned char* lds, PG8_LAS unsigned char* xlds, const Gemm g, const Sched& S, const Epi& E) {
    const int tid = threadIdx.x, wid = __builtin_amdgcn_readfirstlane(tid >> 6), lane = tid & 63, wr = wid >> 2, wc = wid & 3, fr = lane & 15, fq = lane >> 4;
    const int RB = F8 ? g.K : g.K * 2, nt = RB / 128;
    unsigned voffA[2], voffB[2];
#pragma unroll
    for (int i = 0; i < 2; ++i) { int R, C; stage_rc(tid * 16 + i * 8192, R, C); const int Rb = (R & ~31) + perm32(R & 31);
        voffA[i] = (unsigned)(R * RB + C * 2); voffB[i] = (unsigned)(Rb * RB + C * 2); }
    const size_t kstep = (size_t)128;
    const size_t hstep = (size_t)HALF * RB;
    const size_t tstep = 2 * hstep;
    const unsigned ldsw = (unsigned)wid * 1024u;
    const int aoff = lds_byte(wr * 64 + fr, fq * 8), boff = lds_byte(wc * 32 + fr, fq * 8);
#define PG8_SA(b, h) (((b) * 2 + (h)) * HTB)
#define PG8_SB(b, h) ((4 + (b) * 2 + (h)) * HTB)
#define PG8_STAGE(bufoff, gbase, voff) do { _Pragma("unroll") for (int _i = 0; _i < 2; ++_i) \
        __builtin_amdgcn_global_load_lds((const unsigned*)((const char*)(gbase) + (voff)[_i]), (PG8_LAS unsigned*)(lds + (bufoff) + ldsw + _i * 8192), 16, 0, 0); } while (0)
#define PG8_LDA(dst, b, h) do { _Pragma("unroll") for (int m = 0; m < 4; ++m) _Pragma("unroll") for (int k = 0; k < 2; ++k) dst[m][k] = *(const PG8_LAS h16x8*)(lds + PG8_SA(b, h) + aoff + m * 2048 + k * 1024); } while (0)
#define PG8_LDB(dst, b, h) do { _Pragma("unroll") for (int n = 0; n < 2; ++n) _Pragma("unroll") for (int k = 0; k < 2; ++k) dst[n][k] = *(const PG8_LAS h16x8*)(lds + PG8_SB(b, h) + boff + n * 2048 + k * 1024); } while (0)
#define PG8_CAT(v) __builtin_shufflevector(__builtin_bit_cast(i32x4, v[0]), __builtin_bit_cast(i32x4, v[1]), 0, 1, 2, 3, 4, 5, 6, 7)
#define PG8_MMA(ai, bj, At, Bt) do { __builtin_amdgcn_s_setprio(1); \
        if constexpr (F8) { _Pragma("unroll") for (int m = 0; m < 4; ++m) _Pragma("unroll") for (int n = 0; n < 2; ++n) \
            asm volatile("v_mfma_scale_f32_16x16x128_f8f6f4 %0, %1, %2, %0, %3, %4 op_sel_hi:[0,0,0]" : "+v"(acc[ai][bj][m][n]) : "v"(PG8_CAT(Bt[n])), "v"(PG8_CAT(At[m])), "v"(sc_w), "v"(sc_x)); } \
        else { _Pragma("unroll") for (int m = 0; m < 4; ++m) _Pragma("unroll") for (int n = 0; n < 2; ++n) _Pragma("unroll") for (int k = 0; k < 2; ++k) \
            acc[ai][bj][m][n] = __builtin_amdgcn_mfma_f32_16x16x32_f16(Bt[n][k], At[m][k], acc[ai][bj][m][n], 0, 0, 0); } \
        __builtin_amdgcn_s_setprio(0); } while (0)
#define PG8_WAIT_V(n) asm volatile("s_waitcnt vmcnt(" #n ")" ::: "memory")
#define PG8_WAIT_L(n) asm volatile("s_waitcnt lgkmcnt(" #n ")" ::: "memory")
#define PG8_BAR __builtin_amdgcn_s_barrier()
#define PG8_SCHED __builtin_amdgcn_sched_barrier(0)
    Unit cur, nxt; int ui = 0;
    if (!S.next(0, cur)) return;
    const int sc_w = g.scale_w, sc_x = g.scale_x;
    Acc acc;
#pragma unroll
    for (int a = 0; a < 2; ++a)
#pragma unroll
        for (int b = 0; b < 2; ++b)
#pragma unroll
            for (int m = 0; m < 4; ++m)
#pragma unroll
                for (int n = 0; n < 2; ++n) acc[a][b][m][n] = (f32x4){0.f, 0.f, 0.f, 0.f};
    h16x8 At[4][2], B0[2][2], B1[2][2];
    const char* cA = (const char*)g.A + (size_t)cur.pm * tstep; const char* cB = (const char*)g.Bt + (size_t)cur.pn * tstep;
    PG8_STAGE(PG8_SB(0, 0), cB, voffB); PG8_STAGE(PG8_SB(0, 1), cB + hstep, voffB); PG8_STAGE(PG8_SA(0, 0), cA, voffA); PG8_STAGE(PG8_SA(0, 1), cA + hstep, voffA);
    if (wr == 1) PG8_BAR;
    PG8_WAIT_V(2); PG8_BAR;
    PG8_STAGE(PG8_SB(1, 0), cB + kstep, voffB); PG8_STAGE(PG8_SA(1, 0), cA + kstep, voffA); PG8_STAGE(PG8_SB(1, 1), cB + hstep + kstep, voffB);
    PG8_WAIT_V(6); PG8_BAR;
    for (;;) {
        const bool has_next = S.next(ui + 1, nxt);
        const char* nA = has_next ? (const char*)g.A + (size_t)nxt.pm * tstep : cA; const char* nB = has_next ? (const char*)g.Bt + (size_t)nxt.pn * tstep : cB;
        for (int t = 0; t < nt; t += 2) {
            const bool last = (t == nt - 2);
            if (t == 0) E.prefetch(cur, wid, lane, xlds);
            const char* a1 = cA + (size_t)(t + 1) * kstep;
            const char* a2 = last ? nA : cA + (size_t)(t + 2) * kstep; const char* b2 = last ? nB : cB + (size_t)(t + 2) * kstep;
            const char* a3 = a2 + kstep; const char* b3 = b2 + kstep;
            PG8_LDB(B0, 0, 0); PG8_LDB(B1, 0, 1); PG8_SCHED; PG8_LDA(At, 0, 0); PG8_STAGE(PG8_SA(1, 1), a1 + hstep, voffA);
            PG8_WAIT_V(8); PG8_WAIT_L(0); PG8_BAR; PG8_MMA(0, 0, At, B0); PG8_MMA(0, 1, At, B1); PG8_BAR; PG8_SCHED;
            PG8_LDA(At, 0, 1); PG8_STAGE(PG8_SB(0, 0), b2, voffB); PG8_STAGE(PG8_SB(0, 1), b2 + hstep, voffB); PG8_STAGE(PG8_SA(0, 0), a2, voffA);
            PG8_WAIT_V(8); PG8_WAIT_L(0); PG8_BAR; PG8_MMA(1, 0, At, B0); PG8_MMA(1, 1, At, B1); PG8_BAR; PG8_SCHED;
            PG8_LDB(B0, 1, 0); PG8_LDB(B1, 1, 1); PG8_SCHED; PG8_LDA(At, 1, 0); PG8_STAGE(PG8_SA(0, 1), a2 + hstep, voffA);
            PG8_WAIT_V(8); PG8_WAIT_L(0); PG8_BAR; PG8_MMA(0, 0, At, B0); PG8_MMA(0, 1, At, B1); PG8_BAR; PG8_SCHED;
            PG8_LDA(At, 1, 1); PG8_STAGE(PG8_SB(1, 0), b3, voffB); PG8_STAGE(PG8_SB(1, 1), b3 + hstep, voffB); PG8_STAGE(PG8_SA(1, 0), a3, voffA);
            PG8_WAIT_V(8); PG8_WAIT_L(0); PG8_BAR; PG8_MMA(1, 0, At, B0); PG8_MMA(1, 1, At, B1); PG8_BAR; PG8_SCHED;
        }
        if (wr == 0) PG8_BAR;
        if constexpr (F8) asm volatile("s_nop 15\n\ts_nop 15" ::: "memory");
        E(acc, cur, wr, wc, fr, fq, xlds);
#ifdef PROBE_EPI2
        if constexpr (Epi::IDEMPOTENT) { asm volatile("s_waitcnt vmcnt(8) lgkmcnt(0)" ::: "memory"); __builtin_amdgcn_s_barrier(); E(acc, cur, wr, wc, fr, fq, xlds); }
#endif
        if (!has_next) break;
#pragma unroll
        for (int a = 0; a < 2; ++a)
#pragma unroll
            for (int b = 0; b < 2; ++b)
#pragma unroll
                for (int m = 0; m < 4; ++m)
#pragma unroll
                    for (int n = 0; n < 2; ++n) acc[a][b][m][n] = (f32x4){0.f, 0.f, 0.f, 0.f};
        cur = nxt; cA = nA; cB = nB; ++ui;
        if (wr == 1) PG8_BAR;
    }
    PG8_WAIT_V(0);
    PG8_BAR;
#undef PG8_SA
#undef PG8_SB
#undef PG8_STAGE
#undef PG8_LDA
#undef PG8_LDB
#undef PG8_MMA
#undef PG8_CAT
#undef PG8_WAIT_V
#undef PG8_WAIT_L
#undef PG8_BAR
#undef PG8_SCHED
}
}

__device__ __forceinline__ void p5b_fixup(const Ptrs& P, int gtid, int nthreads) {
    const float* HALO = (const float*)(P.ws + WS_HALO); const float* FIXP = (const float*)(P.ws + WS_FIXP); const float* FIXU = (const float*)(P.ws + WS_FIXU); h16* ACT = (h16*)(P.ws + WS_ACT);
    for (int e = gtid; e < 64 * 2 * (FF / 4); e += nthreads) {
        const int c = (e % (FF / 4)) * 4, i = (e / (FF / 4)) & 1, pm = e / (2 * (FF / 4));
        if ((pm & 15) == 0) continue;
        const f32x4 p = *(const f32x4*)(FIXP + (size_t)(pm * 2 + i) * FF + c), uu = *(const f32x4*)(FIXU + (size_t)(pm * 2 + i) * FF + c);
        const f32x4 h0 = *(const f32x4*)(HALO + (size_t)((pm - 1) * 2 + 0) * FF + c), h1 = *(const f32x4*)(HALO + (size_t)((pm - 1) * 2 + 1) * FF + c);
        const f32x4 w0 = *(const f32x4*)(P.conv_w + c), w1 = *(const f32x4*)(P.conv_w + FF + c);
        f32x4 pre;
        if (i == 0) pre = p + w0 * h0 + w1 * h1; else pre = p + w0 * h1;
#if F8FFN
        *(unsigned*)((unsigned char*)ACT + (size_t)(pm * 256 + i) * FF + c) = pk4f8(gelu_tanh(pre[0]) * uu[0] * F8_ACT_SCALE, gelu_tanh(pre[1]) * uu[1] * F8_ACT_SCALE, gelu_tanh(pre[2]) * uu[2] * F8_ACT_SCALE, gelu_tanh(pre[3]) * uu[3] * F8_ACT_SCALE);
#else
        const unsigned lo = pk2h(gelu_tanh(pre[0]) * uu[0], gelu_tanh(pre[1]) * uu[1]), hi = pk2h(gelu_tanh(pre[2]) * uu[2], gelu_tanh(pre[3]) * uu[3]);
        *(unsigned long long*)(ACT + (size_t)(pm * 256 + i) * FF + c) = (unsigned long long)lo | ((unsigned long long)hi << 32);
#endif
    }
}


#define XB_TMO      128
#define XB_XCNT(j)  (256  + 64 * (j))
#define XB_XSUB(j)  (1280 + 64 * (j))
#define XB_XGEN(j)  (2304 + 64 * (j))
#define XB_TOP      3328
#define XB_TOPGEN   3392
#define XCD_BAR_WORDS 3456
#define XB_SPIN_CAP (1u << 18)
__device__ __forceinline__ unsigned xb_ld(unsigned* p)              { return __hip_atomic_load(p, __ATOMIC_RELAXED, __HIP_MEMORY_SCOPE_AGENT); }
__device__ __forceinline__ unsigned xb_add(unsigned* p, unsigned v) { return __hip_atomic_fetch_add(p, v, __ATOMIC_RELAXED, __HIP_MEMORY_SCOPE_AGENT); }
__device__ __forceinline__ unsigned xb_xcc_id() { return (unsigned)__builtin_amdgcn_s_getreg((3 << 11) | 20) & 0xFu; }
#define XB_SPIN(cond, bar) do { unsigned _sp = 0; while (cond) { __builtin_amdgcn_s_sleep(1); \
    if ((++_sp & 255u) == 0u) { if (xb_ld(&(bar)[XB_TMO])) break; if (_sp > XB_SPIN_CAP) { atomicAdd(&(bar)[XB_TMO], 1u); break; } } } } while (0)
struct XcdBarrier { unsigned* bar; unsigned x; volatile LAS unsigned* st; };
__device__ __forceinline__ XcdBarrier xcd_barrier_post(unsigned* bar, volatile LAS unsigned* st) {
    XcdBarrier b; b.bar = bar; b.x = xb_xcc_id(); b.st = st;
    if (threadIdx.x == 0) (void)xb_add(&bar[XB_XCNT(b.x)], 1u);
    return b;
}
__device__ __forceinline__ void xcd_barrier_complete(unsigned* bar, unsigned x, unsigned& nloc, unsigned& nx) {
    const unsigned G = gridDim.x * gridDim.y * gridDim.z;
    unsigned sum, cnt, mine, sp = 0u;
    for (;;) {
        sum = 0u; cnt = 0u; mine = 0u;
#pragma unroll
        for (unsigned j = 0; j < 16; ++j) { const unsigned c = xb_ld(&bar[XB_XCNT(j)]); sum += c; cnt += (c > 0u) ? 1u : 0u; mine = (j == x) ? c : mine; }
        if (sum == G) break;
        __builtin_amdgcn_s_sleep(1);
        if ((++sp & 255u) == 0u) { if (xb_ld(&bar[XB_TMO])) break; if (sp > XB_SPIN_CAP) { atomicAdd(&bar[XB_TMO], 1u); break; } }
    }
    nloc = mine > 0u ? mine : 1u; nx = cnt > 0u ? cnt : 1u;
}
__device__ __forceinline__ void xcd_barrier(const XcdBarrier& b) {
    asm volatile("s_waitcnt vmcnt(0)" ::: "memory");
    __syncthreads();
    if (threadIdx.x == 0) {
        unsigned* bar = b.bar;
        __builtin_amdgcn_s_waitcnt(0);
        unsigned nloc = b.st[0], nx = b.st[1];
        if (nloc == 0u) { xcd_barrier_complete(bar, b.x, nloc, nx); b.st[0] = nloc; b.st[1] = nx; }
        const unsigned old = xb_add(&bar[XB_XSUB(b.x)], 1u);
        const unsigned gen = old / nloc;
        if (old + 1u == (gen + 1u) * nloc) {
            __builtin_amdgcn_fence(__ATOMIC_RELEASE, "agent");
            asm volatile("s_waitcnt vmcnt(0)" ::: "memory");
            const unsigned og = xb_add(&bar[XB_TOP], 1u);
            const unsigned tg = og / nx;
            if (og + 1u == (tg + 1u) * nx) xb_add(&bar[XB_TOPGEN], 1u);
            else XB_SPIN(xb_ld(&bar[XB_TOPGEN]) == tg, bar);
            __builtin_amdgcn_fence(__ATOMIC_ACQUIRE, "agent");
            xb_add(&bar[XB_XGEN(b.x)], 1u);
            asm volatile("s_waitcnt vmcnt(0)" ::: "memory");
        } else {
            XB_SPIN(xb_ld(&bar[XB_XGEN(b.x)]) == gen, bar);
            __builtin_amdgcn_fence(__ATOMIC_ACQUIRE, "agent");
            asm volatile("s_waitcnt vmcnt(0)" ::: "memory");
        }
    }
    __syncthreads();
}

#ifndef PROBE_MASK
#define PROBE_MASK 0
#endif
namespace att {
constexpr int NW = 8, QBLK = 32, KVBLK = 64, QB = NW * QBLK;
constexpr int SHM_V = KVBLK * HD * 2, SHM_K = KVBLK * HD * 2;
constexpr int LDS_BYTES = 2 * SHM_V + 2 * SHM_K + NW * 64 * 4;
constexpr float THR = 8.f;
typedef short s16x4 __attribute__((ext_vector_type(4)));
typedef short s16x8 __attribute__((ext_vector_type(8)));
typedef float f32x16 __attribute__((ext_vector_type(16)));
#define KSWZ(row, colB) ((row) * 256 + ((colB) ^ (((row) & 7) << 4)))
#define SBAR() __builtin_amdgcn_sched_barrier(0)
__device__ __forceinline__ int v_st(int k, int c) { const int kk = (k & ~0xC) | ((k & 4) << 1) | ((k & 8) >> 1); return ((kk >> 3) * 4 + (c >> 5)) * 512 + ((kk & 7) * 32 + (c & 31)) * 2; }
__device__ __forceinline__ int v_rd_base(int lane) { return ((lane & 3) << 3) | (((lane >> 2) & 3) << 6) | (((lane >> 4) & 1) << 5) | (((lane >> 5) & 1) << 8); }
constexpr int v_rd_off(int d0, int ks, int half) { return d0 * 512 + ks * 4096 + half * 2048; }
__device__ __forceinline__ int crow(int r, int hi) { return (r & 3) + 8 * (r >> 2) + 4 * hi; }
__device__ __forceinline__ h16x8 load8(const h16* p) { return *reinterpret_cast<const h16x8*>(p); }
__device__ __forceinline__ void mask_tile(f32x16& p0, f32x16& p1, int dq, unsigned W) {
    const float NEG = -__builtin_inff();
#pragma unroll
    for (int r = 0; r < 16; ++r) {
        const int c = (r & 3) + 8 * (r >> 2);
        if ((unsigned)(dq - c) >= W) p0[r] = NEG;
        if ((unsigned)(dq - c - 32) >= W) p1[r] = NEG;
    }
}
__device__ __forceinline__ void kill_tile(f32x16& p0, f32x16& p1, bool dead) {
    const float NEG = -__builtin_inff();
#pragma unroll
    for (int r = 0; r < 16; ++r) { p0[r] = dead ? NEG : p0[r]; p1[r] = dead ? NEG : p1[r]; }
}
__device__ __forceinline__ void partialSM(f32x16& p0, f32x16& p1, float& m_reg, float& mn, float& alpha) {
    float pmax = p0[0];
#pragma unroll
    for (int r = 1; r < 16; ++r) pmax = fmaxf(pmax, p0[r]);
#pragma unroll
    for (int r = 0; r < 16; ++r) pmax = fmaxf(pmax, p1[r]);
    { auto rr = __builtin_amdgcn_permlane32_swap(__float_as_uint(pmax), __float_as_uint(pmax), false, false);
      pmax = fmaxf(__uint_as_float(rr[0]), __uint_as_float(rr[1])); }
    constexpr float C2 = 1.4426950408889634f * SCALE;
    if (__builtin_expect(__all((pmax - m_reg) * SCALE <= THR), 1)) { mn = m_reg; alpha = 1.f; }
    else { mn = fmaxf(m_reg, pmax); alpha = __builtin_amdgcn_exp2f((m_reg - mn) * C2); m_reg = mn; }
    const float mnL = -mn * C2;
#pragma unroll
    for (int r = 0; r < 16; ++r) p0[r] = fmaf(p0[r], C2, mnL);
#pragma unroll
    for (int r = 0; r < 16; ++r) p1[r] = fmaf(p1[r], C2, mnL);
#pragma unroll
    for (int r = 0; r < 16; ++r) p0[r] = __builtin_amdgcn_exp2f(p0[r]);
}
__device__ __forceinline__ void finishSM(f32x16& p0, f32x16& p1, float alpha, float& l_reg, h16x8& pa0, h16x8& pa1, h16x8& pa2, h16x8& pa3) {
#pragma unroll
    for (int r = 0; r < 16; ++r) p1[r] = __builtin_amdgcn_exp2f(p1[r]);
    float ps = 0;
#pragma unroll
    for (int r = 0; r < 16; ++r) ps += p0[r];
#pragma unroll
    for (int r = 0; r < 16; ++r) ps += p1[r];
    { auto rr = __builtin_amdgcn_permlane32_swap(__float_as_uint(ps), __float_as_uint(ps), false, false);
      ps = __uint_as_float(rr[0]) + __uint_as_float(rr[1]); }
    l_reg = l_reg * alpha + ps;
#define PK4(P, B_, OUT) do { unsigned a0 = pk2h(P[B_+0], P[B_+1]), a1 = pk2h(P[B_+2], P[B_+3]);                          \
        unsigned b0 = pk2h(P[B_+4], P[B_+5]), b1 = pk2h(P[B_+6], P[B_+7]);                                             \
        auto r0 = __builtin_amdgcn_permlane32_swap(a0, b0, false, false); auto r1 = __builtin_amdgcn_permlane32_swap(a1, b1, false, false); \
        u32x4 w = {r0[0], r1[0], r0[1], r1[1]}; OUT = __builtin_bit_cast(h16x8, w); } while (0)
    PK4(p0, 0, pa0); PK4(p0, 8, pa1); PK4(p1, 0, pa2); PK4(p1, 8, pa3);
#undef PK4
}
template <int KB>
__device__ __forceinline__ void qkt(f32x16& p0, f32x16& p1, const char* K_lds, int r32, int hi, const h16x8* qr, bool act) {
    if (!act) { const float NEG = -__builtin_inff();
#pragma unroll
        for (int r = 0; r < 16; ++r) { p0[r] = NEG; p1[r] = NEG; } return; }
    p0 = f32x16{}; p1 = f32x16{};
    const char* kb[4];
#pragma unroll
    for (int dd = 0; dd < 4; ++dd) kb[dd] = K_lds + KB * SHM_K + KSWZ(r32, (dd * 16 + hi * 8) * 2);
#pragma unroll
    for (int d0 = 0; d0 < 8; ++d0) { const char* a = kb[d0 & 3] + (d0 >> 2) * 128;
        h16x8 b0 = *reinterpret_cast<const h16x8*>(a);
        h16x8 b1 = *reinterpret_cast<const h16x8*>(a + 32 * 256);
        p0 = __builtin_amdgcn_mfma_f32_32x32x16_f16(b0, qr[d0], p0, 0, 0, 0);
        p1 = __builtin_amdgcn_mfma_f32_32x32x16_f16(b1, qr[d0], p1, 0, 0, 0); }
}
template <int VB>
__device__ __forceinline__ void pv_tile(f32x16* o, int vb0, h16x8 pa0, h16x8 pa1, h16x8 pa2, h16x8 pa3, bool act) {
    if (!act) return;
#define TRRD(dst, off) asm volatile("ds_read_b64_tr_b16 %0, %1 offset:%2" : "=&v"(dst) : "v"(vb0), "i"(off) : "memory")
#define MKB(l, h) __builtin_bit_cast(h16x8, (s16x8){l[0], l[1], l[2], l[3], h[0], h[1], h[2], h[3]})
#define PV_D0(d0) do { s16x4 l0, l1, l2, l3, h0, h1, h2, h3; constexpr int b_ = VB * SHM_V + v_rd_off(d0, 0, 0); \
        TRRD(l0, b_); TRRD(h0, b_ + 2048); TRRD(l1, b_ + 4096); TRRD(h1, b_ + 6144); TRRD(l2, b_ + 8192); TRRD(h2, b_ + 10240); TRRD(l3, b_ + 12288); TRRD(h3, b_ + 14336); \
        asm volatile("s_waitcnt lgkmcnt(0)" ::: "memory"); SBAR();   \
        o[d0] = __builtin_amdgcn_mfma_f32_32x32x16_f16(pa0, MKB(l0, h0), o[d0], 0, 0, 0);   \
        o[d0] = __builtin_amdgcn_mfma_f32_32x32x16_f16(pa1, MKB(l1, h1), o[d0], 0, 0, 0);   \
        o[d0] = __builtin_amdgcn_mfma_f32_32x32x16_f16(pa2, MKB(l2, h2), o[d0], 0, 0, 0);   \
        o[d0] = __builtin_amdgcn_mfma_f32_32x32x16_f16(pa3, MKB(l3, h3), o[d0], 0, 0, 0); } while (0)
    PV_D0(0); PV_D0(1); PV_D0(2); PV_D0(3);
#undef PV_D0
#undef MKB
#undef TRRD
}

struct BlockRef { const h16* K; h16* Ob; float* LSE; const float* KS; int P0, pitch, opitch, W, lsestride, moba; };
struct Seam { h16x8 qr[8]; h16x8 st_v0, st_v1, st_k0, st_k1; };
__device__ __forceinline__ int swa_jlo(int P0, int W) { const int lowk = P0 - W + 1; return lowk > 0 ? lowk / KVBLK : 0; }
#define VMW() asm volatile("s_waitcnt vmcnt(0)" ::: "memory")
#define VMWN(n) asm volatile("s_waitcnt vmcnt(%0)" :: "i"(n) : "memory")
#define SLOAD_H(Kt, o0, o1) do { S.st_v0 = load8((Kt) + 1024 + (o0)); S.st_v1 = load8((Kt) + 1024 + (o1));              \
                         S.st_k0 = load8((Kt) + (o0)); S.st_k1 = load8((Kt) + (o1)); } while (0)
#define SWRITE_HK(bf) do { *(h16x8*)(K_lds + (bf) * SHM_K + kws) = S.st_k0; *(h16x8*)(K_lds + (bf) * SHM_K + kws + 32 * 256) = S.st_k1; } while (0)
#define SWRITE_HV(bf) do { *(h16x8*)(V_lds + (bf) * SHM_V + vst0) = S.st_v0; *(h16x8*)(V_lds + (bf) * SHM_V + vst1) = S.st_v1; } while (0)
#define SWRITE_H(bf) do { SWRITE_HV(bf); SWRITE_HK(bf); } while (0)
__device__ __forceinline__ void attn_prime(const BlockRef& cur, char* lds, Seam& S) {
    const int tid = threadIdx.x, wid = __builtin_amdgcn_readfirstlane(tid >> 6), lane = tid & 63, r32 = lane & 31, hi = lane >> 5;
    const int sr = tid >> 4, sc = (tid & 15) * 8, kws = KSWZ(sr, sc * 2); char* K_lds = lds + 2 * SHM_V;
    const int kb0 = swa_jlo(cur.P0, cur.W) * KVBLK;
    const h16* Qw = cur.K - 1024 + (size_t)(cur.P0 + wid * QBLK) * cur.pitch;
    const unsigned qo = (unsigned)(r32 * cur.pitch + hi * 8);
#pragma unroll
    for (int d0 = 0; d0 < 8; ++d0) S.qr[d0] = load8(Qw + qo + d0 * 16);
    { const unsigned o0 = (unsigned)(sr * cur.pitch + sc), o1 = o0 + 32u * (unsigned)cur.pitch; const h16* Kt = cur.K + (size_t)kb0 * cur.pitch;
      SLOAD_H(Kt, o0, o1); } VMW(); SWRITE_HK(0);
    __syncthreads();
}
__device__ __forceinline__ void attn_block(const BlockRef& cur, const BlockRef& nxt, char* lds, Seam& S) {
    const int tid = threadIdx.x, wid = __builtin_amdgcn_readfirstlane(tid >> 6), lane = tid & 63, r32 = lane & 31, hi = lane >> 5;
    const int W = cur.W;
    const int j_lo = swa_jlo(cur.P0, W);
    const int j_hi = (cur.P0 + QB - 1) / KVBLK + 1;
    const int NT = j_hi - j_lo;
    const int kbn = swa_jlo(nxt.P0, nxt.W) * KVBLK;
    const int qlo = cur.P0 + wid * QBLK, qm = qlo + r32 - 4 * hi;
    char* V_lds = lds; char* K_lds = lds + 2 * SHM_V;
    float* ws = (float*)(lds + 2 * SHM_V + 2 * SHM_K) + wid * 64; float* li_l = ws, * al_l = ws + 32;
    float m_reg = -1e30f, l_reg = 0; f32x16 o[4] = {};
    const int sr = tid >> 4, sc = (tid & 15) * 8, vst0 = v_st(sr, sc), vst1 = v_st(32 + sr, sc), kws = KSWZ(sr, sc * 2);
    const int vb0 = (int)(uintptr_t)V_lds + v_rd_base(lane);
    const h16* Kh = cur.K; const int pitch = cur.pitch;
    const unsigned so0 = (unsigned)(sr * pitch + sc), so1 = so0 + 32u * (unsigned)pitch;
#define KTILE(t) (Kh + (size_t)KBASE(t) * pitch)
    unsigned selmask = 0xffffffffu;
    if (cur.moba) {
        const int qblk = cur.P0 >> 8;
        f32x16 gacc = f32x16{};
#pragma unroll
        for (int d0 = 0; d0 < 8; ++d0) {
            f32x4 a0 = {0.f, 0.f, 0.f, 0.f}, a1 = a0;
            if (r32 < qblk) { const float* kp = cur.KS + (size_t)(r32 * 2) * 1024 + d0 * 16 + hi * 8;
                a0 = *(const f32x4*)kp + *(const f32x4*)(kp + 1024); a1 = *(const f32x4*)(kp + 4) + *(const f32x4*)(kp + 1024 + 4); }
            a0 = a0 * (1.0f / 256.0f); a1 = a1 * (1.0f / 256.0f);
            u32x4 w = {pk2h(a0[0], a0[1]), pk2h(a0[2], a0[3]), pk2h(a1[0], a1[1]), pk2h(a1[2], a1[3])};
            gacc = __builtin_amdgcn_mfma_f32_32x32x16_f16(__builtin_bit_cast(h16x8, w), S.qr[d0], gacc, 0, 0, 0);
        }
        float gb[16];
#pragma unroll
        for (int j = 0; j < 16; ++j) { const int rj = (j & 3) + 4 * (j >> 3); const float own = gacc[rj]; const float oth = __shfl_xor(own, 32);
            gb[j] = (hi == ((j >> 2) & 1)) ? own : oth; }
        unsigned sel = 0u;
#pragma unroll
        for (int rnd = 0; rnd < 3; ++rnd) { float best = -3.0e38f; int bi = -1;
#pragma unroll
            for (int j = 0; j < 15; ++j) { const bool ok = (j < qblk) && !((sel >> j) & 1u) && (gb[j] > best); best = ok ? gb[j] : best; bi = ok ? j : bi; }
            if (bi >= 0) sel |= 1u << bi; }
        selmask = sel | (1u << qblk);
    }
#define RESC(a) do { if (__any((a) < 1.f)) { if (hi == 0) al_l[r32] = (a); asm volatile("s_waitcnt lgkmcnt(0)" ::: "memory");              \
                     _Pragma("unroll") for (int d_ = 0; d_ < 4; ++d_) _Pragma("unroll") for (int r = 0; r < 16; ++r) o[d_][r] *= al_l[crow(r, hi)]; } } while (0)
#define KBASE(t) ((j_lo + (t)) * KVBLK)
#define SELB(t) (((selmask >> (KBASE(t) >> 8)) & 1u) != 0u)
#define ACT(t) (KBASE(t) <= qlo + QBLK - 1 && KBASE(t) + KVBLK - 1 >= qlo - W + 1 && (!cur.moba || __any(SELB(t))))
#define MASKT(P0_, P1_, t) do { const int kb_ = KBASE(t); if (ACT(t)) { if (kb_ + KVBLK - 1 > qlo || kb_ <= qlo + QBLK - 1 - W) mask_tile(P0_, P1_, qm - kb_, (unsigned)W); \
                                 if (cur.moba && !__all(SELB(t))) kill_tile(P0_, P1_, !SELB(t)); } } while (0)
    constexpr int NQL = 8;
#define SEAM_K0() do { VMWN(NQL); SWRITE_HK(0); SBAR(); } while (0)
    f32x16 pA0, pA1, pB0, pB1; float mnA, mnB, alA, alB; h16x8 pa0, pa1, pa2, pa3;
    SWRITE_HV(0); SBAR();
    if (NT > 1) { SLOAD_H(KTILE(1), so0, so1); }
    SBAR(); qkt<0>(pA0, pA1, K_lds, r32, hi, S.qr, ACT(0));
    MASKT(pA0, pA1, 0); partialSM(pA0, pA1, m_reg, mnA, alA);
    if (NT > 1) { VMW(); SWRITE_H(1); }
    __syncthreads();
#define HALF_STEP(PX0, PX1, mnX, alX, PY0, PY1, alY, t, KB, VB, SB) do {                                                      \
        SBAR(); qkt<KB>(PX0, PX1, K_lds, r32, hi, S.qr, ACT(t));                                             \
        finishSM(PY0, PY1, alY, l_reg, pa0, pa1, pa2, pa3); SBAR();                                                           \
        if ((t) + 1 < NT) { SLOAD_H(KTILE((t) + 1), so0, so1); SBAR(); }                                               \
        pv_tile<VB>(o, vb0, pa0, pa1, pa2, pa3, ACT((t) - 1)); MASKT(PX0, PX1, (t)); partialSM(PX0, PX1, m_reg, mnX, alX);                                        \
        __syncthreads();                                                                                                      \
        if ((t) + 1 < NT) { VMW(); SWRITE_H(SB); }                                                                          \
        RESC(alX); __syncthreads(); } while (0)
    for (int t = 1; t + 1 < NT; t += 2) {
        HALF_STEP(pB0, pB1, mnB, alB, pA0, pA1, alA, t, 1, 0, 0);
        HALF_STEP(pA0, pA1, mnA, alA, pB0, pB1, alB, t + 1, 0, 1, 1);
    }
    const bool even = (NT & 1) == 0;
    if (even) { SBAR(); qkt<1>(pB0, pB1, K_lds, r32, hi, S.qr, ACT(NT - 1)); SBAR(); }
    { const unsigned n0 = (unsigned)(sr * nxt.pitch + sc), n1 = n0 + 32u * (unsigned)nxt.pitch; const h16* Kt = nxt.K + (size_t)kbn * nxt.pitch;
      SLOAD_H(Kt, n0, n1); SBAR();
      const h16* Qw = nxt.K - 1024 + (size_t)(nxt.P0 + wid * QBLK) * nxt.pitch; const unsigned qo = (unsigned)(r32 * nxt.pitch + hi * 8);
#pragma unroll
      for (int d0 = 0; d0 < 8; ++d0) S.qr[d0] = load8(Qw + qo + d0 * 16); }
    SBAR();
    finishSM(pA0, pA1, alA, l_reg, pa0, pa1, pa2, pa3); SBAR();
    pv_tile<0>(o, vb0, pa0, pa1, pa2, pa3, ACT(even ? NT - 2 : NT - 1));
    if (even) { MASKT(pB0, pB1, NT - 1); partialSM(pB0, pB1, m_reg, mnB, alB); __syncthreads(); RESC(alB);
        finishSM(pB0, pB1, alB, l_reg, pa0, pa1, pa2, pa3); SBAR(); pv_tile<1>(o, vb0, pa0, pa1, pa2, pa3, ACT(NT - 1)); }
    SBAR(); SEAM_K0();
    if (hi == 0) { li_l[r32] = l_reg; if (cur.LSE) cur.LSE[(size_t)(wid * QBLK + r32) * cur.lsestride] = m_reg * SCALE + __logf(l_reg); }
    asm volatile("s_waitcnt lgkmcnt(0)" ::: "memory");
    float rli[16];
#pragma unroll
    for (int r = 0; r < 16; ++r) rli[r] = __builtin_amdgcn_rcpf(li_l[crow(r, hi)]);
    h16* Ow = cur.Ob + (size_t)(cur.P0 + wid * QBLK) * cur.opitch;
    const unsigned olane = (unsigned)(4 * hi * cur.opitch + r32);
#pragma unroll
    for (int r = 0; r < 16; ++r) { h16* rp = Ow + (size_t)(((r & 3) + 8 * (r >> 2)) * cur.opitch);
#pragma unroll
        for (int d0 = 0; d0 < 4; ++d0) { const float v = o[d0][r] * rli[r];
            const float vn = __shfl_xor(v, 1);
            if ((r32 & 1) == 0) *(unsigned*)(rp + olane + d0 * 32) = pk2h(v, vn); } }
    __syncthreads();
#undef RESC
#undef KBASE
#undef SELB
#undef ACT
#undef MASKT
#undef SEAM_K0
#undef HALF_STEP
#undef KTILE
}
#undef ROWP
#undef VMW
#undef VMWN
#undef SLOAD_H
#undef SWRITE_HK
#undef SWRITE_HV
#undef SWRITE_H

__device__ __forceinline__ BlockRef unit_ref(int idx, unsigned char* ws) {
    const h16* QKV = (const h16*)(ws + WS_QKV);
    BlockRef R;
    if (idx < 512) { const int qb = 15 - (idx >> 5), bh = idx & 31, b = bh >> 3, h = bh & 7;
        const size_t tok0 = (size_t)b * SEQ;
        R.K = QKV + tok0 * NQKV + 1024 + h * HD;
        R.Ob = (h16*)(ws + WS_OA) + tok0 * 1024 + h * HD; R.LSE = nullptr; R.KS = (const float*)(ws + WS_KSUM) + (size_t)(b * 16 * 2) * 1024 + h * HD;
        R.P0 = qb * 256; R.pitch = NQKV; R.opitch = 1024; R.W = 1 << 30; R.lsestride = 0; R.moba = 1; }
    else { const int j = idx - 512, g = j >> 9, rem = j & 511, bh = rem & 31, sub = rem >> 5, b = bh >> 3, h = bh & 7;
        const int d = (g == 0) ? 1 : (g == 1) ? 4 : 16, nqb = 16 / d, r = sub / nqb, qb = sub % nqb;
        const size_t tok0 = (size_t)b * SEQ + r, tokq = tok0 + (size_t)d * qb * 256;
        R.K = QKV + tok0 * NQKV + 4096 + h * HD;
        h16* OBg = (h16*)(ws + (g == 0 ? WS_OB0 : g == 1 ? WS_OB1 : WS_OB2));
        R.Ob = OBg + tok0 * 1024 + h * HD; R.LSE = (float*)(ws + WS_LSE) + ((size_t)g * M + tokq) * 8 + h; R.KS = nullptr;
        R.P0 = qb * 256; R.pitch = NQKV * d; R.opitch = 1024 * d; R.W = 129; R.lsestride = 8 * d; R.moba = 0; }
    return R;
}
constexpr int NUNITS = 2048;
__device__ __forceinline__ int unit_pos(int k, int G, int w) { return (k & 1) ? (k + 1) * G - 1 - w : k * G + w; }
__device__ __forceinline__ void attn_phase(char* lds, unsigned char* ws, int G, int w) {
    int k = 0; int p = unit_pos(0, G, w); if (p >= NUNITS) return;
    BlockRef cur = unit_ref(p, ws);
    Seam S;
    attn_prime(cur, lds, S);
    for (;;) {
        const int pn = unit_pos(k + 1, G, w); const bool last = pn >= NUNITS;
        const BlockRef nxt = last ? cur : unit_ref(pn, ws);
        attn_block(cur, nxt, lds, S);
        if (last) break;
        cur = nxt; ++k;
    }
}
#undef KSWZ
#undef SBAR
}

constexpr int MK_LDS_BYTES = 147456, MK_XLDS_OFF = 131072;
struct MkArgs { Ptrs P; int ph_lo, ph_hi; };
namespace cg = cooperative_groups;
__global__ void __launch_bounds__(512, 2) mk_fwd(MkArgs a) {
    cg::grid_group grid = cg::this_grid();
    extern __shared__ __attribute__((aligned(16))) unsigned char lds_raw[];
    LAS unsigned char* lds = (LAS unsigned char*)lds_raw;
    const Ptrs& P = a.P;
    if (a.ph_lo < 0) grid.sync();
    volatile LAS unsigned* xst = (volatile LAS unsigned*)(lds + MK_XLDS_OFF + 8192);
    if (threadIdx.x < 4) xst[threadIdx.x] = 0u;
    __syncthreads();
    XcdBarrier xbar = xcd_barrier_post((unsigned*)(a.P.ws + WS_CTL), xst);

    const int tid = threadIdx.x, lane = tid & 63, wave = __builtin_amdgcn_readfirstlane(tid >> 6);
    const int G = gridDim.x, gw = blockIdx.x * 8 + wave, NGW = G * 8;
    unsigned char* ws = P.ws;
#define IN(k) (a.ph_lo <= (k) && (k) < a.ph_hi)
#if USE_CG_SYNC
#define SEAM(k) do { if (IN(k) && IN((k) + 1)) grid.sync(); } while (0)
#else
#define SEAM(k) do { if (IN(k) && IN((k) + 1)) xcd_barrier(xbar); } while (0)
#endif
#define PH(k) if (IN(k))
#define PHB() do { } while (0)
    PH(0) { PHB(); p0_prologue(P, (LAS float*)lds + wave * 64 * 33, gw, NGW, lane); }
    SEAM(0);
    PH(1) { PHB();
#if F8ATT
        { pg8::Gemm g{ws + WS_XN, ws + WS_WQKV, M, 2048, DM, 0, 0}; pg8::StaticOrder S; S.init(M, 2048, G, (int)blockIdx.x);
          pg8::EpiQKV E{(h16*)(ws + WS_QKV), (const f32x2*)(ws + WS_CS), (float*)(ws + WS_KSUM), 0};
          pg8::gemm_phase<pg8::EpiQKV, pg8::StaticOrder, false>(lds, lds + MK_XLDS_OFF, g, S, E); }
        { pg8::Gemm g{ws + WS_XN8, ws + WS_WQKV8, M, 4096, DM, 0x76767676, 0x7f7f7f7f}; pg8::StaticOrder S; S.init(M, 4096, G, (int)blockIdx.x);
          pg8::EpiQKV E{(h16*)(ws + WS_QKV), (const f32x2*)(ws + WS_CS), (float*)(ws + WS_KSUM), 8};
          pg8::gemm_phase<pg8::EpiQKV, pg8::StaticOrder, true>(lds, lds + MK_XLDS_OFF, g, S, E); }
#else
        { pg8::Gemm g{ws + WS_XN, ws + WS_WQKV, M, NQKV, DM, 0, 0}; pg8::StaticOrder S; S.init(M, NQKV, G, (int)blockIdx.x);
          pg8::EpiQKV E{(h16*)(ws + WS_QKV), (const f32x2*)(ws + WS_CS), (float*)(ws + WS_KSUM), 0};
          pg8::gemm_phase<pg8::EpiQKV, pg8::StaticOrder>(lds, lds + MK_XLDS_OFF, g, S, E); }
#endif
    }
    SEAM(1);
    PH(2) { PHB(); att::attn_phase((char*)lds_raw, ws, G, (int)blockIdx.x); }
    SEAM(2);
    PH(3) { PHB(); for (int m = gw; m < M; m += NGW) p3_row(P, m, lane); }
    SEAM(3);
    PH(4) { PHB();
#if F8ATT
        pg8::Gemm g{ws + WS_MIX, ws + WS_WO, M, DM, DM, 0x76767676, 0x7f7f7f7f}; pg8::StaticOrder S; S.init(M, DM, G, (int)blockIdx.x);
        pg8::EpiY E{(h16*)(ws + WS_Y), (float*)(ws + WS_SS)};
        pg8::gemm_phase<pg8::EpiY, pg8::StaticOrder, true>(lds, lds + MK_XLDS_OFF, g, S, E);
#else
        pg8::Gemm g{ws + WS_MIX, ws + WS_WO, M, DM, DM, 0, 0}; pg8::StaticOrder S; S.init(M, DM, G, (int)blockIdx.x);
        pg8::EpiY E{(h16*)(ws + WS_Y), (float*)(ws + WS_SS)};
        pg8::gemm_phase<pg8::EpiY, pg8::StaticOrder>(lds, lds + MK_XLDS_OFF, g, S, E);
#endif
    }
    SEAM(4);
    PH(5) { PHB(); for (int m = gw; m < M; m += NGW)
        resid_row<true>(P.x + (size_t)m * DM, (const h16*)(ws + WS_Y) + (size_t)m * DM, (const float*)(ws + WS_SS) + (size_t)m * 32, P.g_attn_post, P.g_ffn_pre,
                        P.out + (size_t)m * DM, (h16*)(ws + WS_XN2 + (size_t)m * DM * (F8FFN ? 1 : 2)), lane); }
    SEAM(5);
    PH(6) { PHB(); pg8::Gemm g{ws + WS_XN2, ws + WS_WGU, M, 2 * FF, DM, 0x76767676, 0x7f7f7f7f};   pg8::StaticOrder S; S.init(M, 2 * FF, G, (int)blockIdx.x);
        pg8::EpiGU E{(h16*)(ws + WS_ACT), P.conv_w, P.conv_b, (float*)(ws + WS_HALO), (float*)(ws + WS_FIXP), (float*)(ws + WS_FIXU)};
        pg8::gemm_phase<pg8::EpiGU, pg8::StaticOrder, (F8FFN != 0)>(lds, lds + MK_XLDS_OFF, g, S, E); }
    SEAM(6);
    PH(7) { PHB(); p5b_fixup(P, blockIdx.x * 512 + tid, G * 512); }
    SEAM(7);
    PH(8) { PHB(); pg8::Gemm g{ws + WS_ACT, ws + WS_WD, M, DM, FF, 0x75757575, 0x7c7c7c7c};   pg8::StaticOrder S; S.init(M, DM, G, (int)blockIdx.x);
        pg8::EpiY E{(h16*)(ws + WS_Y2), (float*)(ws + WS_SS)};
        pg8::gemm_phase<pg8::EpiY, pg8::StaticOrder, (F8FFN != 0)>(lds, lds + MK_XLDS_OFF, g, S, E); }
    SEAM(8);
    if (IN(9)) { for (int m = gw; m < M; m += NGW)
        resid_row<false>(P.out + (size_t)m * DM, (const h16*)(ws + WS_Y2) + (size_t)m * DM, (const float*)(ws + WS_SS) + (size_t)m * 32, P.g_ffn_post, nullptr,
                         P.out + (size_t)m * DM, nullptr, lane); }
#undef IN
#undef SEAM
#undef PH
#undef PHB
}

extern "C" void kernel_launch(void* const* d_in, const int* in_sizes, int n_in, void* d_out, int out_size, void* d_ws, size_t ws_size, hipStream_t stream) {
    if (n_in != 15 || ws_size < WS_END) { fprintf(stderr, "kernel_launch: unexpected n_in %d or ws_size %zu (need %zu)\n", n_in, ws_size, (size_t)WS_END); return; }
    static int grid = 0;
    if (grid == 0) {
        int dev = 0, cus = 0, per_cu = 0;
        (void)hipGetDevice(&dev); (void)hipDeviceGetAttribute(&cus, hipDeviceAttributeMultiprocessorCount, dev);
        (void)hipFuncSetAttribute((const void*)mk_fwd, hipFuncAttributeMaxDynamicSharedMemorySize, MK_LDS_BYTES);
        (void)hipOccupancyMaxActiveBlocksPerMultiprocessor(&per_cu, (const void*)mk_fwd, 512, MK_LDS_BYTES);
        if (per_cu < 1) per_cu = 1;
        grid = cus * per_cu;
        fprintf(stderr, "kernel_launch: cus %d per_cu %d grid %d\n", cus, per_cu, grid);
    }
    Ptrs P{};
    P.x = (const float*)d_in[0]; P.pos = (const int*)d_in[1]; P.g_attn_pre = (const float*)d_in[2]; P.w_qkv = (const float*)d_in[3]; P.g_moba = (const float*)d_in[4];
    P.g_dil = (const float*)d_in[5]; P.w_o = (const float*)d_in[6]; P.g_attn_post = (const float*)d_in[7]; P.g_ffn_pre = (const float*)d_in[8]; P.w_gate = (const float*)d_in[9];
    P.w_up = (const float*)d_in[10]; P.conv_w = (const float*)d_in[11]; P.conv_b = (const float*)d_in[12]; P.w_down = (const float*)d_in[13]; P.g_ffn_post = (const float*)d_in[14];
    P.out = (float*)d_out; P.ws = (unsigned char*)d_ws;
    unsigned char* ws = P.ws;
    MkArgs a{}; a.P = P;
    (void)hipMemsetAsync((char*)d_ws + WS_CTL, 0, 16384, stream);
#if ONE_LAUNCH
    a.ph_lo = 0; a.ph_hi = 10;
    { void* kargs[] = {&a};
      hipError_t e = hipLaunchCooperativeKernel((const void*)mk_fwd, dim3(grid), dim3(512), kargs, MK_LDS_BYTES, stream);
      if (e != hipSuccess) fprintf(stderr, "kernel_launch: cooperative launch failed: %s (grid %d)\n", hipGetErrorString(e), grid); }
    return;
#endif
#define MK(lo, hi) do { a.ph_lo = (lo); a.ph_hi = (hi); for (int rr_ = 0; rr_ < 1 + ((PROBE_MASK >> (lo)) & 1); ++rr_) hipLaunchKernelGGL(mk_fwd, dim3(grid), dim3(512), MK_LDS_BYTES, stream, a); } while (0)
    MK(0, 1);
#if OPT_P1
    MK(1, 2);
#else
    for (int c = 0; c < 6; ++c) { float* scr = (float*)(ws + WS_NSCR1);
        nv_gemm<<<dim3(1024 / 64, M / 64), 256, 0, stream>>>((const h16*)(ws + WS_XN), DM, (const h16*)(ws + WS_WQKV) + (size_t)c * 1024 * DM, DM, scr, 1024, DM);
        nv_rope<<<(M * 1024) / 256, 256, 0, stream>>>(scr, (h16*)(ws + WS_QKV), (const f32x2*)(ws + WS_CS), c); }
    nv_ksum<<<(64 * 1024) / 256, 256, 0, stream>>>((const h16*)(ws + WS_QKV), (float*)(ws + WS_KSUM));
#endif
#if OPT_P2
    MK(2, 3);
#else
    for (int mode = 0; mode < 4; ++mode)
        nv_attn<<<4096, 256, 0, stream>>>((const h16*)(ws + WS_QKV), (const float*)(ws + WS_KSUM), (h16*)(ws + WS_OA), (h16*)(ws + WS_OB0), (h16*)(ws + WS_OB1), (h16*)(ws + WS_OB2), (float*)(ws + WS_LSE), mode);
#endif
    MK(3, 4);
#if OPT_P4
    MK(4, 5);
#else
    { float* scr = (float*)(ws + WS_NSCR4);
      nv_gemm<<<dim3(DM / 64, M / 64), 256, 0, stream>>>((const h16*)(ws + WS_MIX), DM, (const h16*)(ws + WS_WO), DM, scr, DM, DM);
      nv_cvt_ss<<<(M * 32) / 4, 256, 0, stream>>>(scr, DM, (h16*)(ws + WS_Y), 0, (float*)(ws + WS_SS)); }
#endif
    MK(5, 6);
#if OPT_P5
    MK(6, 7); MK(7, 8);
#else
    for (int c = 0; c < 32; ++c) { float* scr = (float*)(ws + WS_NSCR5);
        nv_gemm<<<dim3(512 / 64, M / 64), 256, 0, stream>>>((const h16*)(ws + WS_XN2), DM, (const h16*)(ws + WS_WGU) + (size_t)c * 512 * DM, DM, scr, 512, DM);
        nv_conv<<<(M * 256) / 256, 256, 0, stream>>>(scr, (h16*)(ws + WS_ACT), P.conv_w, P.conv_b, 2 * c); }
#endif
#if OPT_P6
    MK(8, 9);
#else
    for (int c = 0; c < 2; ++c) { float* scr = (float*)(ws + WS_NSCR6);
        nv_gemm<<<dim3(1024 / 64, M / 64), 256, 0, stream>>>((const h16*)(ws + WS_ACT), FF, (const h16*)(ws + WS_WD) + (size_t)c * 1024 * FF, FF, scr, 1024, FF);
        nv_cvt_ss<<<(M * 16) / 4, 256, 0, stream>>>(scr, 1024, (h16*)(ws + WS_Y2), c * 1024, (float*)(ws + WS_SS)); }
#endif
    MK(9, 10);
#undef MK
}
```

```cpp
#define OPT_P1 1
#define OPT_P2 1
#define OPT_P4 1
#define OPT_P5 1
#define OPT_P6 1
#define ONE_LAUNCH 1
#define USE_CG_SYNC 0
#include <hip/hip_runtime.h>
#include <hip/hip_cooperative_groups.h>
#include <cstdio>
#include <cstdint>

typedef _Float16 h16;
typedef h16 h16x8 __attribute__((ext_vector_type(8)));
typedef h16 h16x2 __attribute__((ext_vector_type(2)));
typedef float f32x4 __attribute__((ext_vector_type(4)));
typedef float f32x2 __attribute__((ext_vector_type(2)));
typedef unsigned u32x4 __attribute__((ext_vector_type(4)));
#define LAS __attribute__((address_space(3)))

constexpr int BATCH = 4, SEQ = 4096, DM = 2048, M = BATCH * SEQ, NQKV = 6144, FF = 8192, HD = 128, NH = 8;
constexpr float RMS_EPS = 1e-6f;
constexpr float SCALE = 0.08838834764831845f;
constexpr size_t MiB = 1u << 20;
constexpr size_t WS_CTL = 0, WS_CS = 1 * MiB, WS_KSUM = 3 * MiB, WS_SS = 4 * MiB, WS_LSE = 6 * MiB, WS_HALO = 8 * MiB, WS_FIXP = 12 * MiB, WS_FIXU = 16 * MiB;
constexpr size_t WS_WQKV = 24 * MiB, WS_WO = 48 * MiB, WS_WGU = 56 * MiB, WS_WD = 120 * MiB;
constexpr size_t WS_XN = 152 * MiB;
constexpr size_t WS_OB0 = 152 * MiB, WS_OB1 = 184 * MiB, WS_XN2 = 152 * MiB, WS_Y2 = 152 * MiB;
constexpr size_t WS_QKV = 216 * MiB;
constexpr size_t WS_MIX = 216 * MiB, WS_Y = 280 * MiB, WS_ACT = 216 * MiB;
constexpr size_t WS_OA = 408 * MiB, WS_OB2 = 440 * MiB;
constexpr size_t WS_WQKV8 = 32 * MiB;
constexpr size_t WS_X1H = 344 * MiB;
constexpr size_t WS_XN8 = 408 * MiB;
constexpr size_t WS_NSCR1 = 408 * MiB;
constexpr size_t WS_NSCR4 = 344 * MiB;
constexpr size_t WS_NSCR5 = 472 * MiB;
constexpr size_t WS_NSCR6 = 24 * MiB;
constexpr size_t WS_END = 512 * MiB;

struct Ptrs {
    const float* x; const int* pos; const float* g_attn_pre; const float* w_qkv; const float* g_moba; const float* g_dil; const float* w_o;
    const float* g_attn_post; const float* g_ffn_pre; const float* w_gate; const float* w_up; const float* conv_w; const float* conv_b;
    const float* w_down; const float* g_ffn_post; float* out; unsigned char* ws;
};

__device__ __forceinline__ unsigned pk2h(float lo, float hi) { f32x2 v = {lo, hi}; h16x2 b = __builtin_convertvector(v, h16x2); return __builtin_bit_cast(unsigned, b); }
__device__ __forceinline__ unsigned pk4f8(float a, float b, float c, float d) {
    a = fminf(fmaxf(a, -448.f), 448.f); b = fminf(fmaxf(b, -448.f), 448.f); c = fminf(fmaxf(c, -448.f), 448.f); d = fminf(fmaxf(d, -448.f), 448.f);
    int w = __builtin_amdgcn_cvt_pk_fp8_f32(a, b, 0, false); w = __builtin_amdgcn_cvt_pk_fp8_f32(c, d, w, true); return (unsigned)w; }
typedef unsigned u32x2 __attribute__((ext_vector_type(2)));
#ifndef F8FFN
#define F8FFN 1
#endif
#ifndef F8WO
#define F8WO 1
#endif
#ifndef F8ATT
#define F8ATT 1
#endif
constexpr float F8_WGU_SCALE = 512.f, F8_WD_SCALE = 1024.f, F8_ACT_SCALE = 8.f;
__device__ __forceinline__ float wave_sum(float v) {
#pragma unroll
    for (int o = 1; o < 64; o <<= 1) v += __shfl_xor(v, o);
    return v;
}
__device__ __forceinline__ float gelu_tanh(float x) {
    const float t = x * x;
    const float z2 = x * (1.5957691216057308f + 0.07135481627f * t);
    const float e = __builtin_amdgcn_exp2f(-z2 * 1.4426950408889634f);
    return x * __builtin_amdgcn_rcpf(1.0f + e);
}

__device__ __forceinline__ void p0_transpose_item(const float* W, int K, int N, h16* WT, int k0, int n0, int dest_row0, LAS float* scr, int lane) {
#pragma unroll 8
    for (int i = 0; i < 32; ++i) { const int kk = 2 * i + (lane >> 5); scr[kk * 33 + (lane & 31)] = W[(size_t)(k0 + kk) * N + n0 + (lane & 31)]; }
    asm volatile("s_waitcnt lgkmcnt(0)" ::: "memory");
    const int c = lane & 7;
#pragma unroll
    for (int j = 0; j < 4; ++j) { const int n = (lane >> 3) + 8 * j; const LAS float* s = scr + (8 * c) * 33 + n;
        u32x4 o; o.x = pk2h(s[0 * 33], s[1 * 33]); o.y = pk2h(s[2 * 33], s[3 * 33]); o.z = pk2h(s[4 * 33], s[5 * 33]); o.w = pk2h(s[6 * 33], s[7 * 33]);
        *(u32x4*)(WT + (size_t)(dest_row0 + n) * K + k0 + 8 * c) = o; }
    asm volatile("s_waitcnt lgkmcnt(0)" ::: "memory");
}
__device__ __forceinline__ void p0_transpose_item_f8(const float* W, int K, int N, unsigned char* WT, int k0, int n0, int dest_row0, float scale, LAS float* scr, int lane) {
#pragma unroll 8
    for (int i = 0; i < 32; ++i) { const int kk = 2 * i + (lane >> 5); scr[kk * 33 + (lane & 31)] = W[(size_t)(k0 + kk) * N + n0 + (lane & 31)]; }
    asm volatile("s_waitcnt lgkmcnt(0)" ::: "memory");
    const int c = lane & 7;
#pragma unroll
    for (int j = 0; j < 4; ++j) { const int n = (lane >> 3) + 8 * j; const LAS float* s = scr + (8 * c) * 33 + n;
        u32x2 o; o.x = pk4f8(s[0 * 33] * scale, s[1 * 33] * scale, s[2 * 33] * scale, s[3 * 33] * scale); o.y = pk4f8(s[4 * 33] * scale, s[5 * 33] * scale, s[6 * 33] * scale, s[7 * 33] * scale);
        *(u32x2*)(WT + (size_t)(dest_row0 + n) * K + k0 + 8 * c) = o; }
    asm volatile("s_waitcnt lgkmcnt(0)" ::: "memory");
}
__device__ __forceinline__ void rms_row_to_h16(const float* xrow, const float* g, h16* orow, unsigned char* orow8, int lane) {
    f32x4 v[4][2]; float s = 0.f;
#pragma unroll
    for (int j = 0; j < 4; ++j) { const int c = (lane + 64 * j) * 8; v[j][0] = *(const f32x4*)(xrow + c); v[j][1] = *(const f32x4*)(xrow + c + 4);
#pragma unroll
        for (int q = 0; q < 2; ++q) s += (v[j][q].x * v[j][q].x + v[j][q].y * v[j][q].y) + (v[j][q].z * v[j][q].z + v[j][q].w * v[j][q].w); }
    const float rstd = 1.0f / sqrtf(wave_sum(s) * (1.0f / DM) + RMS_EPS);
#pragma unroll
    for (int j = 0; j < 4; ++j) { const int c = (lane + 64 * j) * 8; const f32x4 g0 = *(const f32x4*)(g + c), g1 = *(const f32x4*)(g + c + 4);
        u32x4 o; o.x = pk2h(v[j][0].x * rstd * g0.x, v[j][0].y * rstd * g0.y); o.y = pk2h(v[j][0].z * rstd * g0.z, v[j][0].w * rstd * g0.w);
        o.z = pk2h(v[j][1].x * rstd * g1.x, v[j][1].y * rstd * g1.y); o.w = pk2h(v[j][1].z * rstd * g1.z, v[j][1].w * rstd * g1.w);
        *(u32x4*)(orow + c) = o;
        if (orow8) { u32x2 o8; o8.x = pk4f8(v[j][0].x * rstd * g0.x, v[j][0].y * rstd * g0.y, v[j][0].z * rstd * g0.z, v[j][0].w * rstd * g0.w);
            o8.y = pk4f8(v[j][1].x * rstd * g1.x, v[j][1].y * rstd * g1.y, v[j][1].z * rstd * g1.z, v[j][1].w * rstd * g1.w); *(u32x2*)(orow8 + c) = o8; } }
}
constexpr int I_QKV = (DM / 64) * (NQKV / 32), I_O = (DM / 64) * (DM / 32), I_G = (DM / 64) * (FF / 32), I_D = (FF / 64) * (DM / 32);
constexpr int P0_ITEMS = I_QKV + I_O + 2 * I_G + I_D;
__device__ __forceinline__ void p0_prologue(const Ptrs& P, LAS float* scr  , int gw, int NGW, int lane) {
    h16* WQKV = (h16*)(P.ws + WS_WQKV); h16* WO = (h16*)(P.ws + WS_WO); h16* WGU = (h16*)(P.ws + WS_WGU); h16* WD = (h16*)(P.ws + WS_WD);
    for (int it = gw; it < P0_ITEMS; it += NGW) {
        int r = it;
#if F8ATT
        if (r < I_QKV) { const int nb = NQKV / 32, kb = r / nb, n0 = (r % nb) * 32;
            if (n0 < 2048) p0_transpose_item(P.w_qkv, DM, NQKV, WQKV, kb * 64, n0, n0, scr, lane);
            else p0_transpose_item_f8(P.w_qkv, DM, NQKV, P.ws + WS_WQKV8, kb * 64, n0, n0 - 2048, F8_WGU_SCALE, scr, lane);
            continue; } r -= I_QKV;
        if (r < I_O) { const int nb = DM / 32, kb = r / nb, n0 = (r % nb) * 32;
            if (F8WO) p0_transpose_item_f8(P.w_o, DM, DM, (unsigned char*)WO, kb * 64, n0, n0, F8_WGU_SCALE, scr, lane); else p0_transpose_item(P.w_o, DM, DM, WO, kb * 64, n0, n0, scr, lane);
            continue; } r -= I_O;
#else
        if (r < I_QKV) { const int nb = NQKV / 32, kb = r / nb, n0 = (r % nb) * 32; p0_transpose_item(P.w_qkv, DM, NQKV, WQKV, kb * 64, n0, n0, scr, lane); continue; } r -= I_QKV;
        if (r < I_O) { const int nb = DM / 32, kb = r / nb, n0 = (r % nb) * 32; p0_transpose_item(P.w_o, DM, DM, WO, kb * 64, n0, n0, scr, lane); continue; } r -= I_O;
#endif
#if F8FFN
        if (r < I_G) { const int nb = FF / 32, kb = r / nb, n0 = (r % nb) * 32; p0_transpose_item_f8(P.w_gate, DM, FF, (unsigned char*)WGU, kb * 64, n0, (n0 / 128) * 256 + (n0 % 128), F8_WGU_SCALE, scr, lane); continue; } r -= I_G;
        if (r < I_G) { const int nb = FF / 32, kb = r / nb, n0 = (r % nb) * 32; p0_transpose_item_f8(P.w_up, DM, FF, (unsigned char*)WGU, kb * 64, n0, (n0 / 128) * 256 + 128 + (n0 % 128), F8_WGU_SCALE, scr, lane); continue; } r -= I_G;
        { const int nb = DM / 32, kb = r / nb, n0 = (r % nb) * 32; p0_transpose_item_f8(P.w_down, FF, DM, (unsigned char*)WD, kb * 64, n0, n0, F8_WD_SCALE, scr, lane); }
#else
        if (r < I_G) { const int nb = FF / 32, kb = r / nb, n0 = (r % nb) * 32; p0_transpose_item(P.w_gate, DM, FF, WGU, kb * 64, n0, (n0 / 128) * 256 + (n0 % 128), scr, lane); continue; } r -= I_G;
        if (r < I_G) { const int nb = FF / 32, kb = r / nb, n0 = (r % nb) * 32; p0_transpose_item(P.w_up, DM, FF, WGU, kb * 64, n0, (n0 / 128) * 256 + 128 + (n0 % 128), scr, lane); continue; } r -= I_G;
        { const int nb = DM / 32, kb = r / nb, n0 = (r % nb) * 32; p0_transpose_item(P.w_down, FF, DM, WD, kb * 64, n0, n0, scr, lane); }
#endif
    }
    h16* XN = (h16*)(P.ws + WS_XN);
    for (int m = gw; m < M; m += NGW) rms_row_to_h16(P.x + (size_t)m * DM, P.g_attn_pre, XN + (size_t)m * DM, F8ATT ? P.ws + WS_XN8 + (size_t)m * DM : nullptr, lane);
    f32x2* CS = (f32x2*)(P.ws + WS_CS);
    for (int e = gw * 64 + lane; e < M * 16; e += NGW * 64) { const int m = e >> 4, i = e & 15;
        const float inv_freq = powf(500000.0f, -(float)i / 16.0f); const float ang = (float)P.pos[m] * inv_freq;
        float sn, cs; sincosf(ang, &sn, &cs); CS[e] = (f32x2){cs, sn}; }
}

__device__ __forceinline__ void p3_row(const Ptrs& P, int m, int lane) {
    const h16* OA = (const h16*)(P.ws + WS_OA) + (size_t)m * 1024;
    const h16* OB[3] = {(const h16*)(P.ws + WS_OB0) + (size_t)m * 1024, (const h16*)(P.ws + WS_OB1) + (size_t)m * 1024, (const h16*)(P.ws + WS_OB2) + (size_t)m * 1024};
    const float* LSE = (const float*)(P.ws + WS_LSE);
    h16* MIX = (h16*)(P.ws + WS_MIX) + (size_t)m * DM; unsigned char* MIX8 = P.ws + WS_MIX + (size_t)m * DM; (void)MIX; (void)MIX8;
    {   float v[2][8]; float s = 0.f;
#pragma unroll
        for (int j = 0; j < 2; ++j) { const h16x8 a = *(const h16x8*)(OA + (lane + 64 * j) * 8);
#pragma unroll
            for (int e = 0; e < 8; ++e) { v[j][e] = (float)a[e]; s += v[j][e] * v[j][e]; } }
        const float rstd = 1.0f / sqrtf(wave_sum(s) * (1.0f / 1024.0f) + RMS_EPS);
#pragma unroll
        for (int j = 0; j < 2; ++j) { const int c = (lane + 64 * j) * 8; const f32x4 g0 = *(const f32x4*)(P.g_moba + c), g1 = *(const f32x4*)(P.g_moba + c + 4);
#if F8WO
            u32x2 o; o.x = pk4f8(v[j][0] * rstd * g0.x, v[j][1] * rstd * g0.y, v[j][2] * rstd * g0.z, v[j][3] * rstd * g0.w);
            o.y = pk4f8(v[j][4] * rstd * g1.x, v[j][5] * rstd * g1.y, v[j][6] * rstd * g1.z, v[j][7] * rstd * g1.w);
            *(u32x2*)(MIX8 + c) = o; } }
#else
            u32x4 o; o.x = pk2h(v[j][0] * rstd * g0.x, v[j][1] * rstd * g0.y); o.y = pk2h(v[j][2] * rstd * g0.z, v[j][3] * rstd * g0.w);
            o.z = pk2h(v[j][4] * rstd * g1.x, v[j][5] * rstd * g1.y); o.w = pk2h(v[j][6] * rstd * g1.z, v[j][7] * rstd * g1.w);
            *(u32x4*)(MIX + c) = o; } }
#endif
    {   float v[2][8]; float s = 0.f;
#pragma unroll
        for (int j = 0; j < 2; ++j) { const int hh = (lane >> 4) + 4 * j;
            const float l0 = LSE[((size_t)0 * M + m) * 8 + hh], l1 = LSE[((size_t)1 * M + m) * 8 + hh], l2 = LSE[((size_t)2 * M + m) * 8 + hh];
            const float mx = fmaxf(l0, fmaxf(l1, l2)); const float e0 = __expf(l0 - mx), e1 = __expf(l1 - mx), e2 = __expf(l2 - mx); const float inv = 1.0f / (e0 + e1 + e2);
            const float w0 = e0 * inv, w1 = e1 * inv, w2 = e2 * inv;
            const h16x8 a0 = *(const h16x8*)(OB[0] + (lane + 64 * j) * 8), a1 = *(const h16x8*)(OB[1] + (lane + 64 * j) * 8), a2 = *(const h16x8*)(OB[2] + (lane + 64 * j) * 8);
#pragma unroll
            for (int e = 0; e < 8; ++e) { v[j][e] = w0 * (float)a0[e] + w1 * (float)a1[e] + w2 * (float)a2[e]; s += v[j][e] * v[j][e]; } }
        const float rstd = 1.0f / sqrtf(wave_sum(s) * (1.0f / 1024.0f) + RMS_EPS);
#pragma unroll
        for (int j = 0; j < 2; ++j) { const int c = (lane + 64 * j) * 8; const f32x4 g0 = *(const f32x4*)(P.g_dil + c), g1 = *(const f32x4*)(P.g_dil + c + 4);
#if F8WO
            u32x2 o; o.x = pk4f8(v[j][0] * rstd * g0.x, v[j][1] * rstd * g0.y, v[j][2] * rstd * g0.z, v[j][3] * rstd * g0.w);
            o.y = pk4f8(v[j][4] * rstd * g1.x, v[j][5] * rstd * g1.y, v[j][6] * rstd * g1.z, v[j][7] * rstd * g1.w);
            *(u32x2*)(MIX8 + 1024 + c) = o; } }
#else
            u32x4 o; o.x = pk2h(v[j][0] * rstd * g0.x, v[j][1] * rstd * g0.y); o.y = pk2h(v[j][2] * rstd * g0.z, v[j][3] * rstd * g0.w);
            o.z = pk2h(v[j][4] * rstd * g1.x, v[j][5] * rstd * g1.y); o.w = pk2h(v[j][6] * rstd * g1.z, v[j][7] * rstd * g1.w);
            *(u32x4*)(MIX + 1024 + c) = o; } }
#endif
}
template <bool NEXT>
__device__ __forceinline__ void resid_row(const float* basef, const h16* baseh, const h16* y, const float* ss, const float* gpost, const float* gnext, float* outf, h16* outh, h16* xn2, int lane) {
    const float part = (lane < 32) ? ss[lane] : 0.f;
    const float rstd_y = 1.0f / sqrtf(wave_sum(part) * (1.0f / DM) + RMS_EPS);
    f32x4 v[4][2]; float s = 0.f;
#pragma unroll
    for (int j = 0; j < 4; ++j) { const int c = (lane + 64 * j) * 8; const h16x8 yy = *(const h16x8*)(y + c);
        h16x8 bh; if (!NEXT) bh = *(const h16x8*)(baseh + c);
#pragma unroll
        for (int q = 0; q < 2; ++q) { const f32x4 g = *(const f32x4*)(gpost + c + 4 * q);
            f32x4 b; if (NEXT) b = *(const f32x4*)(basef + c + 4 * q); else b = (f32x4){(float)bh[4 * q], (float)bh[4 * q + 1], (float)bh[4 * q + 2], (float)bh[4 * q + 3]};
            f32x4 o; o.x = b.x + (float)yy[4 * q + 0] * rstd_y * g.x; o.y = b.y + (float)yy[4 * q + 1] * rstd_y * g.y; o.z = b.z + (float)yy[4 * q + 2] * rstd_y * g.z; o.w = b.w + (float)yy[4 * q + 3] * rstd_y * g.w;
            v[j][q] = o; s += (o.x * o.x + o.y * o.y) + (o.z * o.z + o.w * o.w);
            if (!NEXT) *(f32x4*)(outf + c + 4 * q) = o; }
        if (NEXT) { u32x4 w; w.x = pk2h(v[j][0].x, v[j][0].y); w.y = pk2h(v[j][0].z, v[j][0].w); w.z = pk2h(v[j][1].x, v[j][1].y); w.w = pk2h(v[j][1].z, v[j][1].w); *(u32x4*)(outh + c) = w; } }
    if (NEXT) { const float rstd = 1.0f / sqrtf(wave_sum(s) * (1.0f / DM) + RMS_EPS);
#pragma unroll
        for (int j = 0; j < 4; ++j) { const int c = (lane + 64 * j) * 8; const f32x4 g0 = *(const f32x4*)(gnext + c), g1 = *(const f32x4*)(gnext + c + 4);
#if F8FFN
            u32x2 o; o.x = pk4f8(v[j][0].x * rstd * g0.x, v[j][0].y * rstd * g0.y, v[j][0].z * rstd * g0.z, v[j][0].w * rstd * g0.w);
            o.y = pk4f8(v[j][1].x * rstd * g1.x, v[j][1].y * rstd * g1.y, v[j][1].z * rstd * g1.z, v[j][1].w * rstd * g1.w);
            *(u32x2*)((unsigned char*)xn2 + c) = o; } }
#else
            u32x4 o; o.x = pk2h(v[j][0].x * rstd * g0.x, v[j][0].y * rstd * g0.y); o.y = pk2h(v[j][0].z * rstd * g0.z, v[j][0].w * rstd * g0.w);
            o.z = pk2h(v[j][1].x * rstd * g1.x, v[j][1].y * rstd * g1.y); o.w = pk2h(v[j][1].z * rstd * g1.z, v[j][1].w * rstd * g1.w);
            *(u32x4*)(xn2 + c) = o; } }
#endif
}

__global__ __launch_bounds__(256) void k_p0(Ptrs P) {
    __shared__ float scr_all[4 * 64 * 33];
    const int lane = threadIdx.x & 63, wave = threadIdx.x >> 6;
    p0_prologue(P, (LAS float*)scr_all + wave * 64 * 33, blockIdx.x * 4 + wave, gridDim.x * 4, lane);
}
__global__ __launch_bounds__(512) void k_p3(Ptrs P) {
    const int lane = threadIdx.x & 63, gw = blockIdx.x * 8 + (threadIdx.x >> 6), NGW = gridDim.x * 8;
    for (int m = gw; m < M; m += NGW) p3_row(P, m, lane);
}
__global__ __launch_bounds__(256) void nv_gemm(const h16* A, int lda, const h16* Bt, int ldb, float* C, int ldc, int K) {
    __shared__ float As[32][65]; __shared__ float Bs[32][65];
    const int t = threadIdx.x, m0 = blockIdx.y * 64, n0 = blockIdx.x * 64, lr = t >> 2, lk = (t & 3) * 8, ty = t >> 4, tx = t & 15;
    float acc[4][4];
#pragma unroll
    for (int i = 0; i < 4; ++i)
#pragma unroll
        for (int j = 0; j < 4; ++j) acc[i][j] = 0.f;
    for (int k0 = 0; k0 < K; k0 += 32) {
        const h16x8 a = *(const h16x8*)(A + (size_t)(m0 + lr) * lda + k0 + lk);
        const h16x8 b = *(const h16x8*)(Bt + (size_t)(n0 + lr) * ldb + k0 + lk);
#pragma unroll
        for (int e = 0; e < 8; ++e) { As[lk + e][lr] = (float)a[e]; Bs[lk + e][lr] = (float)b[e]; }
        __syncthreads();
#pragma unroll 8
        for (int kk = 0; kk < 32; ++kk) {
            float av[4], bv[4];
#pragma unroll
            for (int i = 0; i < 4; ++i) { av[i] = As[kk][ty * 4 + i]; bv[i] = Bs[kk][tx * 4 + i]; }
#pragma unroll
            for (int i = 0; i < 4; ++i)
#pragma unroll
                for (int j = 0; j < 4; ++j) acc[i][j] = fmaf(av[i], bv[j], acc[i][j]);
        }
        __syncthreads();
    }
#pragma unroll
    for (int i = 0; i < 4; ++i) { f32x4 o = {acc[i][0], acc[i][1], acc[i][2], acc[i][3]}; *(f32x4*)(C + (size_t)(m0 + ty * 4 + i) * ldc + n0 + tx * 4) = o; }
}
__global__ __launch_bounds__(256) void nv_rope(const float* C, h16* QKV, const f32x2* CS, int chunk) {
    const size_t e = (size_t)blockIdx.x * 256 + threadIdx.x; const int m = (int)(e >> 10), j = (int)(e & 1023), d = j & 127;
    float v = C[e];
    if ((chunk % 3) != 2 && d < 32) {
        const int i = d & 15; const f32x2 cs = CS[(size_t)m * 16 + i];
        if (d < 16) v = v * cs.x - C[e + 16] * cs.y; else v = v * cs.x + C[e - 16] * cs.y;
    }
    QKV[(size_t)m * NQKV + chunk * 1024 + j] = (h16)v;
}
__global__ __launch_bounds__(256) void nv_ksum(const h16* QKV, float* KSUM) {
    const int e = blockIdx.x * 256 + threadIdx.x; const int pm = e >> 10, c = e & 1023;
    float s = 0.f;
    for (int r = 0; r < 256; ++r) s += (float)QKV[(size_t)(pm * 256 + r) * NQKV + 1024 + c];
    KSUM[(size_t)(pm * 2 + 0) * 1024 + c] = s; KSUM[(size_t)(pm * 2 + 1) * 1024 + c] = 0.f;
}
__global__ __launch_bounds__(256) void nv_cvt_ss(const float* C, int ncols, h16* Y, int col0, float* SS) {
    const int lane = threadIdx.x & 63; const size_t w = (size_t)blockIdx.x * 4 + (threadIdx.x >> 6); const int nslot = ncols / 64; const int m = (int)(w / nslot), s = (int)(w % nslot);
    const float v = C[(size_t)m * ncols + s * 64 + lane];
    Y[(size_t)m * DM + col0 + s * 64 + lane] = (h16)v;
    const float q = wave_sum(v * v);
    if (lane == 0) SS[(size_t)m * 32 + col0 / 64 + s] = q;
}
__global__ __launch_bounds__(256) void nv_conv(const float* C, h16* ACT, const float* conv_w, const float* conv_b, int g0) {
    const size_t e = (size_t)blockIdx.x * 256 + threadIdx.x; const int m = (int)(e >> 8), jj = (int)(e & 255), gi = jj >> 7, j = jj & 127;
    const int c = 128 * (g0 + gi) + j; const int s = m & (SEQ - 1);
    const float* Cg = C + (size_t)m * 512 + gi * 256 + j;
    const float g_0 = Cg[0], g_1 = (s >= 1) ? Cg[-512] : 0.f, g_2 = (s >= 2) ? Cg[-1024] : 0.f, u = Cg[128];
    const float pre = conv_b[c] + conv_w[c] * g_2 + conv_w[FF + c] * g_1 + conv_w[2 * FF + c] * g_0;
    ACT[(size_t)m * FF + c] = (h16)(gelu_tanh(pre) * u);
}
__global__ __launch_bounds__(256) void nv_attn(const h16* QKV, const float* KSUM, h16* OA, h16* OB0, h16* OB1, h16* OB2, float* LSE, int mode) {
    __shared__ float Qs[32][129]; __shared__ float Ks[32][129]; __shared__ float Vs[32][128]; __shared__ float Ps[32][33]; __shared__ float Gs[32][16]; __shared__ unsigned Sel[32];
    const int t = threadIdx.x, u = blockIdx.x, b = u >> 10, h = (u >> 7) & 7, rem = u & 127;
    int d = 1, r = 0, i0, W; const h16 *Qp, *Kp, *Vp; h16* Op; size_t pitch, opitch;
    if (mode == 0) { i0 = rem * 32; W = 1 << 30; pitch = NQKV; opitch = 1024;
        Qp = QKV + (size_t)(b * SEQ) * NQKV + 0 + h * HD; Kp = Qp + 1024; Vp = Qp + 2048; Op = OA + (size_t)(b * SEQ) * 1024 + h * HD; }
    else { d = (mode == 1) ? 1 : (mode == 2) ? 4 : 16; const int nq = (SEQ / d) / 32; r = rem / nq; i0 = (rem % nq) * 32; W = 129; pitch = (size_t)NQKV * d; opitch = (size_t)1024 * d;
        Qp = QKV + (size_t)(b * SEQ + r) * NQKV + 3072 + h * HD; Kp = Qp + 1024; Vp = Qp + 2048;
        h16* OBm = (mode == 1) ? OB0 : (mode == 2) ? OB1 : OB2; Op = OBm + (size_t)(b * SEQ + r) * 1024 + h * HD; }
    for (int e = t; e < 32 * 128; e += 256) { const int qi = e >> 7, c = e & 127; Qs[qi][c] = (float)Qp[(size_t)(i0 + qi) * pitch + c]; }
    __syncthreads();
    const int qi = t >> 3, sub = t & 7;
    if (mode == 0) {
        const int qblk = i0 >> 8;
        for (int jj = 0; jj < 2; ++jj) { const int j = sub + 8 * jj; float g = 0.f;
            if (j < qblk) { const float* k0 = KSUM + (size_t)((b * 16 + j) * 2) * 1024 + h * HD; for (int c = 0; c < 128; ++c) g += Qs[qi][c] * (k0[c] + k0[1024 + c]) * (1.0f / 256.0f); }
            Gs[qi][j] = g; }
        __syncthreads();
        if (sub == 0) { unsigned sel = 0;
            for (int rnd = 0; rnd < 3; ++rnd) { float best = -3.0e38f; int bi = -1;
                for (int j = 0; j < 16; ++j) if (j < qblk && !((sel >> j) & 1u) && Gs[qi][j] > best) { best = Gs[qi][j]; bi = j; }
                if (bi >= 0) sel |= 1u << bi; }
            sel |= 1u << qblk; Sel[qi] = sel; }
        __syncthreads();
    }
    const unsigned selmask = (mode == 0) ? Sel[qi] : 0xffffffffu;
    float o[16];
#pragma unroll
    for (int c = 0; c < 16; ++c) o[c] = 0.f;
    float mrun = -1e30f, lrun = 0.f;
    int klo = (mode == 0) ? 0 : (i0 - 128 > 0 ? i0 - 128 : 0); klo &= ~31;
    const int khi = i0 + 32;
    const int iq = i0 + qi;
    for (int k0 = klo; k0 < khi; k0 += 32) {
        __syncthreads();
        for (int e = t; e < 32 * 128; e += 256) { const int kk = e >> 7, c = e & 127; Ks[kk][c] = (float)Kp[(size_t)(k0 + kk) * pitch + c]; Vs[kk][c] = (float)Vp[(size_t)(k0 + kk) * pitch + c]; }
        __syncthreads();
        float sc[4]; float tmax = -1e30f;
#pragma unroll
        for (int j = 0; j < 4; ++j) { const int kk = sub * 4 + j, kidx = k0 + kk; float a = 0.f;
            for (int c = 0; c < 128; ++c) a += Qs[qi][c] * Ks[kk][c];
            a *= SCALE;
            bool ok = (kidx <= iq) && (iq - kidx < W);
            if (mode == 0) ok = ok && ((selmask >> (kidx >> 8)) & 1u);
            sc[j] = ok ? a : -INFINITY; tmax = fmaxf(tmax, sc[j]); }
        tmax = fmaxf(tmax, __shfl_xor(tmax, 1)); tmax = fmaxf(tmax, __shfl_xor(tmax, 2)); tmax = fmaxf(tmax, __shfl_xor(tmax, 4));
        const float mnew = fmaxf(mrun, tmax); const float alpha = __expf(mrun - mnew);
        float ps = 0.f;
#pragma unroll
        for (int j = 0; j < 4; ++j) { const float p = __expf(sc[j] - mnew); Ps[qi][sub * 4 + j] = p; ps += p; }
        ps += __shfl_xor(ps, 1); ps += __shfl_xor(ps, 2); ps += __shfl_xor(ps, 4);
        lrun = lrun * alpha + ps; mrun = mnew;
        __syncthreads();
#pragma unroll
        for (int c = 0; c < 16; ++c) o[c] *= alpha;
        for (int kk = 0; kk < 32; ++kk) { const float p = Ps[qi][kk];
#pragma unroll
            for (int c = 0; c < 16; ++c) o[c] = fmaf(p, Vs[kk][sub * 16 + c], o[c]); }
    }
    const float inv = 1.0f / lrun;
#pragma unroll
    for (int c = 0; c < 16; ++c) Op[(size_t)(i0 + qi) * opitch + sub * 16 + c] = (h16)(o[c] * inv);
    if (mode != 0 && sub == 0) LSE[((size_t)(mode - 1) * M + (size_t)(b * SEQ + r + d * (i0 + qi))) * 8 + h] = mrun + __logf(lrun);
}

namespace pg8 {
#define PG8_LAS __attribute__((address_space(3)))
constexpr int BM = 256, BK = 64, HALF = 128, HTB = HALF * BK * 2, STAGE_BYTES = 8 * HTB, NXCD = 8, WGM = 8;
__host__ __device__ __forceinline__ int lds_byte(int r, int c) { const int st = (r >> 4) * 2 + (c >> 5), rr = r & 15, cc = c & 31, ob = rr * 64 + cc * 2; return st * 1024 + (ob ^ (((ob >> 9) & 1) << 5)); }
__host__ __device__ __forceinline__ void stage_rc(int b, int& R, int& C) { const int st = b / 1024, sb = b % 1024, swz = sb ^ (((sb >> 9) & 1) << 5); R = (st >> 1) * 16 + swz / 64; C = (st & 1) * 32 + (swz % 64) / 2; }
__host__ __device__ __forceinline__ int perm32(int rho) { const int n = rho >> 4, i = rho & 15; return 8 * (i >> 2) + 4 * n + (i & 3); }
struct Unit { int pm, pn; };
struct Gemm { const void* A; const void* Bt; int M, N, K; int scale_w, scale_x; };
typedef int i32x8 __attribute__((ext_vector_type(8)));
typedef int i32x4 __attribute__((ext_vector_type(4)));
struct StaticOrder {
    int nM, nN, nwg, G, c;
    __host__ __device__ void init(int M_, int N_, int G_, int c_) { nM = M_ / BM; nN = N_ / BM; nwg = nM * nN; G = G_; c = c_; }
    __host__ __device__ bool next(int i, Unit& u) const {
        const long L = (long)i * G + c; if (L >= nwg) return false;
        int wgid = (int)L; { const int q = nwg / NXCD, r = nwg % NXCD, xcd = wgid % NXCD, off = wgid / NXCD; wgid = (xcd < r ? xcd * (q + 1) : r * (q + 1) + (xcd - r) * q) + off; }
        const int nig = WGM * nN, gid = wgid / nig, fm = gid * WGM, gsz = (nM - fm) < WGM ? (nM - fm) : WGM;
        u.pm = fm + ((wgid % nig) % gsz); u.pn = (wgid % nig) / gsz; return true;
    }
};
typedef f32x4 Acc[2][2][4][2];

__device__ __forceinline__ u32x4 pack8h(f32x4 v0, f32x4 v1) { u32x4 w; w.x = pk2h(v0[0], v0[1]); w.y = pk2h(v0[2], v0[3]); w.z = pk2h(v1[0], v1[1]); w.w = pk2h(v1[2], v1[3]); return w; }

struct EpiQKV {
    static constexpr bool IDEMPOTENT = false;
    __device__ __forceinline__ void prefetch(const Unit&, int, int, PG8_LAS unsigned char*) const {}
    h16* O; const f32x2* CS; float* KSUM; int pn_off;
    __device__ __forceinline__ void operator()(Acc& acc, const Unit& u0, int wr, int wc, int fr, int fq, PG8_LAS unsigned char* xlds) const {
        Unit u = u0; u.pn += pn_off;
        const int grp6 = u.pn >> 2, kind = grp6 % 3;
        const int row0 = u.pm * BM + wr * 64 + fr;
        if (kind != 2 && wc == 0) {
            const float sgn = (fq < 2) ? -1.f : 1.f;
#pragma unroll
            for (int ai = 0; ai < 2; ++ai)
#pragma unroll
                for (int m = 0; m < 4; ++m) {
                    const f32x4* cp = (const f32x4*)(CS + (size_t)(row0 + ai * HALF + m * 16) * 16 + 8 * (fq & 1));
                    const f32x4 c0 = cp[0], c1 = cp[1], c2 = cp[2], c3 = cp[3];
                    const float cs[8] = {c0[0], c0[2], c1[0], c1[2], c2[0], c2[2], c3[0], c3[2]}, sn[8] = {c0[1], c0[3], c1[1], c1[3], c2[1], c2[3], c3[1], c3[3]};
#pragma unroll
                    for (int bj = 0; bj < 2; ++bj)
#pragma unroll
                        for (int n = 0; n < 2; ++n)
#pragma unroll
                            for (int e = 0; e < 4; ++e) { const float v = acc[ai][bj][m][n][e]; const float o = __shfl_xor(v, 32);
                                acc[ai][bj][m][n][e] = v * cs[4 * n + e] + sgn * o * sn[4 * n + e]; }
                }
        }
        if (grp6 == 1) {
#pragma unroll
            for (int bj = 0; bj < 2; ++bj)
#pragma unroll
                for (int n = 0; n < 2; ++n) { f32x4 s = {0.f, 0.f, 0.f, 0.f};
#pragma unroll
                    for (int ai = 0; ai < 2; ++ai)
#pragma unroll
                        for (int m = 0; m < 4; ++m) s += acc[ai][bj][m][n];
#pragma unroll
                    for (int e = 0; e < 4; ++e) { float t = s[e]; t += __shfl_xor(t, 1); t += __shfl_xor(t, 2); t += __shfl_xor(t, 4); t += __shfl_xor(t, 8); s[e] = t; }
                    if (fr == 0) *(f32x4*)(KSUM + (size_t)(u.pm * 2 + wr) * 1024 + (u.pn - 4) * 256 + bj * HALF + wc * 32 + 8 * fq + 4 * n) = s; }
        }
        const int col0 = u.pn * BM + wc * 32 + 8 * fq;
#pragma unroll
        for (int ai = 0; ai < 2; ++ai)
#pragma unroll
            for (int m = 0; m < 4; ++m) { h16* rowp = O + (size_t)(row0 + ai * HALF + m * 16) * NQKV + col0;
#pragma unroll
                for (int bj = 0; bj < 2; ++bj) *(u32x4*)(rowp + bj * HALF) = pack8h(acc[ai][bj][m][0], acc[ai][bj][m][1]); }
    }
};
struct EpiY {
    static constexpr bool IDEMPOTENT = false;
    __device__ __forceinline__ void prefetch(const Unit&, int, int, PG8_LAS unsigned char*) const {}
    h16* O; float* SS;
    __device__ __forceinline__ void operator()(Acc& acc, const Unit& u, int wr, int wc, int fr, int fq, PG8_LAS unsigned char* xlds) const {
        const int row0 = u.pm * BM + wr * 64 + fr, col0 = u.pn * BM + wc * 32 + 8 * fq;
#pragma unroll
        for (int ai = 0; ai < 2; ++ai)
#pragma unroll
            for (int m = 0; m < 4; ++m) { const int row = row0 + ai * HALF + m * 16; h16* rowp = O + (size_t)row * DM + col0; float q = 0.f;
#pragma unroll
                for (int bj = 0; bj < 2; ++bj) { const f32x4 v0 = acc[ai][bj][m][0], v1 = acc[ai][bj][m][1];
                    q += (v0[0] * v0[0] + v0[1] * v0[1]) + (v0[2] * v0[2] + v0[3] * v0[3]) + (v1[0] * v1[0] + v1[1] * v1[1]) + (v1[2] * v1[2] + v1[3] * v1[3]);
                    *(u32x4*)(rowp + bj * HALF) = pack8h(v0, v1); }
                q += __shfl_xor(q, 16); q += __shfl_xor(q, 32);
                if (fq == 0) SS[(size_t)row * 32 + u.pn * 4 + wc] = q; }
    }
};
template <int CTRL> __device__ __forceinline__ float dpp_mov(float old, float src) {
    return __builtin_bit_cast(float, __builtin_amdgcn_update_dpp(__builtin_bit_cast(int, old), __builtin_bit_cast(int, src), CTRL, 0xF, 0xF, false)); }
struct EpiGU {
    static constexpr bool IDEMPOTENT = true;
    h16* ACT; const float* conv_w; const float* conv_b; float* HALO; float* FIXP; float* FIXU;
    __device__ __forceinline__ void prefetch(const Unit& u, int wid, int lane, PG8_LAS unsigned char* xlds) const {
        const int wc = wid & 3, col = u.pn * HALF + wc * 32 + (lane & 31), v = lane >> 5;
        const float* s0 = conv_w + (size_t)v * FF + col;
        const float* s1 = v ? conv_b + col : conv_w + (size_t)2 * FF + col;
        PG8_LAS unsigned* d = (PG8_LAS unsigned*)(xlds + 4096 + wid * 512);
        __builtin_amdgcn_global_load_lds((const unsigned*)s0, d, 4, 0, 0);
        __builtin_amdgcn_global_load_lds((const unsigned*)s1, d + 64, 4, 0, 0);
    }
    __device__ __forceinline__ void operator()(Acc& acc, const Unit& u, int wr, int wc, int fr, int fq, PG8_LAS unsigned char* xlds) const {
#if F8FFN
        typedef h16x2 hh;
        PG8_LAS u32x4* xb = (PG8_LAS u32x4*)xlds;
        const int c0 = u.pn * HALF + wc * 32 + 8 * fq;
#define CV2(a, b) __builtin_bit_cast(hh, pk2h((a), (b)))
#define DPPI(ctrl, oldv, srcv) __builtin_amdgcn_update_dpp((int)(oldv), (int)(srcv), ctrl, 0xF, 0xF, false)
        if (fr >= 14) {
#pragma unroll
            for (int ai = 0; ai < 2; ++ai) xb[(((ai * 2 + wr) * 4 + wc) * 4 + fq) * 2 + (fr - 14)] = pack8h(acc[ai][0][3][0], acc[ai][0][3][1]);
            if (wr == 1) { float* hp = HALO + ((size_t)(u.pm * 2 + (fr - 14))) * FF + c0;
                *(f32x4*)hp = acc[1][0][3][0]; *(f32x4*)(hp + 4) = acc[1][0][3][1]; }
        }
        asm volatile("s_waitcnt lgkmcnt(0)" ::: "memory"); __builtin_amdgcn_s_barrier(); asm volatile("" ::: "memory");
        hh w0[4], w1[4], w2[4], bb[4];
        { const PG8_LAS float* cw = (const PG8_LAS float*)(xlds + 4096 + (wr * 4 + wc) * 512) + 8 * fq;
#pragma unroll
          for (int n = 0; n < 2; ++n) { const f32x4 a = *(const PG8_LAS f32x4*)(cw + 4 * n), b = *(const PG8_LAS f32x4*)(cw + 32 + 4 * n), c = *(const PG8_LAS f32x4*)(cw + 64 + 4 * n), d = *(const PG8_LAS f32x4*)(cw + 96 + 4 * n);
              w0[2 * n] = CV2(a[0], a[1]); w0[2 * n + 1] = CV2(a[2], a[3]); w1[2 * n] = CV2(b[0], b[1]); w1[2 * n + 1] = CV2(b[2], b[3]);
              w2[2 * n] = CV2(c[0], c[1]); w2[2 * n + 1] = CV2(c[2], c[3]); bb[2 * n] = CV2(d[0], d[1]); bb[2 * n + 1] = CV2(d[2], d[3]); } }
        const hh zero2 = {(h16)0.f, (h16)0.f}, one2 = {(h16)1.f, (h16)1.f}, c1 = {(h16)-2.3022082f, (h16)-2.3022082f}, c2 = {(h16)-0.1029432f, (h16)-0.1029432f};
        const hh s8 = {(h16)F8_ACT_SCALE, (h16)F8_ACT_SCALE}, hi448 = {(h16)448.f, (h16)448.f}, lo448 = {(h16)-448.f, (h16)-448.f};
#pragma unroll
        for (int ai = 0; ai < 2; ++ai) {
            int pv[4];
            if (ai == 0 && wr == 0) { pv[0] = 0; pv[1] = 0; pv[2] = 0; pv[3] = 0; }
            else { const int sg = (wr == 1) ? (ai * 2 + 0) : (0 * 2 + 1);
                const u32x4 t = xb[((sg * 4 + wc) * 4 + fq) * 2 + (fr & 1)];
                pv[0] = (int)t.x; pv[1] = (int)t.y; pv[2] = (int)t.z; pv[3] = (int)t.w; }
#pragma unroll
            for (int m = 0; m < 4; ++m) {
                const int row = u.pm * BM + ai * HALF + wr * 64 + m * 16 + fr;
                hh gg[4], pre[4], o[4];
#pragma unroll
                for (int q = 0; q < 4; ++q) { gg[q] = CV2(acc[ai][0][m][q >> 1][2 * (q & 1)], acc[ai][0][m][q >> 1][2 * (q & 1) + 1]);
                    const int gi = __builtin_bit_cast(int, gg[q]);
                    const hh p1 = __builtin_bit_cast(hh, DPPI(0x111, DPPI(0x121, 0, pv[q]), gi));
                    const hh p2 = __builtin_bit_cast(hh, DPPI(0x112, DPPI(0x122, 0, pv[q]), gi));
                    pre[q] = w2[q] * gg[q] + (w1[q] * p1 + (w0[q] * p2 + bb[q])); }
                if (ai == 0 && wr == 0 && m == 0 && fr < 2) { float* fp = FIXP + ((size_t)(u.pm * 2 + fr)) * FF + c0; float* fu = FIXU + ((size_t)(u.pm * 2 + fr)) * FF + c0;
                    *(f32x4*)fp = (f32x4){(float)pre[0][0], (float)pre[0][1], (float)pre[1][0], (float)pre[1][1]}; *(f32x4*)(fp + 4) = (f32x4){(float)pre[2][0], (float)pre[2][1], (float)pre[3][0], (float)pre[3][1]};
                    *(f32x4*)fu = acc[0][1][0][0]; *(f32x4*)(fu + 4) = acc[0][1][0][1]; }
#pragma unroll
                for (int q = 0; q < 4; ++q) { const hh x = pre[q]; const hh a = x * (x * x * c2 + c1);
                    hh e; e[0] = __builtin_exp2f16(a[0]); e[1] = __builtin_exp2f16(a[1]);
                    const hh d = e + one2; hh r; r[0] = __builtin_amdgcn_rcph(d[0]); r[1] = __builtin_amdgcn_rcph(d[1]);
                    const hh uu = CV2(acc[ai][1][m][q >> 1][2 * (q & 1)], acc[ai][1][m][q >> 1][2 * (q & 1) + 1]);
                    hh y = (x * r) * uu * s8; y = __builtin_elementwise_max(__builtin_elementwise_min(y, hi448), lo448); o[q] = y; }
                typedef short s16x2 __attribute__((ext_vector_type(2)));
                s16x2 wl = {0, 0}, wh = {0, 0};
                wl = __builtin_amdgcn_cvt_scalef32_pk_fp8_f16(wl, o[0], 1.0f, false); wl = __builtin_amdgcn_cvt_scalef32_pk_fp8_f16(wl, o[1], 1.0f, true);
                wh = __builtin_amdgcn_cvt_scalef32_pk_fp8_f16(wh, o[2], 1.0f, false); wh = __builtin_amdgcn_cvt_scalef32_pk_fp8_f16(wh, o[3], 1.0f, true);
                u32x2 w8; w8.x = __builtin_bit_cast(unsigned, wl); w8.y = __builtin_bit_cast(unsigned, wh);
                *(u32x2*)((unsigned char*)ACT + (size_t)row * FF + c0) = w8;
#pragma unroll
                for (int q = 0; q < 4; ++q) pv[q] = __builtin_bit_cast(int, gg[q]);
            }
        }
#undef CV2
#undef DPPI
#else
        PG8_LAS float* xb = (PG8_LAS float*)xlds;
        const int c0 = u.pn * HALF + wc * 32 + 8 * fq;
        if (fr >= 14) {
#pragma unroll
            for (int ai = 0; ai < 2; ++ai) { PG8_LAS float* d = xb + ((((ai * 2 + wr) * 4 + wc) * 4 + fq) * 2 + (fr - 14)) * 8;
                *(PG8_LAS f32x4*)d = acc[ai][0][3][0]; *(PG8_LAS f32x4*)(d + 4) = acc[ai][0][3][1]; }
            if (wr == 1) { float* hp = HALO + ((size_t)(u.pm * 2 + (fr - 14))) * FF + c0;
                *(f32x4*)hp = acc[1][0][3][0]; *(f32x4*)(hp + 4) = acc[1][0][3][1]; }
        }
        asm volatile("s_waitcnt lgkmcnt(0)" ::: "memory"); __builtin_amdgcn_s_barrier(); asm volatile("" ::: "memory");
        f32x4 w0[2], w1[2], w2[2], bb[2];
        { const PG8_LAS float* cw = (const PG8_LAS float*)(xlds + 4096 + (wr * 4 + wc) * 512) + 8 * fq;
#pragma unroll
          for (int n = 0; n < 2; ++n) { w0[n] = *(const PG8_LAS f32x4*)(cw + 4 * n); w1[n] = *(const PG8_LAS f32x4*)(cw + 32 + 4 * n); w2[n] = *(const PG8_LAS f32x4*)(cw + 64 + 4 * n); bb[n] = *(const PG8_LAS f32x4*)(cw + 96 + 4 * n); } }
#pragma unroll
        for (int ai = 0; ai < 2; ++ai) {
            f32x4 pv[2];
            if (ai == 0 && wr == 0) { pv[0] = (f32x4){0.f, 0.f, 0.f, 0.f}; pv[1] = pv[0]; }
            else { const int sg = (wr == 1) ? (ai * 2 + 0) : (0 * 2 + 1);
                const PG8_LAS float* s = xb + (((sg * 4 + wc) * 4 + fq) * 2 + (fr & 1)) * 8;
                pv[0] = *(const PG8_LAS f32x4*)s; pv[1] = *(const PG8_LAS f32x4*)(s + 4); }
#pragma unroll
            for (int m = 0; m < 4; ++m) {
                const int row = u.pm * BM + ai * HALF + wr * 64 + m * 16 + fr;
                f32x4 o[2];
#pragma unroll
                for (int n = 0; n < 2; ++n)
#pragma unroll
                    for (int e = 0; e < 4; ++e) { const float g = acc[ai][0][m][n][e], pg = pv[n][e];
                        const float p1 = dpp_mov<0x111>(dpp_mov<0x121>(0.f, pg), g);
                        const float p2 = dpp_mov<0x112>(dpp_mov<0x122>(0.f, pg), g);
                        o[n][e] = bb[n][e] + w0[n][e] * p2 + w1[n][e] * p1 + w2[n][e] * g; }
                if (ai == 0 && wr == 0 && m == 0 && fr < 2) { float* fp = FIXP + ((size_t)(u.pm * 2 + fr)) * FF + c0; float* fu = FIXU + ((size_t)(u.pm * 2 + fr)) * FF + c0;
                    *(f32x4*)fp = o[0]; *(f32x4*)(fp + 4) = o[1]; *(f32x4*)fu = acc[0][1][0][0]; *(f32x4*)(fu + 4) = acc[0][1][0][1]; }
#pragma unroll
                for (int n = 0; n < 2; ++n)
#pragma unroll
                    for (int e = 0; e < 4; ++e) o[n][e] = gelu_tanh(o[n][e]) * acc[ai][1][m][n][e];
                *(u32x4*)(ACT + (size_t)row * FF + c0) = pack8h(o[0], o[1]);
                pv[0] = acc[ai][0][m][0]; pv[1] = acc[ai][0][m][1];
            }
        }
#endif
    }
};

template <class Epi, class Sched, bool F8 = false>
__device__ __forceinline__ void gemm_phase(PG8_LAS unsigned char* lds, PG8_LAS unsigned char* xlds, const Gemm g, const Sched& S, const Epi& E) {
    const int tid = threadIdx.x, wid = __builtin_amdgcn_readfirstlane(tid >> 6), lane = tid & 63, wr = wid >> 2, wc = wid & 3, fr = lane & 15, fq = lane >> 4;
    const int RB = F8 ? g.K : g.K * 2, nt = RB / 128;
    unsigned voffA[2], voffB[2];
#pragma unroll
    for (int i = 0; i < 2; ++i) { int R, C; stage_rc(tid * 16 + i * 8192, R, C); const int Rb = (R & ~31) + perm32(R & 31);
        voffA[i] = (unsigned)(R * RB + C * 2); voffB[i] = (unsigned)(Rb * RB + C * 2); }
    const size_t kstep = (size_t)128;
    const size_t hstep = (size_t)HALF * RB;
    const size_t tstep = 2 * hstep;
    const unsigned ldsw = (unsigned)wid * 1024u;
    const int aoff = lds_byte(wr * 64 + fr, fq * 8), boff = lds_byte(wc * 32 + fr, fq * 8);
#define PG8_SA(b, h) (((b) * 2 + (h)) * HTB)
#define PG8_SB(b, h) ((4 + (b) * 2 + (h)) * HTB)
#define PG8_STAGE(bufoff, gbase, voff) do { _Pragma("unroll") for (int _i = 0; _i < 2; ++_i) \
        __builtin_amdgcn_global_load_lds((const unsigned*)((const char*)(gbase) + (voff)[_i]), (PG8_LAS unsigned*)(lds + (bufoff) + ldsw + _i * 8192), 16, 0, 0); } while (0)
#define PG8_LDA(dst, b, h) do { _Pragma("unroll") for (int m = 0; m < 4; ++m) _Pragma("unroll") for (int k = 0; k < 2; ++k) dst[m][k] = *(const PG8_LAS h16x8*)(lds + PG8_SA(b, h) + aoff + m * 2048 + k * 1024); } while (0)
#define PG8_LDB(dst, b, h) do { _Pragma("unroll") for (int n = 0; n < 2; ++n) _Pragma("unroll") for (int k = 0; k < 2; ++k) dst[n][k] = *(const PG8_LAS h16x8*)(lds + PG8_SB(b, h) + boff + n * 2048 + k * 1024); } while (0)
#define PG8_CAT(v) __builtin_shufflevector(__builtin_bit_cast(i32x4, v[0]), __builtin_bit_cast(i32x4, v[1]), 0, 1, 2, 3, 4, 5, 6, 7)
#define PG8_MMA(ai, bj, At, Bt) do { __builtin_amdgcn_s_setprio(1); \
        if constexpr (F8) { _Pragma("unroll") for (int m = 0; m < 4; ++m) _Pragma("unroll") for (int n = 0; n < 2; ++n) \
            asm volatile("v_mfma_scale_f32_16x16x128_f8f6f4 %0, %1, %2, %0, %3, %4 op_sel_hi:[0,0,0]" : "+v"(acc[ai][bj][m][n]) : "v"(PG8_CAT(Bt[n])), "v"(PG8_CAT(At[m])), "v"(sc_w), "v"(sc_x)); } \
        else { _Pragma("unroll") for (int m = 0; m < 4; ++m) _Pragma("unroll") for (int n = 0; n < 2; ++n) _Pragma("unroll") for (int k = 0; k < 2; ++k) \
            acc[ai][bj][m][n] = __builtin_amdgcn_mfma_f32_16x16x32_f16(Bt[n][k], At[m][k], acc[ai][bj][m][n], 0, 0, 0); } \
        __builtin_amdgcn_s_setprio(0); } while (0)
#define PG8_WAIT_V(n) asm volatile("s_waitcnt vmcnt(" #n ")" ::: "memory")
#define PG8_WAIT_L(n) asm volatile("s_waitcnt lgkmcnt(" #n ")" ::: "memory")
#define PG8_BAR __builtin_amdgcn_s_barrier()
#define PG8_SCHED __builtin_amdgcn_sched_barrier(0)
    Unit cur, nxt; int ui = 0;
    if (!S.next(0, cur)) return;
    const int sc_w = g.scale_w, sc_x = g.scale_x;
    Acc acc;
#pragma unroll
    for (int a = 0; a < 2; ++a)
#pragma unroll
        for (int b = 0; b < 2; ++b)
#pragma unroll
            for (int m = 0; m < 4; ++m)
#pragma unroll
                for (int n = 0; n < 2; ++n) acc[a][b][m][n] = (f32x4){0.f, 0.f, 0.f, 0.f};
    h16x8 At[4][2], B0[2][2], B1[2][2];
    const char* cA = (const char*)g.A + (size_t)cur.pm * tstep; const char* cB = (const char*)g.Bt + (size_t)cur.pn * tstep;
    PG8_STAGE(PG8_SB(0, 0), cB, voffB); PG8_STAGE(PG8_SB(0, 1), cB + hstep, voffB); PG8_STAGE(PG8_SA(0, 0), cA, voffA); PG8_STAGE(PG8_SA(0, 1), cA + hstep, voffA);
    if (wr == 1) PG8_BAR;
    PG8_WAIT_V(2); PG8_BAR;
    PG8_STAGE(PG8_SB(1, 0), cB + kstep, voffB); PG8_STAGE(PG8_SA(1, 0), cA + kstep, voffA); PG8_STAGE(PG8_SB(1, 1), cB + hstep + kstep, voffB);
    PG8_WAIT_V(6); PG8_BAR;
    for (;;) {
        const bool has_next = S.next(ui + 1, nxt);
        const char* nA = has_next ? (const char*)g.A + (size_t)nxt.pm * tstep : cA; const char* nB = has_next ? (const char*)g.Bt + (size_t)nxt.pn * tstep : cB;
        for (int t = 0; t < nt; t += 2) {
            const bool last = (t == nt - 2);
            if (t == 0) E.prefetch(cur, wid, lane, xlds);
            const char* a1 = cA + (size_t)(t + 1) * kstep;
            const char* a2 = last ? nA : cA + (size_t)(t + 2) * kstep; const char* b2 = last ? nB : cB + (size_t)(t + 2) * kstep;
            const char* a3 = a2 + kstep; const char* b3 = b2 + kstep;
            PG8_LDB(B0, 0, 0); PG8_LDB(B1, 0, 1); PG8_SCHED; PG8_LDA(At, 0, 0); PG8_STAGE(PG8_SA(1, 1), a1 + hstep, voffA);
            PG8_WAIT_V(8); PG8_WAIT_L(0); PG8_BAR; PG8_MMA(0, 0, At, B0); PG8_MMA(0, 1, At, B1); PG8_BAR; PG8_SCHED;
            PG8_LDA(At, 0, 1); PG8_STAGE(PG8_SB(0, 0), b2, voffB); PG8_STAGE(PG8_SB(0, 1), b2 + hstep, voffB); PG8_STAGE(PG8_SA(0, 0), a2, voffA);
            PG8_WAIT_V(8); PG8_WAIT_L(0); PG8_BAR; PG8_MMA(1, 0, At, B0); PG8_MMA(1, 1, At, B1); PG8_BAR; PG8_SCHED;
            PG8_LDB(B0, 1, 0); PG8_LDB(B1, 1, 1); PG8_SCHED; PG8_LDA(At, 1, 0); PG8_STAGE(PG8_SA(0, 1), a2 + hstep, voffA);
            PG8_WAIT_V(8); PG8_WAIT_L(0); PG8_BAR; PG8_MMA(0, 0, At, B0); PG8_MMA(0, 1, At, B1); PG8_BAR; PG8_SCHED;
            PG8_LDA(At, 1, 1); PG8_STAGE(PG8_SB(1, 0), b3, voffB); PG8_STAGE(PG8_SB(1, 1), b3 + hstep, voffB); PG8_STAGE(PG8_SA(1, 0), a3, voffA);
            PG8_WAIT_V(8); PG8_WAIT_L(0); PG8_BAR; PG8_MMA(1, 0, At, B0); PG8_MMA(1, 1, At, B1); PG8_BAR; PG8_SCHED;
        }
        if (wr == 0) PG8_BAR;
        if constexpr (F8) asm volatile("s_nop 15\n\ts_nop 15" ::: "memory");
        E(acc, cur, wr, wc, fr, fq, xlds);
#ifdef PROBE_EPI2
        if constexpr (Epi::IDEMPOTENT) { asm volatile("s_waitcnt vmcnt(8) lgkmcnt(0)" ::: "memory"); __builtin_amdgcn_s_barrier(); E(acc, cur, wr, wc, fr, fq, xlds); }
#endif
        if (!has_next) break;
#pragma unroll
        for (int a = 0; a < 2; ++a)
#pragma unroll
            for (int b = 0; b < 2; ++b)
#pragma unroll
                for (int m = 0; m < 4; ++m)
#pragma unroll
                    for (int n = 0; n < 2; ++n) acc[a][b][m][n] = (f32x4){0.f, 0.f, 0.f, 0.f};
        cur = nxt; cA = nA; cB = nB; ++ui;
        if (wr == 1) PG8_BAR;
    }
    PG8_WAIT_V(0);
    PG8_BAR;
#undef PG8_SA
#undef PG8_SB
#undef PG8_STAGE
#undef PG8_LDA
#undef PG8_LDB
#undef PG8_MMA
#undef PG8_CAT
#undef PG8_WAIT_V
#undef PG8_WAIT_L
#undef PG8_BAR
#undef PG8_SCHED
}
}

__device__ __forceinline__ void p5b_fixup_tile(const Ptrs& P, int pm, int tid) {
    if ((pm & 15) == 0) return;
    const float* HALO = (const float*)(P.ws + WS_HALO); const float* FIXP = (const float*)(P.ws + WS_FIXP); const float* FIXU = (const float*)(P.ws + WS_FIXU); h16* ACT = (h16*)(P.ws + WS_ACT);
    for (int e = tid; e < 2 * (FF / 4); e += 512) {
        const int c = (e % (FF / 4)) * 4, i = e / (FF / 4);
        const f32x4 p = *(const f32x4*)(FIXP + (size_t)(pm * 2 + i) * FF + c), uu = *(const f32x4*)(FIXU + (size_t)(pm * 2 + i) * FF + c);
        const f32x4 h0 = *(const f32x4*)(HALO + (size_t)((pm - 1) * 2 + 0) * FF + c), h1 = *(const f32x4*)(HALO + (size_t)((pm - 1) * 2 + 1) * FF + c);
        const f32x4 w0 = *(const f32x4*)(P.conv_w + c), w1 = *(const f32x4*)(P.conv_w + FF + c);
        f32x4 pre;
        if (i == 0) pre = p + w0 * h0 + w1 * h1; else pre = p + w0 * h1;
#if F8FFN
        *(unsigned*)((unsigned char*)ACT + (size_t)(pm * 256 + i) * FF + c) = pk4f8(gelu_tanh(pre[0]) * uu[0] * F8_ACT_SCALE, gelu_tanh(pre[1]) * uu[1] * F8_ACT_SCALE, gelu_tanh(pre[2]) * uu[2] * F8_ACT_SCALE, gelu_tanh(pre[3]) * uu[3] * F8_ACT_SCALE);
#else
        const unsigned lo = pk2h(gelu_tanh(pre[0]) * uu[0], gelu_tanh(pre[1]) * uu[1]), hi = pk2h(gelu_tanh(pre[2]) * uu[2], gelu_tanh(pre[3]) * uu[3]);
        *(unsigned long long*)(ACT + (size_t)(pm * 256 + i) * FF + c) = (unsigned long long)lo | ((unsigned long long)hi << 32);
#endif
    }
}
__device__ __forceinline__ void p5b_fixup(const Ptrs& P, int gtid, int nthreads) {
    const float* HALO = (const float*)(P.ws + WS_HALO); const float* FIXP = (const float*)(P.ws + WS_FIXP); const float* FIXU = (const float*)(P.ws + WS_FIXU); h16* ACT = (h16*)(P.ws + WS_ACT);
    for (int e = gtid; e < 64 * 2 * (FF / 4); e += nthreads) {
        const int c = (e % (FF / 4)) * 4, i = (e / (FF / 4)) & 1, pm = e / (2 * (FF / 4));
        if ((pm & 15) == 0) continue;
        const f32x4 p = *(const f32x4*)(FIXP + (size_t)(pm * 2 + i) * FF + c), uu = *(const f32x4*)(FIXU + (size_t)(pm * 2 + i) * FF + c);
        const f32x4 h0 = *(const f32x4*)(HALO + (size_t)((pm - 1) * 2 + 0) * FF + c), h1 = *(const f32x4*)(HALO + (size_t)((pm - 1) * 2 + 1) * FF + c);
        const f32x4 w0 = *(const f32x4*)(P.conv_w + c), w1 = *(const f32x4*)(P.conv_w + FF + c);
        f32x4 pre;
        if (i == 0) pre = p + w0 * h0 + w1 * h1; else pre = p + w0 * h1;
#if F8FFN
        *(unsigned*)((unsigned char*)ACT + (size_t)(pm * 256 + i) * FF + c) = pk4f8(gelu_tanh(pre[0]) * uu[0] * F8_ACT_SCALE, gelu_tanh(pre[1]) * uu[1] * F8_ACT_SCALE, gelu_tanh(pre[2]) * uu[2] * F8_ACT_SCALE, gelu_tanh(pre[3]) * uu[3] * F8_ACT_SCALE);
#else
        const unsigned lo = pk2h(gelu_tanh(pre[0]) * uu[0], gelu_tanh(pre[1]) * uu[1]), hi = pk2h(gelu_tanh(pre[2]) * uu[2], gelu_tanh(pre[3]) * uu[3]);
        *(unsigned long long*)(ACT + (size_t)(pm * 256 + i) * FF + c) = (unsigned long long)lo | ((unsigned long long)hi << 32);
#endif
    }
}


#define XB_TMO      128
#define XB_XCNT(j)  (256  + 64 * (j))
#define XB_XSUB(j)  (1280 + 64 * (j))
#define XB_XGEN(j)  (2304 + 64 * (j))
#define XB_TOP      3328
#define XB_TOPGEN   3392
#define XCD_BAR_WORDS 3456
#define XB_SPIN_CAP (1u << 18)
__device__ __forceinline__ unsigned xb_ld(unsigned* p)              { return __hip_atomic_load(p, __ATOMIC_RELAXED, __HIP_MEMORY_SCOPE_AGENT); }
__device__ __forceinline__ unsigned xb_add(unsigned* p, unsigned v) { return __hip_atomic_fetch_add(p, v, __ATOMIC_RELAXED, __HIP_MEMORY_SCOPE_AGENT); }
__device__ __forceinline__ unsigned xb_xcc_id() { return (unsigned)__builtin_amdgcn_s_getreg((3 << 11) | 20) & 0xFu; }
#define XB_SPIN(cond, bar) do { unsigned _sp = 0; while (cond) { __builtin_amdgcn_s_sleep(1); \
    if ((++_sp & 255u) == 0u) { if (xb_ld(&(bar)[XB_TMO])) break; if (_sp > XB_SPIN_CAP) { atomicAdd(&(bar)[XB_TMO], 1u); break; } } } } while (0)
struct XcdBarrier { unsigned* bar; unsigned x; volatile LAS unsigned* st; };
__device__ __forceinline__ XcdBarrier xcd_barrier_post(unsigned* bar, volatile LAS unsigned* st) {
    XcdBarrier b; b.bar = bar; b.x = xb_xcc_id(); b.st = st;
    if (threadIdx.x == 0) (void)xb_add(&bar[XB_XCNT(b.x)], 1u);
    return b;
}
__device__ __forceinline__ void xcd_barrier_complete(unsigned* bar, unsigned x, unsigned& nloc, unsigned& nx) {
    const unsigned G = gridDim.x * gridDim.y * gridDim.z;
    unsigned sum, cnt, mine, sp = 0u;
    for (;;) {
        sum = 0u; cnt = 0u; mine = 0u;
#pragma unroll
        for (unsigned j = 0; j < 16; ++j) { const unsigned c = xb_ld(&bar[XB_XCNT(j)]); sum += c; cnt += (c > 0u) ? 1u : 0u; mine = (j == x) ? c : mine; }
        if (sum == G) break;
        __builtin_amdgcn_s_sleep(1);
        if ((++sp & 255u) == 0u) { if (xb_ld(&bar[XB_TMO])) break; if (sp > XB_SPIN_CAP) { atomicAdd(&bar[XB_TMO], 1u); break; } }
    }
    nloc = mine > 0u ? mine : 1u; nx = cnt > 0u ? cnt : 1u;
}
__device__ __forceinline__ void xcd_barrier(const XcdBarrier& b) {
    asm volatile("s_waitcnt vmcnt(0)" ::: "memory");
    __syncthreads();
    if (threadIdx.x == 0) {
        unsigned* bar = b.bar;
        __builtin_amdgcn_s_waitcnt(0);
        unsigned nloc = b.st[0], nx = b.st[1];
        if (nloc == 0u) { xcd_barrier_complete(bar, b.x, nloc, nx); b.st[0] = nloc; b.st[1] = nx; }
        const unsigned old = xb_add(&bar[XB_XSUB(b.x)], 1u);
        const unsigned gen = old / nloc;
        if (old + 1u == (gen + 1u) * nloc) {
            __builtin_amdgcn_fence(__ATOMIC_RELEASE, "agent");
            asm volatile("s_waitcnt vmcnt(0)" ::: "memory");
            const unsigned og = xb_add(&bar[XB_TOP], 1u);
            const unsigned tg = og / nx;
            if (og + 1u == (tg + 1u) * nx) xb_add(&bar[XB_TOPGEN], 1u);
            else XB_SPIN(xb_ld(&bar[XB_TOPGEN]) == tg, bar);
            __builtin_amdgcn_fence(__ATOMIC_ACQUIRE, "agent");
            xb_add(&bar[XB_XGEN(b.x)], 1u);
            asm volatile("s_waitcnt vmcnt(0)" ::: "memory");
        } else {
            XB_SPIN(xb_ld(&bar[XB_XGEN(b.x)]) == gen, bar);
            __builtin_amdgcn_fence(__ATOMIC_ACQUIRE, "agent");
            asm volatile("s_waitcnt vmcnt(0)" ::: "memory");
        }
    }
    __syncthreads();
}

#ifndef PROBE_MASK
#define PROBE_MASK 0
#endif
namespace att {
constexpr int NW = 8, QBLK = 32, KVBLK = 64, QB = NW * QBLK;
constexpr int SHM_V = KVBLK * HD * 2, SHM_K = KVBLK * HD * 2;
constexpr int LDS_BYTES = 2 * SHM_V + 2 * SHM_K + NW * 64 * 4;
constexpr float THR = 8.f;
typedef short s16x4 __attribute__((ext_vector_type(4)));
typedef short s16x8 __attribute__((ext_vector_type(8)));
typedef float f32x16 __attribute__((ext_vector_type(16)));
#define KSWZ(row, colB) ((row) * 256 + ((colB) ^ (((row) & 7) << 4)))
#define SBAR() __builtin_amdgcn_sched_barrier(0)
__device__ __forceinline__ int v_st(int k, int c) { const int kk = (k & ~0xC) | ((k & 4) << 1) | ((k & 8) >> 1); return ((kk >> 3) * 4 + (c >> 5)) * 512 + ((kk & 7) * 32 + (c & 31)) * 2; }
__device__ __forceinline__ int v_rd_base(int lane) { return ((lane & 3) << 3) | (((lane >> 2) & 3) << 6) | (((lane >> 4) & 1) << 5) | (((lane >> 5) & 1) << 8); }
constexpr int v_rd_off(int d0, int ks, int half) { return d0 * 512 + ks * 4096 + half * 2048; }
__device__ __forceinline__ int crow(int r, int hi) { return (r & 3) + 8 * (r >> 2) + 4 * hi; }
__device__ __forceinline__ h16x8 load8(const h16* p) { return *reinterpret_cast<const h16x8*>(p); }
__device__ __forceinline__ void mask_tile(f32x16& p0, f32x16& p1, int dq, unsigned W) {
    const float NEG = -__builtin_inff();
#pragma unroll
    for (int r = 0; r < 16; ++r) {
        const int c = (r & 3) + 8 * (r >> 2);
        if ((unsigned)(dq - c) >= W) p0[r] = NEG;
        if ((unsigned)(dq - c - 32) >= W) p1[r] = NEG;
    }
}
__device__ __forceinline__ void kill_tile(f32x16& p0, f32x16& p1, bool dead) {
    const float NEG = -__builtin_inff();
#pragma unroll
    for (int r = 0; r < 16; ++r) { p0[r] = dead ? NEG : p0[r]; p1[r] = dead ? NEG : p1[r]; }
}
__device__ __forceinline__ void partialSM(f32x16& p0, f32x16& p1, float& m_reg, float& mn, float& alpha) {
    float pmax = p0[0];
#pragma unroll
    for (int r = 1; r < 16; ++r) pmax = fmaxf(pmax, p0[r]);
#pragma unroll
    for (int r = 0; r < 16; ++r) pmax = fmaxf(pmax, p1[r]);
    { auto rr = __builtin_amdgcn_permlane32_swap(__float_as_uint(pmax), __float_as_uint(pmax), false, false);
      pmax = fmaxf(__uint_as_float(rr[0]), __uint_as_float(rr[1])); }
    constexpr float C2 = 1.4426950408889634f * SCALE;
    if (__builtin_expect(__all((pmax - m_reg) * SCALE <= THR), 1)) { mn = m_reg; alpha = 1.f; }
    else { mn = fmaxf(m_reg, pmax); alpha = __builtin_amdgcn_exp2f((m_reg - mn) * C2); m_reg = mn; }
    const float mnL = -mn * C2;
#pragma unroll
    for (int r = 0; r < 16; ++r) p0[r] = fmaf(p0[r], C2, mnL);
#pragma unroll
    for (int r = 0; r < 16; ++r) p1[r] = fmaf(p1[r], C2, mnL);
#pragma unroll
    for (int r = 0; r < 16; ++r) p0[r] = __builtin_amdgcn_exp2f(p0[r]);
}
__device__ __forceinline__ void finishSM(f32x16& p0, f32x16& p1, float alpha, float& l_reg, h16x8& pa0, h16x8& pa1, h16x8& pa2, h16x8& pa3) {
#pragma unroll
    for (int r = 0; r < 16; ++r) p1[r] = __builtin_amdgcn_exp2f(p1[r]);
    float ps = 0;
#pragma unroll
    for (int r = 0; r < 16; ++r) ps += p0[r];
#pragma unroll
    for (int r = 0; r < 16; ++r) ps += p1[r];
    { auto rr = __builtin_amdgcn_permlane32_swap(__float_as_uint(ps), __float_as_uint(ps), false, false);
      ps = __uint_as_float(rr[0]) + __uint_as_float(rr[1]); }
    l_reg = l_reg * alpha + ps;
#define PK4(P, B_, OUT) do { unsigned a0 = pk2h(P[B_+0], P[B_+1]), a1 = pk2h(P[B_+2], P[B_+3]);                          \
        unsigned b0 = pk2h(P[B_+4], P[B_+5]), b1 = pk2h(P[B_+6], P[B_+7]);                                             \
        auto r0 = __builtin_amdgcn_permlane32_swap(a0, b0, false, false); auto r1 = __builtin_amdgcn_permlane32_swap(a1, b1, false, false); \
        u32x4 w = {r0[0], r1[0], r0[1], r1[1]}; OUT = __builtin_bit_cast(h16x8, w); } while (0)
    PK4(p0, 0, pa0); PK4(p0, 8, pa1); PK4(p1, 0, pa2); PK4(p1, 8, pa3);
#undef PK4
}
template <int KB>
__device__ __forceinline__ void qkt(f32x16& p0, f32x16& p1, const char* K_lds, int r32, int hi, const h16x8* qr, bool act) {
    if (!act) { const float NEG = -__builtin_inff();
#pragma unroll
        for (int r = 0; r < 16; ++r) { p0[r] = NEG; p1[r] = NEG; } return; }
    p0 = f32x16{}; p1 = f32x16{};
    const char* kb[4];
#pragma unroll
    for (int dd = 0; dd < 4; ++dd) kb[dd] = K_lds + KB * SHM_K + KSWZ(r32, (dd * 16 + hi * 8) * 2);
#pragma unroll
    for (int d0 = 0; d0 < 8; ++d0) { const char* a = kb[d0 & 3] + (d0 >> 2) * 128;
        h16x8 b0 = *reinterpret_cast<const h16x8*>(a);
        h16x8 b1 = *reinterpret_cast<const h16x8*>(a + 32 * 256);
        p0 = __builtin_amdgcn_mfma_f32_32x32x16_f16(b0, qr[d0], p0, 0, 0, 0);
        p1 = __builtin_amdgcn_mfma_f32_32x32x16_f16(b1, qr[d0], p1, 0, 0, 0); }
}
template <int VB>
__device__ __forceinline__ void pv_tile(f32x16* o, int vb0, h16x8 pa0, h16x8 pa1, h16x8 pa2, h16x8 pa3, bool act) {
    if (!act) return;
#define TRRD(dst, off) asm volatile("ds_read_b64_tr_b16 %0, %1 offset:%2" : "=&v"(dst) : "v"(vb0), "i"(off) : "memory")
#define MKB(l, h) __builtin_bit_cast(h16x8, (s16x8){l[0], l[1], l[2], l[3], h[0], h[1], h[2], h[3]})
#define PV_D0(d0) do { s16x4 l0, l1, l2, l3, h0, h1, h2, h3; constexpr int b_ = VB * SHM_V + v_rd_off(d0, 0, 0); \
        TRRD(l0, b_); TRRD(h0, b_ + 2048); TRRD(l1, b_ + 4096); TRRD(h1, b_ + 6144); TRRD(l2, b_ + 8192); TRRD(h2, b_ + 10240); TRRD(l3, b_ + 12288); TRRD(h3, b_ + 14336); \
        asm volatile("s_waitcnt lgkmcnt(0)" ::: "memory"); SBAR();   \
        o[d0] = __builtin_amdgcn_mfma_f32_32x32x16_f16(pa0, MKB(l0, h0), o[d0], 0, 0, 0);   \
        o[d0] = __builtin_amdgcn_mfma_f32_32x32x16_f16(pa1, MKB(l1, h1), o[d0], 0, 0, 0);   \
        o[d0] = __builtin_amdgcn_mfma_f32_32x32x16_f16(pa2, MKB(l2, h2), o[d0], 0, 0, 0);   \
        o[d0] = __builtin_amdgcn_mfma_f32_32x32x16_f16(pa3, MKB(l3, h3), o[d0], 0, 0, 0); } while (0)
    PV_D0(0); PV_D0(1); PV_D0(2); PV_D0(3);
#undef PV_D0
#undef MKB
#undef TRRD
}

struct BlockRef { const h16* K; h16* Ob; float* LSE; const float* KS; int P0, pitch, opitch, W, lsestride, moba; };
struct Seam { h16x8 qr[8]; h16x8 st_v0, st_v1, st_k0, st_k1; };
__device__ __forceinline__ int swa_jlo(int P0, int W) { const int lowk = P0 - W + 1; return lowk > 0 ? lowk / KVBLK : 0; }
#define VMW() asm volatile("s_waitcnt vmcnt(0)" ::: "memory")
#define VMWN(n) asm volatile("s_waitcnt vmcnt(%0)" :: "i"(n) : "memory")
#define SLOAD_H(Kt, o0, o1) do { S.st_v0 = load8((Kt) + 1024 + (o0)); S.st_v1 = load8((Kt) + 1024 + (o1));              \
                         S.st_k0 = load8((Kt) + (o0)); S.st_k1 = load8((Kt) + (o1)); } while (0)
#define SWRITE_HK(bf) do { *(h16x8*)(K_lds + (bf) * SHM_K + kws) = S.st_k0; *(h16x8*)(K_lds + (bf) * SHM_K + kws + 32 * 256) = S.st_k1; } while (0)
#define SWRITE_HV(bf) do { *(h16x8*)(V_lds + (bf) * SHM_V + vst0) = S.st_v0; *(h16x8*)(V_lds + (bf) * SHM_V + vst1) = S.st_v1; } while (0)
#define SWRITE_H(bf) do { SWRITE_HV(bf); SWRITE_HK(bf); } while (0)
__device__ __forceinline__ void attn_prime(const BlockRef& cur, char* lds, Seam& S) {
    const int tid = threadIdx.x, wid = __builtin_amdgcn_readfirstlane(tid >> 6), lane = tid & 63, r32 = lane & 31, hi = lane >> 5;
    const int sr = tid >> 4, sc = (tid & 15) * 8, kws = KSWZ(sr, sc * 2); char* K_lds = lds + 2 * SHM_V;
    const int kb0 = swa_jlo(cur.P0, cur.W) * KVBLK;
    const h16* Qw = cur.K - 1024 + (size_t)(cur.P0 + wid * QBLK) * cur.pitch;
    const unsigned qo = (unsigned)(r32 * cur.pitch + hi * 8);
#pragma unroll
    for (int d0 = 0; d0 < 8; ++d0) S.qr[d0] = load8(Qw + qo + d0 * 16);
    { const unsigned o0 = (unsigned)(sr * cur.pitch + sc), o1 = o0 + 32u * (unsigned)cur.pitch; const h16* Kt = cur.K + (size_t)kb0 * cur.pitch;
      SLOAD_H(Kt, o0, o1); } VMW(); SWRITE_HK(0);
    __syncthreads();
}
__device__ __forceinline__ void attn_block(const BlockRef& cur, const BlockRef& nxt, char* lds, Seam& S) {
    const int tid = threadIdx.x, wid = __builtin_amdgcn_readfirstlane(tid >> 6), lane = tid & 63, r32 = lane & 31, hi = lane >> 5;
    const int W = cur.W;
    const int j_lo = swa_jlo(cur.P0, W);
    const int j_hi = (cur.P0 + QB - 1) / KVBLK + 1;
    const int NT = j_hi - j_lo;
    const int kbn = swa_jlo(nxt.P0, nxt.W) * KVBLK;
    const int qlo = cur.P0 + wid * QBLK, qm = qlo + r32 - 4 * hi;
    char* V_lds = lds; char* K_lds = lds + 2 * SHM_V;
    float* ws = (float*)(lds + 2 * SHM_V + 2 * SHM_K) + wid * 64; float* li_l = ws, * al_l = ws + 32;
    float m_reg = -1e30f, l_reg = 0; f32x16 o[4] = {};
    const int sr = tid >> 4, sc = (tid & 15) * 8, vst0 = v_st(sr, sc), vst1 = v_st(32 + sr, sc), kws = KSWZ(sr, sc * 2);
    const int vb0 = (int)(uintptr_t)V_lds + v_rd_base(lane);
    const h16* Kh = cur.K; const int pitch = cur.pitch;
    const unsigned so0 = (unsigned)(sr * pitch + sc), so1 = so0 + 32u * (unsigned)pitch;
#define KTILE(t) (Kh + (size_t)KBASE(t) * pitch)
    unsigned selmask = 0xffffffffu;
    if (cur.moba) {
        const int qblk = cur.P0 >> 8;
        f32x16 gacc = f32x16{};
#pragma unroll
        for (int d0 = 0; d0 < 8; ++d0) {
            f32x4 a0 = {0.f, 0.f, 0.f, 0.f}, a1 = a0;
            if (r32 < qblk) { const float* kp = cur.KS + (size_t)(r32 * 2) * 1024 + d0 * 16 + hi * 8;
                a0 = *(const f32x4*)kp + *(const f32x4*)(kp + 1024); a1 = *(const f32x4*)(kp + 4) + *(const f32x4*)(kp + 1024 + 4); }
            a0 = a0 * (1.0f / 256.0f); a1 = a1 * (1.0f / 256.0f);
            u32x4 w = {pk2h(a0[0], a0[1]), pk2h(a0[2], a0[3]), pk2h(a1[0], a1[1]), pk2h(a1[2], a1[3])};
            gacc = __builtin_amdgcn_mfma_f32_32x32x16_f16(__builtin_bit_cast(h16x8, w), S.qr[d0], gacc, 0, 0, 0);
        }
        float gb[16];
#pragma unroll
        for (int j = 0; j < 16; ++j) { const int rj = (j & 3) + 4 * (j >> 3); const float own = gacc[rj]; const float oth = __shfl_xor(own, 32);
            gb[j] = (hi == ((j >> 2) & 1)) ? own : oth; }
        unsigned sel = 0u;
#pragma unroll
        for (int rnd = 0; rnd < 3; ++rnd) { float best = -3.0e38f; int bi = -1;
#pragma unroll
            for (int j = 0; j < 15; ++j) { const bool ok = (j < qblk) && !((sel >> j) & 1u) && (gb[j] > best); best = ok ? gb[j] : best; bi = ok ? j : bi; }
            if (bi >= 0) sel |= 1u << bi; }
        selmask = sel | (1u << qblk);
    }
#define RESC(a) do { if (__any((a) < 1.f)) { if (hi == 0) al_l[r32] = (a); asm volatile("s_waitcnt lgkmcnt(0)" ::: "memory");              \
                     _Pragma("unroll") for (int d_ = 0; d_ < 4; ++d_) _Pragma("unroll") for (int r = 0; r < 16; ++r) o[d_][r] *= al_l[crow(r, hi)]; } } while (0)
#define KBASE(t) ((j_lo + (t)) * KVBLK)
#define SELB(t) (((selmask >> (KBASE(t) >> 8)) & 1u) != 0u)
#define ACT(t) (KBASE(t) <= qlo + QBLK - 1 && KBASE(t) + KVBLK - 1 >= qlo - W + 1 && (!cur.moba || __any(SELB(t))))
#define MASKT(P0_, P1_, t) do { const int kb_ = KBASE(t); if (ACT(t)) { if (kb_ + KVBLK - 1 > qlo || kb_ <= qlo + QBLK - 1 - W) mask_tile(P0_, P1_, qm - kb_, (unsigned)W); \
                                 if (cur.moba && !__all(SELB(t))) kill_tile(P0_, P1_, !SELB(t)); } } while (0)
    constexpr int NQL = 8;
#define SEAM_K0() do { VMWN(NQL); SWRITE_HK(0); SBAR(); } while (0)
    f32x16 pA0, pA1, pB0, pB1; float mnA, mnB, alA, alB; h16x8 pa0, pa1, pa2, pa3;
    SWRITE_HV(0); SBAR();
    if (NT > 1) { SLOAD_H(KTILE(1), so0, so1); }
    SBAR(); qkt<0>(pA0, pA1, K_lds, r32, hi, S.qr, ACT(0));
    MASKT(pA0, pA1, 0); partialSM(pA0, pA1, m_reg, mnA, alA);
    if (NT > 1) { VMW(); SWRITE_H(1); }
    __syncthreads();
#define HALF_STEP(PX0, PX1, mnX, alX, PY0, PY1, alY, t, KB, VB, SB) do {                                                      \
        SBAR(); qkt<KB>(PX0, PX1, K_lds, r32, hi, S.qr, ACT(t));                                             \
        finishSM(PY0, PY1, alY, l_reg, pa0, pa1, pa2, pa3); SBAR();                                                           \
        if ((t) + 1 < NT) { SLOAD_H(KTILE((t) + 1), so0, so1); SBAR(); }                                               \
        pv_tile<VB>(o, vb0, pa0, pa1, pa2, pa3, ACT((t) - 1)); MASKT(PX0, PX1, (t)); partialSM(PX0, PX1, m_reg, mnX, alX);                                        \
        __syncthreads();                                                                                                      \
        if ((t) + 1 < NT) { VMW(); SWRITE_H(SB); }                                                                          \
        RESC(alX); __syncthreads(); } while (0)
    for (int t = 1; t + 1 < NT; t += 2) {
        HALF_STEP(pB0, pB1, mnB, alB, pA0, pA1, alA, t, 1, 0, 0);
        HALF_STEP(pA0, pA1, mnA, alA, pB0, pB1, alB, t + 1, 0, 1, 1);
    }
    const bool even = (NT & 1) == 0;
    if (even) { SBAR(); qkt<1>(pB0, pB1, K_lds, r32, hi, S.qr, ACT(NT - 1)); SBAR(); }
    { const unsigned n0 = (unsigned)(sr * nxt.pitch + sc), n1 = n0 + 32u * (unsigned)nxt.pitch; const h16* Kt = nxt.K + (size_t)kbn * nxt.pitch;
      SLOAD_H(Kt, n0, n1); SBAR();
      const h16* Qw = nxt.K - 1024 + (size_t)(nxt.P0 + wid * QBLK) * nxt.pitch; const unsigned qo = (unsigned)(r32 * nxt.pitch + hi * 8);
#pragma unroll
      for (int d0 = 0; d0 < 8; ++d0) S.qr[d0] = load8(Qw + qo + d0 * 16); }
    SBAR();
    finishSM(pA0, pA1, alA, l_reg, pa0, pa1, pa2, pa3); SBAR();
    pv_tile<0>(o, vb0, pa0, pa1, pa2, pa3, ACT(even ? NT - 2 : NT - 1));
    if (even) { MASKT(pB0, pB1, NT - 1); partialSM(pB0, pB1, m_reg, mnB, alB); __syncthreads(); RESC(alB);
        finishSM(pB0, pB1, alB, l_reg, pa0, pa1, pa2, pa3); SBAR(); pv_tile<1>(o, vb0, pa0, pa1, pa2, pa3, ACT(NT - 1)); }
    SBAR(); SEAM_K0();
    if (hi == 0) { li_l[r32] = l_reg; if (cur.LSE) cur.LSE[(size_t)(wid * QBLK + r32) * cur.lsestride] = m_reg * SCALE + __logf(l_reg); }
    asm volatile("s_waitcnt lgkmcnt(0)" ::: "memory");
    float rli[16];
#pragma unroll
    for (int r = 0; r < 16; ++r) rli[r] = __builtin_amdgcn_rcpf(li_l[crow(r, hi)]);
    h16* Ow = cur.Ob + (size_t)(cur.P0 + wid * QBLK) * cur.opitch;
    const unsigned olane = (unsigned)(4 * hi * cur.opitch + r32);
#pragma unroll
    for (int r = 0; r < 16; ++r) { h16* rp = Ow + (size_t)(((r & 3) + 8 * (r >> 2)) * cur.opitch);
#pragma unroll
        for (int d0 = 0; d0 < 4; ++d0) { const float v = o[d0][r] * rli[r];
            const float vn = __shfl_xor(v, 1);
            if ((r32 & 1) == 0) *(unsigned*)(rp + olane + d0 * 32) = pk2h(v, vn); } }
    __syncthreads();
#undef RESC
#undef KBASE
#undef SELB
#undef ACT
#undef MASKT
#undef SEAM_K0
#undef HALF_STEP
#undef KTILE
}
#undef ROWP
#undef VMW
#undef VMWN
#undef SLOAD_H
#undef SWRITE_HK
#undef SWRITE_HV
#undef SWRITE_H

__device__ __forceinline__ BlockRef unit_ref(int idx, unsigned char* ws) {
    const h16* QKV = (const h16*)(ws + WS_QKV);
    BlockRef R;
    if (idx < 512) { const int qb = 15 - (idx >> 5), bh = idx & 31, b = bh >> 3, h = bh & 7;
        const size_t tok0 = (size_t)b * SEQ;
        R.K = QKV + tok0 * NQKV + 1024 + h * HD;
        R.Ob = (h16*)(ws + WS_OA) + tok0 * 1024 + h * HD; R.LSE = nullptr; R.KS = (const float*)(ws + WS_KSUM) + (size_t)(b * 16 * 2) * 1024 + h * HD;
        R.P0 = qb * 256; R.pitch = NQKV; R.opitch = 1024; R.W = 1 << 30; R.lsestride = 0; R.moba = 1; }
    else { const int j = idx - 512, g = j >> 9, rem = j & 511, bh = rem & 31, sub = rem >> 5, b = bh >> 3, h = bh & 7;
        const int d = (g == 0) ? 1 : (g == 1) ? 4 : 16, nqb = 16 / d, r = sub / nqb, qb = sub % nqb;
        const size_t tok0 = (size_t)b * SEQ + r, tokq = tok0 + (size_t)d * qb * 256;
        R.K = QKV + tok0 * NQKV + 4096 + h * HD;
        h16* OBg = (h16*)(ws + (g == 0 ? WS_OB0 : g == 1 ? WS_OB1 : WS_OB2));
        R.Ob = OBg + tok0 * 1024 + h * HD; R.LSE = (float*)(ws + WS_LSE) + ((size_t)g * M + tokq) * 8 + h; R.KS = nullptr;
        R.P0 = qb * 256; R.pitch = NQKV * d; R.opitch = 1024 * d; R.W = 129; R.lsestride = 8 * d; R.moba = 0; }
    return R;
}
constexpr int NUNITS = 2048;
__device__ __forceinline__ int unit_pos(int k, int G, int w) { return (k & 1) ? (k + 1) * G - 1 - w : k * G + w; }
__device__ __forceinline__ void attn_phase(char* lds, unsigned char* ws, int G, int w) {
    int k = 0; int p = unit_pos(0, G, w); if (p >= NUNITS) return;
    BlockRef cur = unit_ref(p, ws);
    Seam S;
    attn_prime(cur, lds, S);
    for (;;) {
        const int pn = unit_pos(k + 1, G, w); const bool last = pn >= NUNITS;
        const BlockRef nxt = last ? cur : unit_ref(pn, ws);
        attn_block(cur, nxt, lds, S);
        if (last) break;
        cur = nxt; ++k;
    }
}
#undef KSWZ
#undef SBAR
}

constexpr int MK_LDS_BYTES = 147456, MK_XLDS_OFF = 131072;
struct MkArgs { Ptrs P; int ph_lo, ph_hi; };
namespace cg = cooperative_groups;
__global__ void __launch_bounds__(512, 2) mk_fwd(MkArgs a) {
    cg::grid_group grid = cg::this_grid();
    extern __shared__ __attribute__((aligned(16))) unsigned char lds_raw[];
    LAS unsigned char* lds = (LAS unsigned char*)lds_raw;
    const Ptrs& P = a.P;
    if (a.ph_lo < 0) grid.sync();
    volatile LAS unsigned* xst = (volatile LAS unsigned*)(lds + MK_XLDS_OFF + 8192);
    if (threadIdx.x < 4) xst[threadIdx.x] = 0u;
    __syncthreads();
    XcdBarrier xbar = xcd_barrier_post((unsigned*)(a.P.ws + WS_CTL), xst);

    const int tid = threadIdx.x, lane = tid & 63, wave = __builtin_amdgcn_readfirstlane(tid >> 6);
    const int G = gridDim.x, gw = blockIdx.x * 8 + wave, NGW = G * 8;
    unsigned char* ws = P.ws;
#define IN(k) (a.ph_lo <= (k) && (k) < a.ph_hi)
#if USE_CG_SYNC
#define SEAM(k) do { if (IN(k) && IN((k) + 1)) grid.sync(); } while (0)
#else
#define SEAM(k) do { if (IN(k) && IN((k) + 1)) xcd_barrier(xbar); } while (0)
#endif
#define PH(k) if (IN(k))
#define PHB() do { } while (0)
    PH(0) { PHB(); p0_prologue(P, (LAS float*)lds + wave * 64 * 33, gw, NGW, lane); }
    SEAM(0);
    PH(1) { PHB();
#if F8ATT
        { pg8::Gemm g{ws + WS_XN, ws + WS_WQKV, M, 2048, DM, 0, 0}; pg8::StaticOrder S; S.init(M, 2048, G, (int)blockIdx.x);
          pg8::EpiQKV E{(h16*)(ws + WS_QKV), (const f32x2*)(ws + WS_CS), (float*)(ws + WS_KSUM), 0};
          pg8::gemm_phase<pg8::EpiQKV, pg8::StaticOrder, false>(lds, lds + MK_XLDS_OFF, g, S, E); }
        { pg8::Gemm g{ws + WS_XN8, ws + WS_WQKV8, M, 4096, DM, 0x76767676, 0x7f7f7f7f}; pg8::StaticOrder S; S.init(M, 4096, G, (int)blockIdx.x);
          pg8::EpiQKV E{(h16*)(ws + WS_QKV), (const f32x2*)(ws + WS_CS), (float*)(ws + WS_KSUM), 8};
          pg8::gemm_phase<pg8::EpiQKV, pg8::StaticOrder, true>(lds, lds + MK_XLDS_OFF, g, S, E); }
#else
        { pg8::Gemm g{ws + WS_XN, ws + WS_WQKV, M, NQKV, DM, 0, 0}; pg8::StaticOrder S; S.init(M, NQKV, G, (int)blockIdx.x);
          pg8::EpiQKV E{(h16*)(ws + WS_QKV), (const f32x2*)(ws + WS_CS), (float*)(ws + WS_KSUM), 0};
          pg8::gemm_phase<pg8::EpiQKV, pg8::StaticOrder>(lds, lds + MK_XLDS_OFF, g, S, E); }
#endif
    }
    SEAM(1);
    PH(2) { PHB(); att::attn_phase((char*)lds_raw, ws, G, (int)blockIdx.x); }
    SEAM(2);
    PH(3) { PHB(); for (int m = gw; m < M; m += NGW) p3_row(P, m, lane); }
    SEAM(3);
    PH(4) { PHB();
#if F8WO
        pg8::Gemm g{ws + WS_MIX, ws + WS_WO, M, DM, DM, 0x76767676, 0x7f7f7f7f}; pg8::StaticOrder S; S.init(M, DM, G, (int)blockIdx.x);
        pg8::EpiY E{(h16*)(ws + WS_Y), (float*)(ws + WS_SS)};
        pg8::gemm_phase<pg8::EpiY, pg8::StaticOrder, true>(lds, lds + MK_XLDS_OFF, g, S, E);
#else
        pg8::Gemm g{ws + WS_MIX, ws + WS_WO, M, DM, DM, 0, 0}; pg8::StaticOrder S; S.init(M, DM, G, (int)blockIdx.x);
        pg8::EpiY E{(h16*)(ws + WS_Y), (float*)(ws + WS_SS)};
        pg8::gemm_phase<pg8::EpiY, pg8::StaticOrder>(lds, lds + MK_XLDS_OFF, g, S, E);
#endif
    }
    SEAM(4);
    PH(5) { PHB(); for (int m = gw; m < M; m += NGW)
        resid_row<true>(P.x + (size_t)m * DM, nullptr, (const h16*)(ws + WS_Y) + (size_t)m * DM, (const float*)(ws + WS_SS) + (size_t)m * 32, P.g_attn_post, P.g_ffn_pre,
                        nullptr, (h16*)(ws + WS_X1H) + (size_t)m * DM, (h16*)(ws + WS_XN2 + (size_t)m * DM * (F8FFN ? 1 : 2)), lane); }
    SEAM(5);
    PH(6) { PHB(); pg8::Gemm g{ws + WS_XN2, ws + WS_WGU, M, 2 * FF, DM, 0x76767676, 0x7f7f7f7f};   pg8::StaticOrder S; S.init(M, 2 * FF, G, (int)blockIdx.x);
        pg8::EpiGU E{(h16*)(ws + WS_ACT), P.conv_w, P.conv_b, (float*)(ws + WS_HALO), (float*)(ws + WS_FIXP), (float*)(ws + WS_FIXU)};
        pg8::gemm_phase<pg8::EpiGU, pg8::StaticOrder, (F8FFN != 0)>(lds, lds + MK_XLDS_OFF, g, S, E); }
    SEAM(6);
    PH(8) { PHB(); pg8::Gemm g{ws + WS_ACT, ws + WS_WD, M, DM, FF, 0x75757575, 0x7c7c7c7c};   pg8::StaticOrder S; S.init(M, DM, G, (int)blockIdx.x);
        { pg8::Unit uu; for (int i = 0; S.next(i, uu); ++i) p5b_fixup_tile(P, uu.pm, tid); }
        asm volatile("s_waitcnt vmcnt(0)" ::: "memory"); __syncthreads();
        pg8::EpiY E{(h16*)(ws + WS_Y2), (float*)(ws + WS_SS)};
        pg8::gemm_phase<pg8::EpiY, pg8::StaticOrder, (F8FFN != 0)>(lds, lds + MK_XLDS_OFF, g, S, E); }
    SEAM(8);
    if (IN(9)) { for (int m = gw; m < M; m += NGW)
        resid_row<false>(nullptr, (const h16*)(ws + WS_X1H) + (size_t)m * DM, (const h16*)(ws + WS_Y2) + (size_t)m * DM, (const float*)(ws + WS_SS) + (size_t)m * 32, P.g_ffn_post, nullptr,
                         P.out + (size_t)m * DM, nullptr, nullptr, lane); }
#undef IN
#undef SEAM
#undef PH
#undef PHB
}

extern "C" void kernel_launch(void* const* d_in, const int* in_sizes, int n_in, void* d_out, int out_size, void* d_ws, size_t ws_size, hipStream_t stream) {
    if (n_in != 15 || ws_size < WS_END) { fprintf(stderr, "kernel_launch: unexpected n_in %d or ws_size %zu (need %zu)\n", n_in, ws_size, (size_t)WS_END); return; }
    static int grid = 0;
    if (grid == 0) {
        int dev = 0, cus = 0, per_cu = 0;
        (void)hipGetDevice(&dev); (void)hipDeviceGetAttribute(&cus, hipDeviceAttributeMultiprocessorCount, dev);
        (void)hipFuncSetAttribute((const void*)mk_fwd, hipFuncAttributeMaxDynamicSharedMemorySize, MK_LDS_BYTES);
        (void)hipOccupancyMaxActiveBlocksPerMultiprocessor(&per_cu, (const void*)mk_fwd, 512, MK_LDS_BYTES);
        if (per_cu < 1) per_cu = 1;
        grid = cus * per_cu;
        fprintf(stderr, "kernel_launch: cus %d per_cu %d grid %d\n", cus, per_cu, grid);
    }
    Ptrs P{};
    P.x = (const float*)d_in[0]; P.pos = (const int*)d_in[1]; P.g_attn_pre = (const float*)d_in[2]; P.w_qkv = (const float*)d_in[3]; P.g_moba = (const float*)d_in[4];
    P.g_dil = (const float*)d_in[5]; P.w_o = (const float*)d_in[6]; P.g_attn_post = (const float*)d_in[7]; P.g_ffn_pre = (const float*)d_in[8]; P.w_gate = (const float*)d_in[9];
    P.w_up = (const float*)d_in[10]; P.conv_w = (const float*)d_in[11]; P.conv_b = (const float*)d_in[12]; P.w_down = (const float*)d_in[13]; P.g_ffn_post = (const float*)d_in[14];
    P.out = (float*)d_out; P.ws = (unsigned char*)d_ws;
    unsigned char* ws = P.ws;
    MkArgs a{}; a.P = P;
    (void)hipMemsetAsync((char*)d_ws + WS_CTL, 0, 16384, stream);
#if ONE_LAUNCH
    a.ph_lo = 0; a.ph_hi = 10;
    { void* kargs[] = {&a};
      hipError_t e = hipLaunchCooperativeKernel((const void*)mk_fwd, dim3(grid), dim3(512), kargs, MK_LDS_BYTES, stream);
      if (e != hipSuccess) fprintf(stderr, "kernel_launch: cooperative launch failed: %s (grid %d)\n", hipGetErrorString(e), grid); }
    return;
#endif
#define MK(lo, hi) do { a.ph_lo = (lo); a.ph_hi = (hi); for (int rr_ = 0; rr_ < 1 + ((PROBE_MASK >> (lo)) & 1); ++rr_) hipLaunchKernelGGL(mk_fwd, dim3(grid), dim3(512), MK_LDS_BYTES, stream, a); } while (0)
    MK(0, 1);
#if OPT_P1
    MK(1, 2);
#else
    for (int c = 0; c < 6; ++c) { float* scr = (float*)(ws + WS_NSCR1);
        nv_gemm<<<dim3(1024 / 64, M / 64), 256, 0, stream>>>((const h16*)(ws + WS_XN), DM, (const h16*)(ws + WS_WQKV) + (size_t)c * 1024 * DM, DM, scr, 1024, DM);
        nv_rope<<<(M * 1024) / 256, 256, 0, stream>>>(scr, (h16*)(ws + WS_QKV), (const f32x2*)(ws + WS_CS), c); }
    nv_ksum<<<(64 * 1024) / 256, 256, 0, stream>>>((const h16*)(ws + WS_QKV), (float*)(ws + WS_KSUM));
#endif
#if OPT_P2
    MK(2, 3);
#else
    for (int mode = 0; mode < 4; ++mode)
        nv_attn<<<4096, 256, 0, stream>>>((const h16*)(ws + WS_QKV), (const float*)(ws + WS_KSUM), (h16*)(ws + WS_OA), (h16*)(ws + WS_OB0), (h16*)(ws + WS_OB1), (h16*)(ws + WS_OB2), (float*)(ws + WS_LSE), mode);
#endif
    MK(3, 4);
#if OPT_P4
    MK(4, 5);
#else
    { float* scr = (float*)(ws + WS_NSCR4);
      nv_gemm<<<dim3(DM / 64, M / 64), 256, 0, stream>>>((const h16*)(ws + WS_MIX), DM, (const h16*)(ws + WS_WO), DM, scr, DM, DM);
      nv_cvt_ss<<<(M * 32) / 4, 256, 0, stream>>>(scr, DM, (h16*)(ws + WS_Y), 0, (float*)(ws + WS_SS)); }
#endif
    MK(5, 6);
#if OPT_P5
    MK(6, 7); MK(7, 8);
#else
    for (int c = 0; c < 32; ++c) { float* scr = (float*)(ws + WS_NSCR5);
        nv_gemm<<<dim3(512 / 64, M / 64), 256, 0, stream>>>((const h16*)(ws + WS_XN2), DM, (const h16*)(ws + WS_WGU) + (size_t)c * 512 * DM, DM, scr, 512, DM);
        nv_conv<<<(M * 256) / 256, 256, 0, stream>>>(scr, (h16*)(ws + WS_ACT), P.conv_w, P.conv_b, 2 * c); }
#endif
#if OPT_P6
    MK(8, 9);
#else
    for (int c = 0; c < 2; ++c) { float* scr = (float*)(ws + WS_NSCR6);
        nv_gemm<<<dim3(1024 / 64, M / 64), 256, 0, stream>>>((const h16*)(ws + WS_ACT), FF, (const h16*)(ws + WS_WD) + (size_t)c * 1024 * FF, FF, scr, 1024, FF);
        nv_cvt_ss<<<(M * 16) / 4, 256, 0, stream>>>(scr, 1024, (h16*)(ws + WS_Y2), c * 1024, (float*)(ws + WS_SS)); }
#endif
    MK(9, 10);
#undef MK
}
```
